# Optimizing an MI355X kernel written in HIP

```python
import functools
import jax, jax.numpy as jnp
from jax import lax
import numpy as np

D_MODEL = 1024
BATCH = 16
SEQ = 2048
DEPTH = 1
DEC_BATCH = 128
DEC_SEQ = 1
PAST_LEN = 8192
PAGE_SIZE = 128

MIX_WIDTH = D_MODEL
A_WIDTH = MIX_WIDTH // 2
A_GROUPS = 4
A_GROUP_DIM = A_WIDTH // A_GROUPS
CHUNK = 128
B_WIDTH = MIX_WIDTH - A_WIDTH
HEAD_DIM = 64
N_HEADS = B_WIDTH // HEAD_DIM
N_KV_HEADS = 2
GROUP_SIZE = N_HEADS // N_KV_HEADS
N_IDX_HEADS = 4
IDX_DIM = 64
IDX_W_SCALE = (N_IDX_HEADS * IDX_DIM) ** -0.5
TOPK_MAX = 256
Q_BLOCK = 128
ROPE_THETA = 10000.0
D_FF = 2816
LN_EPS = 1e-5
ALPHA = (2.0 * DEPTH) ** 0.25
BETA = (8.0 * DEPTH) ** -0.25
IN_SPLITS = (A_WIDTH, A_WIDTH, N_HEADS * HEAD_DIM, N_KV_HEADS * HEAD_DIM, N_KV_HEADS * HEAD_DIM, N_IDX_HEADS * IDX_DIM, IDX_DIM, N_IDX_HEADS)
IN_WIDTH = sum(IN_SPLITS)
SPLIT_POINTS = tuple(sum(IN_SPLITS[:i + 1]) for i in range(len(IN_SPLITS) - 1))

kernel_name = 'hymba_gmlp_dsa_macaron_deepnorm_step'


def _layernorm(x, g, b):
    xf = x.astype(jnp.float32)
    mu = jnp.mean(xf, axis=-1, keepdims=True)
    var = jnp.mean(jnp.square(xf - mu), axis=-1, keepdims=True)
    return ((xf - mu) * lax.rsqrt(var + LN_EPS) * g.astype(jnp.float32) + b.astype(jnp.float32)).astype(x.dtype)


def _swiglu(x, w_up, w_down):
    gate, up = jnp.split(x @ w_up, 2, axis=-1)
    return (jax.nn.silu(gate) * up) @ w_down


def _rope(x, pos):
    half = x.shape[-1] // 2
    inv = ROPE_THETA ** (-jnp.arange(half, dtype=jnp.float32) / half)
    ang = pos.astype(jnp.float32)[:, None] * inv[None, :]
    cos = jnp.cos(ang)[None, :, None, :]
    sin = jnp.sin(ang)[None, :, None, :]
    xf = x.astype(jnp.float32)
    x1, x2 = xf[..., :half], xf[..., half:]
    return jnp.concatenate([x1 * cos - x2 * sin, x2 * cos + x1 * sin], axis=-1).astype(x.dtype)


def _mixer_inputs(h, w_in, pos):
    B, T, _ = h.shape
    u, va, q, k, v, qi, ki, wi = jnp.split(h @ w_in, SPLIT_POINTS, axis=-1)
    q = _rope(q.reshape(B, T, N_HEADS, HEAD_DIM), pos)
    k = _rope(k.reshape(B, T, N_KV_HEADS, HEAD_DIM), pos)
    v = v.reshape(B, T, N_KV_HEADS, HEAD_DIM)
    qi = _rope(qi.reshape(B, T, N_IDX_HEADS, IDX_DIM), pos)
    ki = _rope(ki.reshape(B, T, 1, IDX_DIM), pos)[:, :, 0]
    return u, va, q, k, v, qi, ki, wi * IDX_W_SCALE


def _chunk_gmlp(u, v, a_ln_g, a_ln_b, a_ws, a_bs):
    B, T, _ = u.shape
    u = jax.nn.gelu(u)
    v = _layernorm(jax.nn.gelu(v), a_ln_g, a_ln_b)
    n_chunks = -(-T // CHUNK)
    pad = n_chunks * CHUNK - T
    vp = jnp.pad(v, ((0, 0), (0, pad), (0, 0))).reshape(B, n_chunks, CHUNK, A_GROUPS, A_GROUP_DIM)
    causal = jnp.tril(jnp.ones((CHUNK, CHUNK), dtype=bool))
    ws = jnp.where(causal[None], a_ws, 0)
    mixed = jnp.einsum('gts,bcsgd->bctgd', ws, vp) + a_bs.T[None, None, :, :, None]
    mixed = mixed.reshape(B, n_chunks * CHUNK, A_WIDTH)[:, :T]
    return u * mixed, v


def _indexer_scores(q_idx, w_idx, k_idx, q_pos):
    dots = jnp.einsum('bthd,bsd->bths', q_idx.astype(jnp.float32), k_idx.astype(jnp.float32))
    s = jnp.einsum('bth,bths->bts', w_idx.astype(jnp.float32), jax.nn.relu(dots))
    visible = jnp.arange(k_idx.shape[1])[None, :] <= q_pos[:, None]
    return jnp.where(visible[None], s, -jnp.inf)


def _select(scores, q_pos, topk):
    _, idx = lax.top_k(scores, topk)
    return idx, idx <= q_pos[None, :, None]


def _sparse_attend(q, k_sel, v_sel, valid):
    B, T = q.shape[:2]
    qg = q.reshape(B, T, N_KV_HEADS, GROUP_SIZE, HEAD_DIM).astype(jnp.float32)
    logits = jnp.einsum('btgrd,btkgd->btgrk', qg, k_sel.astype(jnp.float32)) * (HEAD_DIM ** -0.5)
    logits = jnp.where(valid[:, :, None, None, :], logits, -jnp.inf)
    p = jax.nn.softmax(logits, axis=-1)
    out = jnp.einsum('btgrk,btkgd->btgrd', p, v_sel.astype(jnp.float32))
    return out.reshape(B, T, N_HEADS * HEAD_DIM).astype(q.dtype)


def _prompt_attention(q, k, v, q_idx, k_idx, w_idx, pos):
    B, S = q.shape[:2]
    topk = min(TOPK_MAX, S // 4)
    nb = S // Q_BLOCK
    b_ix = jnp.arange(B)[:, None, None]

    def blockify(t):
        return jnp.moveaxis(t.reshape((B, nb, Q_BLOCK) + t.shape[2:]), 1, 0)

    def one_block(args):
        qb, qib, wb, pb = args
        idx, valid = _select(_indexer_scores(qib, wb, k_idx, pb), pb, topk)
        return _sparse_attend(qb, k[b_ix, idx], v[b_ix, idx], valid)

    out = lax.map(one_block, (blockify(q), blockify(q_idx), blockify(w_idx), pos.reshape(nb, Q_BLOCK)))
    return jnp.moveaxis(out, 0, 1).reshape(B, S, N_HEADS * HEAD_DIM)


def _sample_attention(q, k_new, v_new, q_idx, k_idx_new, w_idx, pos, cache_k, cache_v, cache_kidx, page_table):
    DB, T = q.shape[:2]
    past = page_table.shape[1] * PAGE_SIZE
    topk = min(TOPK_MAX, (past + T) // 4)
    kidx_past = cache_kidx[page_table].reshape(DB, past, IDX_DIM)
    kidx_all = jnp.concatenate([kidx_past, k_idx_new], axis=1)
    idx, valid = _select(_indexer_scores(q_idx, w_idx, kidx_all, pos), pos, topk)
    b_ix = jnp.arange(DB)[:, None, None]
    in_past = (idx < past)[..., None, None]
    p_pos = jnp.minimum(idx, past - 1)
    phys = page_table[b_ix, p_pos // PAGE_SIZE]
    slot = p_pos % PAGE_SIZE
    n_pos = jnp.clip(idx - past, 0, T - 1)
    k_sel = jnp.where(in_past, cache_k[phys, slot], k_new[b_ix, n_pos])
    v_sel = jnp.where(in_past, cache_v[phys, slot], v_new[b_ix, n_pos])
    return _sparse_attend(q, k_sel, v_sel, valid)


def _layer(x, pos, attend, ln1_g, ln1_b, ffn1_w_up, ffn1_w_down, ln2_g, ln2_b, w_in, a_ln_g, a_ln_b, a_ws, a_bs, w_out, ln3_g, ln3_b, ffn2_w_up, ffn2_w_down):
    x = _layernorm(ALPHA * x + 0.5 * _swiglu(x, ffn1_w_up, ffn1_w_down), ln1_g, ln1_b)
    u, va, q, k, v, qi, ki, wi = _mixer_inputs(x, w_in, pos)
    a_out, a_v = _chunk_gmlp(u, va, a_ln_g, a_ln_b, a_ws, a_bs)
    b_out = attend(q, k, v, qi, ki, wi, pos)
    mix = jnp.concatenate([a_out, b_out], axis=-1) @ w_out
    x = _layernorm(ALPHA * x + mix, ln2_g, ln2_b)
    x = _layernorm(ALPHA * x + 0.5 * _swiglu(x, ffn2_w_up, ffn2_w_down), ln3_g, ln3_b)
    return x, k, v, ki, a_v


def setup_inputs(seed: int = 0) -> dict:
    key = jax.random.key(seed)
    ks = jax.random.split(key, 26)
    n_pages = PAST_LEN // PAGE_SIZE
    n_pool = (5 * DEC_BATCH * n_pages) // 4
    f32 = jnp.float32

    def nrm(k, shape, scale=1.0):
        return jax.random.normal(k, shape, f32) * scale

    perm = jax.random.permutation(ks[5], n_pool)[:DEC_BATCH * n_pages]
    return {
        'x_prompt': nrm(ks[0], (BATCH, SEQ, D_MODEL)),
        'x_sample': nrm(ks[1], (DEC_BATCH, DEC_SEQ, D_MODEL)),
        'cache_k': nrm(ks[2], (DEPTH, n_pool, PAGE_SIZE, N_KV_HEADS, HEAD_DIM)),
        'cache_v': nrm(ks[3], (DEPTH, n_pool, PAGE_SIZE, N_KV_HEADS, HEAD_DIM)),
        'cache_kidx': nrm(ks[4], (DEPTH, n_pool, PAGE_SIZE, IDX_DIM)),
        'page_table': perm.reshape(DEC_BATCH, n_pages).astype(jnp.int32),
        'ln1_g': 1.0 + nrm(ks[6], (DEPTH, D_MODEL), 0.02),
        'ln1_b': nrm(ks[7], (DEPTH, D_MODEL), 0.02),
        'ffn1_w_up': nrm(ks[8], (DEPTH, D_MODEL, 2 * D_FF), D_MODEL ** -0.5),
        'ffn1_w_down': nrm(ks[9], (DEPTH, D_FF, D_MODEL), BETA * D_FF ** -0.5),
        'ln2_g': 1.0 + nrm(ks[10], (DEPTH, D_MODEL), 0.02),
        'ln2_b': nrm(ks[11], (DEPTH, D_MODEL), 0.02),
        'w_in': nrm(ks[12], (DEPTH, D_MODEL, IN_WIDTH), D_MODEL ** -0.5),
        'a_ln_g': 1.0 + nrm(ks[13], (DEPTH, A_WIDTH), 0.02),
        'a_ln_b': nrm(ks[14], (DEPTH, A_WIDTH), 0.02),
        'a_ws': nrm(ks[15], (DEPTH, A_GROUPS, CHUNK, CHUNK), CHUNK ** -0.5),
        'a_bs': 1.0 + nrm(ks[16], (DEPTH, A_GROUPS, CHUNK), 0.02),
        'w_out': nrm(ks[17], (DEPTH, MIX_WIDTH, D_MODEL), BETA * MIX_WIDTH ** -0.5),
        'ln3_g': 1.0 + nrm(ks[18], (DEPTH, D_MODEL), 0.02),
        'ln3_b': nrm(ks[19], (DEPTH, D_MODEL), 0.02),
        'ffn2_w_up': nrm(ks[20], (DEPTH, D_MODEL, 2 * D_FF), D_MODEL ** -0.5),
        'ffn2_w_down': nrm(ks[21], (DEPTH, D_FF, D_MODEL), BETA * D_FF ** -0.5),
    }


def reference(x_prompt, x_sample, cache_k, cache_v, cache_kidx, page_table, ln1_g, ln1_b, ffn1_w_up, ffn1_w_down, ln2_g, ln2_b, w_in, a_ln_g, a_ln_b, a_ws, a_bs, w_out, ln3_g, ln3_b, ffn2_w_up, ffn2_w_down):
    pos_p = jnp.arange(x_prompt.shape[1], dtype=jnp.int32)
    past = page_table.shape[1] * PAGE_SIZE
    pos_s = past + jnp.arange(x_sample.shape[1], dtype=jnp.int32)
    weights = (ln1_g, ln1_b, ffn1_w_up, ffn1_w_down, ln2_g, ln2_b, w_in, a_ln_g, a_ln_b, a_ws, a_bs, w_out, ln3_g, ln3_b, ffn2_w_up, ffn2_w_down)
    yp, ys = x_prompt, x_sample
    kp, vp, kip, ksm, vsm, kis, avs = [], [], [], [], [], [], []
    for l in range(DEPTH):
        lw = [w[l] for w in weights]
        yp, k1, v1, ki1, _ = _layer(yp, pos_p, _prompt_attention, *lw)
        attend_s = functools.partial(_sample_attention, cache_k=cache_k[l], cache_v=cache_v[l], cache_kidx=cache_kidx[l], page_table=page_table)
        ys, k2, v2, ki2, av2 = _layer(ys, pos_s, attend_s, *lw)
        kp.append(k1); vp.append(v1); kip.append(ki1)
        ksm.append(k2); vsm.append(v2); kis.append(ki2); avs.append(av2)
    return (yp, ys, jnp.stack(kp), jnp.stack(vp), jnp.stack(kip), jnp.stack(ksm), jnp.stack(vsm), jnp.stack(kis), jnp.stack(avs))
```

```cpp
#include <hip/hip_runtime.h>
#include <cstdio>
#include <cstdint>
namespace pg8 {
#define PG8_LAS __attribute__((address_space(3)))
typedef unsigned short bf16_t;
typedef short bf16x8 __attribute__((ext_vector_type(8)));
typedef float f32x4 __attribute__((ext_vector_type(4)));
typedef unsigned u32x4 __attribute__((ext_vector_type(4)));
constexpr int BM = 256, BK = 64, HALF = 128, HTB = HALF * BK * 2  , STAGE_BYTES = 8 * HTB, NXCD = 8, WGM = 8;

__host__ __device__ __forceinline__ int lds_byte(int r, int c) { const int st = (r >> 4) * 2 + (c >> 5), rr = r & 15, cc = c & 31, ob = rr * 64 + cc * 2; return st * 1024 + (ob ^ (((ob >> 9) & 1) << 5)); }
__host__ __device__ __forceinline__ void stage_rc(int b, int& R, int& C) { const int st = b / 1024, sb = b % 1024, swz = sb ^ (((sb >> 9) & 1) << 5); R = (st >> 1) * 16 + swz / 64; C = (st & 1) * 32 + (swz % 64) / 2; }
__host__ __device__ __forceinline__ int perm32(int rho) { const int n = rho >> 4, i = rho & 15; return 8 * (i >> 2) + 4 * n + (i & 3); }

struct Unit { int pm, pn; };
struct Gemm { const bf16_t* A; const bf16_t* Bt; int M, N, K; };

struct StaticOrder {
    int nM, nN, nwg, G, c;
    __host__ __device__ void init(int M, int N, int G_, int c_) { nM = M / BM; nN = N / BM; nwg = nM * nN; G = G_; c = c_; }
    __host__ __device__ bool next(int i, Unit& u) const {
        const long L = (long)i * G + c; if (L >= nwg) return false;
        int wgid = (int)L; { const int q = nwg / NXCD, r = nwg % NXCD, xcd = wgid % NXCD, off = wgid / NXCD; wgid = (xcd < r ? xcd * (q + 1) : r * (q + 1) + (xcd - r) * q) + off; }
        const int nig = WGM * nN, gid = wgid / nig, fm = gid * WGM, gsz = (nM - fm) < WGM ? (nM - fm) : WGM;
        u.pm = fm + ((wgid % nig) % gsz); u.pn = (wgid % nig) / gsz; return true;
    }
    __device__ __forceinline__ void a_ready(const Unit&) const {}
    __device__ __forceinline__ void done(const Unit&) const {}
};

__device__ __forceinline__ unsigned cvt_pk_bf16(float lo, float hi) { unsigned r; asm volatile("v_cvt_pk_bf16_f32 %0, %1, %2" : "=v"(r) : "v"(lo), "v"(hi)); return r; }
typedef float f32x2 __attribute__((ext_vector_type(2)));
struct PanelStats {
    unsigned* xbuf;
    unsigned* cnt;
    unsigned* tmo;
    int ntn; float eps;
    unsigned code;
    __device__ __forceinline__ bool run(const f32x4 (&v)[2][2][4][2], const Unit& u, int wr, int wc, int fr, int fq, PG8_LAS unsigned char* lds, int wid, int lane) const {
        typedef float f32x2v __attribute__((ext_vector_type(2)));
        PG8_LAS f32x2v* P = (PG8_LAS f32x2v*)lds;
        PG8_LAS f32x2v* S = (PG8_LAS f32x2v*)(lds + 8192);
        PG8_LAS unsigned* flag = (PG8_LAS unsigned*)(lds + 8192 + 2048);
#pragma unroll
        for (int ai = 0; ai < 2; ++ai)
#pragma unroll
            for (int m = 0; m < 4; ++m) {
                float s = 0.f;
#pragma unroll
                for (int bj = 0; bj < 2; ++bj)
#pragma unroll
                    for (int n = 0; n < 2; ++n) { const f32x4 x = v[ai][bj][m][n]; s += (x[0] + x[1]) + (x[2] + x[3]); }
                s += __shfl_xor(s, 16); s += __shfl_xor(s, 32);
                const float mw = s * (1.0f / 64.0f); float q = 0.f;
#pragma unroll
                for (int bj = 0; bj < 2; ++bj)
#pragma unroll
                    for (int n = 0; n < 2; ++n) { const f32x4 d = v[ai][bj][m][n] - mw; q += (d[0] * d[0] + d[1] * d[1]) + (d[2] * d[2] + d[3] * d[3]); }
                q += __shfl_xor(q, 16); q += __shfl_xor(q, 32);
                if (fq == 0) P[(ai * HALF + wr * 64 + m * 16 + fr) * 4 + wc] = (f32x2v){mw, q};
            }
        asm volatile("s_waitcnt lgkmcnt(0)" ::: "memory"); __builtin_amdgcn_s_barrier(); asm volatile("" ::: "memory");
#if defined(BROKEN_EXCHANGE_NO_WAIT)
#warning BROKEN CONTROL BUILD: the row-statistics exchange does not wait; results are wrong by design
        if (blockIdx.x >= 64) { const long long t0_ = clock64(); while (clock64() - t0_ < 60000) __builtin_amdgcn_s_sleep(8); }
#endif
        const int row = wid * 32 + (lane & 31);
        if (lane < 32) {
            const f32x2v a = P[row * 4 + 0], b = P[row * 4 + 1], c = P[row * 4 + 2], d = P[row * 4 + 3];
            const float mt = (a.x + b.x + c.x + d.x) * 0.25f;
            const float da = a.x - mt, db = b.x - mt, dc = c.x - mt, dd = d.x - mt;
            const float m2 = (a.y + b.y) + (c.y + d.y) + 64.0f * ((da * da + db * db) + (dc * dc + dd * dd));
            unsigned long long* slot = (unsigned long long*)xbuf + ((size_t)(u.pm * BM + row) * 4 + u.pn);
            __hip_atomic_store(slot, ((unsigned long long)__float_as_uint(m2) << 32) | __float_as_uint(mt), __ATOMIC_RELAXED, __HIP_MEMORY_SCOPE_AGENT);
        }
        asm volatile("s_waitcnt vmcnt(0)" ::: "memory");
        if (lane == 0) __hip_atomic_fetch_add(cnt + 64 * u.pm, 1u, __ATOMIC_RELAXED, __HIP_MEMORY_SCOPE_AGENT);
        if (wid == 0) {
            bool dead = false; const unsigned long long t0 = __builtin_amdgcn_s_memrealtime(); const unsigned want = 8u * (unsigned)ntn;
            for (;;) {
#if defined(BROKEN_EXCHANGE_NO_WAIT)
                break;
#endif
                if ((unsigned)__builtin_amdgcn_readfirstlane(__hip_atomic_load(cnt + 64 * u.pm, __ATOMIC_RELAXED, __HIP_MEMORY_SCOPE_AGENT)) >= want) break;
                if (__builtin_amdgcn_s_memrealtime() - t0 > 2000000ull) {
                    if (lane == 0) { unsigned expect = 0u; __hip_atomic_compare_exchange_strong(tmo + 1, &expect, code | (unsigned)(u.pm & 0xff), __ATOMIC_RELAXED, __ATOMIC_RELAXED, __HIP_MEMORY_SCOPE_AGENT);
                                     __hip_atomic_store(tmo, 1u, __ATOMIC_RELAXED, __HIP_MEMORY_SCOPE_AGENT); }
                    dead = true; break; }
                __builtin_amdgcn_s_sleep(2);
            }
            __builtin_amdgcn_fence(__ATOMIC_ACQUIRE, "agent");
            if (lane == 0) flag[0] = dead ? 1u : 0u;
        }
        asm volatile("s_waitcnt vmcnt(0) lgkmcnt(0)" ::: "memory"); __builtin_amdgcn_s_barrier(); asm volatile("" ::: "memory");
        const bool bad = flag[0] != 0u;
        if (lane < 32) {
            const unsigned long long* slot = (const unsigned long long*)xbuf + (size_t)(u.pm * BM + row) * 4; float mt[4], m2[4]; float ms = 0.f;
#pragma unroll
            for (int t = 0; t < 4; ++t) { if (t < ntn) { const unsigned long long w = __hip_atomic_load(slot + t, __ATOMIC_RELAXED, __HIP_MEMORY_SCOPE_AGENT); mt[t] = __uint_as_float((unsigned)w); m2[t] = __uint_as_float((unsigned)(w >> 32)); } else { mt[t] = 0.f; m2[t] = 0.f; } ms += mt[t]; }
            const float mean = ms / (float)ntn; float q = 0.f;
#pragma unroll
            for (int t = 0; t < 4; ++t) if (t < ntn) { const float dm = mt[t] - mean; q += m2[t] + 256.0f * dm * dm; }
            S[row] = (f32x2v){mean, 1.0f / sqrtf(q / (256.0f * (float)ntn) + eps)};
        }
        asm volatile("s_waitcnt lgkmcnt(0)" ::: "memory"); __builtin_amdgcn_s_barrier(); asm volatile("" ::: "memory");
        return bad;
    }
};
template <class Epi, class Sched, bool ALIGN_EPI = false, bool SP2 = false, bool HALF_N = false>
__device__ __forceinline__ void gemm_phase(PG8_LAS unsigned char* lds, const Gemm g, const Sched& S, const Epi& E) {
    const int tid = threadIdx.x, wid = __builtin_amdgcn_readfirstlane(tid >> 6), lane = tid & 63, wr = wid >> 2, wc = wid & 3, fr = lane & 15, fq = lane >> 4;
    const int K = g.K, nt = K / BK;
    unsigned voffA[2], voffB[2];
#pragma unroll
    for (int i = 0; i < 2; ++i) { int R, C; stage_rc(tid * 16 + i * 8192, R, C); const int Rb = Epi::PERM ? ((R & ~31) + perm32(R & 31)) : R;
        voffA[i] = (unsigned)(R * K + C) * 2u; voffB[i] = (unsigned)(Rb * K + C) * 2u; }
    const size_t kstep = (size_t)(BK * 2);
    const size_t hstep = (size_t)HALF * K * 2;
    const size_t tstep = 2 * hstep;
    const unsigned ldsw = (unsigned)wid * 1024u;
    const int aoff = lds_byte(wr * 64 + fr, fq * 8), boff = lds_byte(wc * 32 + fr, fq * 8);
#define PG8_SA(b, h) (((b) * 2 + (h)) * HTB)
#define PG8_SB(b, h) ((4 + (b) * 2 + (h)) * HTB)
#define PG8_STAGE(bufoff, gbase, voff) do { _Pragma("unroll") for (int _i = 0; _i < 2; ++_i) \
        __builtin_amdgcn_global_load_lds((const unsigned*)((const char*)(gbase) + (voff)[_i]), (PG8_LAS unsigned*)(lds + (bufoff) + ldsw + _i * 8192), 16, 0, 0); } while (0)
#define PG8_LDA(dst, b, h) do { _Pragma("unroll") for (int m = 0; m < 4; ++m) _Pragma("unroll") for (int k = 0; k < 2; ++k) dst[m][k] = *(const PG8_LAS bf16x8*)(lds + PG8_SA(b, h) + aoff + m * 2048 + k * 1024); } while (0)
#define PG8_LDB(dst, b, h) do { _Pragma("unroll") for (int n = 0; n < 2; ++n) _Pragma("unroll") for (int k = 0; k < 2; ++k) dst[n][k] = *(const PG8_LAS bf16x8*)(lds + PG8_SB(b, h) + boff + n * 2048 + k * 1024); } while (0)
#define PG8_MMA(ai, bj, At, Bt) do { __builtin_amdgcn_s_setprio(1); _Pragma("unroll") for (int m = 0; m < 4; ++m) _Pragma("unroll") for (int n = 0; n < 2; ++n) _Pragma("unroll") for (int k = 0; k < 2; ++k) \
        acc[ai][bj][m][n] = __builtin_amdgcn_mfma_f32_16x16x32_bf16(Bt[n][k], At[m][k], acc[ai][bj][m][n], 0, 0, 0); __builtin_amdgcn_s_setprio(0); } while (0)
#define PG8_WAIT_V(n) asm volatile("s_waitcnt vmcnt(" #n ")" ::: "memory")
#define PG8_WAIT_L(n) asm volatile("s_waitcnt lgkmcnt(" #n ")" ::: "memory")
#define PG8_BAR __builtin_amdgcn_s_barrier()
#define PG8_SCHED __builtin_amdgcn_sched_barrier(0)
    Unit cur, nxt; int ui = 0;
    if (!S.next(0, cur)) return;
    f32x4 acc[2][2][4][2];
#pragma unroll
    for (int a = 0; a < 2; ++a)
#pragma unroll
        for (int b = 0; b < 2; ++b)
#pragma unroll
            for (int m = 0; m < 4; ++m)
#pragma unroll
                for (int n = 0; n < 2; ++n) acc[a][b][m][n] = (f32x4){0.f, 0.f, 0.f, 0.f};
    bf16x8 At[4][2], B0[2][2], B1[2][2];
    const char* cA = (const char*)g.A + (size_t)cur.pm * tstep; const char* cB = (const char*)g.Bt + (size_t)cur.pn * tstep;
    S.a_ready(cur);
    if constexpr (SP2) {
        PG8_STAGE(PG8_SB(0, 0), cB, voffB); PG8_STAGE(PG8_SB(0, 1), cB + hstep, voffB); PG8_STAGE(PG8_SA(0, 0), cA, voffA); PG8_STAGE(PG8_SA(0, 1), cA + hstep, voffA);
        if (wr == 1) PG8_BAR;
        PG8_WAIT_V(2); PG8_BAR;
        PG8_STAGE(PG8_SB(1, 0), cB + kstep, voffB); PG8_STAGE(PG8_SA(1, 0), cA + kstep, voffA); PG8_STAGE(PG8_SB(1, 1), cB + hstep + kstep, voffB);
        PG8_WAIT_V(6); PG8_BAR;
    } else {
        PG8_STAGE(PG8_SB(0, 0), cB, voffB); PG8_STAGE(PG8_SA(0, 0), cA, voffA); PG8_STAGE(PG8_SB(0, 1), cB + hstep, voffB); PG8_STAGE(PG8_SA(0, 1), cA + hstep, voffA);
        if (wr == 1) PG8_BAR;
        PG8_WAIT_V(4); PG8_BAR;
        PG8_STAGE(PG8_SB(1, 0), cB + kstep, voffB); PG8_STAGE(PG8_SA(1, 0), cA + kstep, voffA); PG8_STAGE(PG8_SB(1, 1), cB + hstep + kstep, voffB);
        PG8_WAIT_V(6); PG8_BAR;
    }
    for (;;) {
        const bool has_next = S.next(ui + 1, nxt);
        const char* nA = has_next ? (const char*)g.A + (size_t)nxt.pm * tstep : cA; const char* nB = has_next ? (const char*)g.Bt + (size_t)nxt.pn * tstep : cB;
        for (int t = 0; t < nt; t += 2) {
            const bool last = (t == nt - 2);
            const char* a1 = cA + (size_t)(t + 1) * kstep;
            const char* a2 = last ? nA : cA + (size_t)(t + 2) * kstep; const char* b2 = last ? nB : cB + (size_t)(t + 2) * kstep;
            const char* a3 = a2 + kstep; const char* b3 = b2 + kstep;
            if (last && has_next) S.a_ready(nxt);
            if constexpr (SP2) {
            PG8_LDB(B0, 0, 0); if constexpr (!HALF_N) PG8_LDB(B1, 0, 1); PG8_SCHED; PG8_LDA(At, 0, 0); PG8_STAGE(PG8_SA(1, 1), a1 + hstep, voffA);
            PG8_WAIT_V(8); PG8_WAIT_L(0); PG8_BAR; PG8_MMA(0, 0, At, B0); if constexpr (!HALF_N) PG8_MMA(0, 1, At, B1); PG8_BAR; PG8_SCHED;
            PG8_LDA(At, 0, 1); PG8_STAGE(PG8_SB(0, 0), b2, voffB); PG8_STAGE(PG8_SB(0, 1), b2 + hstep, voffB); PG8_STAGE(PG8_SA(0, 0), a2, voffA);
            PG8_WAIT_V(8); PG8_WAIT_L(0); PG8_BAR; PG8_MMA(1, 0, At, B0); if constexpr (!HALF_N) PG8_MMA(1, 1, At, B1); PG8_BAR; PG8_SCHED;
            PG8_LDB(B0, 1, 0); if constexpr (!HALF_N) PG8_LDB(B1, 1, 1); PG8_SCHED; PG8_LDA(At, 1, 0); PG8_STAGE(PG8_SA(0, 1), a2 + hstep, voffA);
            PG8_WAIT_V(8); PG8_WAIT_L(0); PG8_BAR; PG8_MMA(0, 0, At, B0); if constexpr (!HALF_N) PG8_MMA(0, 1, At, B1); PG8_BAR; PG8_SCHED;
            PG8_LDA(At, 1, 1); PG8_STAGE(PG8_SB(1, 0), b3, voffB); PG8_STAGE(PG8_SB(1, 1), b3 + hstep, voffB); PG8_STAGE(PG8_SA(1, 0), a3, voffA);
            PG8_WAIT_V(8); PG8_WAIT_L(0); PG8_BAR; PG8_MMA(1, 0, At, B0); if constexpr (!HALF_N) PG8_MMA(1, 1, At, B1); PG8_BAR; PG8_SCHED;
            } else {
            PG8_LDB(B0, 0, 0); PG8_SCHED; PG8_LDA(At, 0, 0); PG8_STAGE(PG8_SA(1, 1), a1 + hstep, voffA);
            PG8_WAIT_L(8); PG8_BAR; PG8_WAIT_L(0); PG8_MMA(0, 0, At, B0); PG8_BAR; PG8_SCHED;
            PG8_LDB(B1, 0, 1); PG8_STAGE(PG8_SB(0, 0), b2, voffB);
            PG8_BAR; PG8_WAIT_L(0); PG8_MMA(0, 1, At, B1); PG8_BAR;
            PG8_LDA(At, 0, 1); PG8_STAGE(PG8_SA(0, 0), a2, voffA);
            PG8_BAR; PG8_WAIT_L(0); PG8_MMA(1, 0, At, B0); PG8_BAR; PG8_SCHED;
            PG8_STAGE(PG8_SB(0, 1), b2 + hstep, voffB);
            PG8_WAIT_V(6); PG8_BAR; PG8_MMA(1, 1, At, B1); PG8_BAR;
            PG8_LDB(B0, 1, 0); PG8_SCHED; PG8_LDA(At, 1, 0); PG8_STAGE(PG8_SA(0, 1), a2 + hstep, voffA);
            PG8_WAIT_L(8); PG8_BAR; PG8_WAIT_L(0); PG8_MMA(0, 0, At, B0); PG8_BAR; PG8_SCHED;
            PG8_LDB(B1, 1, 1); PG8_STAGE(PG8_SB(1, 0), b3, voffB);
            PG8_BAR; PG8_WAIT_L(0); PG8_MMA(0, 1, At, B1); PG8_BAR;
            PG8_LDA(At, 1, 1); PG8_STAGE(PG8_SA(1, 0), a3, voffA);
            PG8_BAR; PG8_WAIT_L(0); PG8_MMA(1, 0, At, B0); PG8_BAR; PG8_SCHED;
            PG8_STAGE(PG8_SB(1, 1), b3 + hstep, voffB);
            PG8_WAIT_V(6); PG8_BAR; PG8_MMA(1, 1, At, B1); PG8_BAR;
            }
        }
        if constexpr (ALIGN_EPI) { if (wr == 0) PG8_BAR; }
        if constexpr (!Epi::AFTER_DRAIN) { E(acc, cur, wr, wc, fr, fq); S.done(cur); }
        if (!has_next) break;
#pragma unroll
        for (int a = 0; a < 2; ++a)
#pragma unroll
            for (int b = 0; b < 2; ++b)
#pragma unroll
                for (int m = 0; m < 4; ++m)
#pragma unroll
                    for (int n = 0; n < 2; ++n) acc[a][b][m][n] = (f32x4){0.f, 0.f, 0.f, 0.f};
        cur = nxt; cA = nA; cB = nB; ++ui;
        if constexpr (ALIGN_EPI) { if (wr == 1) PG8_BAR; }
    }
    PG8_WAIT_V(0);
    if constexpr (!ALIGN_EPI) { if (wr == 0) PG8_BAR; }
    PG8_BAR;
    if constexpr (Epi::AFTER_DRAIN) { E.fused(acc, cur, wr, wc, fr, fq, lds, wid, lane); S.done(cur); }
#undef PG8_SA
#undef PG8_SB
#undef PG8_STAGE
#undef PG8_LDA
#undef PG8_LDB
#undef PG8_MMA
#undef PG8_WAIT_V
#undef PG8_WAIT_L
#undef PG8_BAR
#undef PG8_SCHED
}
}
namespace pg8 {
typedef unsigned u32x2 __attribute__((ext_vector_type(2)));
constexpr float kAlpha = 1.189207115002721f;
__device__ __forceinline__ float silu_f(float x) { return x * __builtin_amdgcn_rcpf(1.f + __builtin_amdgcn_exp2f(-1.4426950408889634f * x)); }
__device__ __forceinline__ float gelu_f(float x) { const float t = x * (1.f + 0.044715f * x * x); return x * __builtin_amdgcn_rcpf(1.f + __builtin_amdgcn_exp2f(-2.3022081981f * t)); }
__device__ __forceinline__ u32x4 pack8(const f32x4 a, const f32x4 b) { u32x4 w; w.x = cvt_pk_bf16(a[0], a[1]); w.y = cvt_pk_bf16(a[2], a[3]); w.z = cvt_pk_bf16(b[0], b[1]); w.w = cvt_pk_bf16(b[2], b[3]); return w; }
__device__ __forceinline__ f32x4 unpack4(const u32x2 w) { f32x4 r; r[0] = __uint_as_float(w.x << 16); r[1] = __uint_as_float(w.x & 0xffff0000u); r[2] = __uint_as_float(w.y << 16); r[3] = __uint_as_float(w.y & 0xffff0000u); return r; }

__device__ __forceinline__ void row_stats4(const float* st, size_t row, float& mean, float& rstd) {
    const f32x4 a = *(const f32x4*)(st + row * 8), b = *(const f32x4*)(st + row * 8 + 4);
    mean = ((a[0] + a[2]) + (b[0] + b[2])) * 0.25f;
    const float d0 = a[0] - mean, d1 = a[2] - mean, d2 = b[0] - mean, d3 = b[2] - mean;
    const float m2 = ((a[1] + a[3]) + (b[1] + b[3])) + 256.f * ((d0 * d0 + d1 * d1) + (d2 * d2 + d3 * d3));
    rstd = 1.0f / sqrtf(m2 * (1.f / 1024.f) + 1e-5f);
}
__device__ __forceinline__ void stats_from(const f32x4 a, const f32x4 b, float& mean, float& rstd) {
    mean = ((a[0] + a[2]) + (b[0] + b[2])) * 0.25f;
    const float d0 = a[0] - mean, d1 = a[2] - mean, d2 = b[0] - mean, d3 = b[2] - mean;
    rstd = 1.0f / sqrtf((((a[1] + a[3]) + (b[1] + b[3])) + 256.f * ((d0 * d0 + d1 * d1) + (d2 * d2 + d3 * d3))) * (1.f / 1024.f) + 1e-5f);
}
typedef float f32x2t __attribute__((ext_vector_type(2)));
__device__ __forceinline__ void panel_stats_to_lds(const float* st, int pm, PG8_LAS f32x2t* T, int tid) {
    if (tid < 256) { const size_t row = (size_t)(pm * BM + tid); float mean, rstd; stats_from(*(const f32x4*)(st + row * 8), *(const f32x4*)(st + row * 8 + 4), mean, rstd); T[tid] = (f32x2t){mean, rstd}; }
    asm volatile("s_waitcnt lgkmcnt(0)" ::: "memory"); __builtin_amdgcn_s_barrier(); asm volatile("" ::: "memory");
}
__device__ __forceinline__ void fold_ln(f32x4 (&acc)[2][2][4][2], const float* st, const float* c1, const float* c2, const Unit& u, int wr, int wc, int fr, int fq, unsigned tlds) {
    PG8_LAS f32x2t* T = (PG8_LAS f32x2t*)(size_t)tlds;
    const int rl0 = wr * 64 + fr, col0 = u.pn * BM + wc * 32 + 8 * fq;
    f32x4 c1v[2][2], c2v[2][2];
#pragma unroll
    for (int bj = 0; bj < 2; ++bj)
#pragma unroll
        for (int n = 0; n < 2; ++n) { c1v[bj][n] = *(const f32x4*)(c1 + col0 + bj * HALF + 4 * n); c2v[bj][n] = *(const f32x4*)(c2 + col0 + bj * HALF + 4 * n); }
    __builtin_amdgcn_sched_barrier(0);
    panel_stats_to_lds(st, u.pm, T, (wr * 4 + wc) * 64 + fq * 16 + fr);
#pragma unroll
    for (int ai = 0; ai < 2; ++ai)
#pragma unroll
        for (int m = 0; m < 4; ++m) { const f32x2t t = T[ai * HALF + m * 16 + rl0]; const float tq = -t.y * t.x;
#pragma unroll
            for (int bj = 0; bj < 2; ++bj)
#pragma unroll
                for (int n = 0; n < 2; ++n) acc[ai][bj][m][n] = acc[ai][bj][m][n] * t.y + (c1v[bj][n] * tq + c2v[bj][n]); }
}

template <int RESMODE, bool HALFACC> struct EpiZ {
    static constexpr bool PERM = true, AFTER_DRAIN = false;
    const bf16_t* res; const float* stprev; const float* gamma; const float* beta; bf16_t* Z; float* ST; unsigned xlds; static constexpr float racc = HALFACC ? 0.5f : 1.0f;
    __device__ __forceinline__ void operator()(f32x4 (&acc)[2][2][4][2], const Unit& u, int wr, int wc, int fr, int fq) const {
        asm volatile("" : "+v"(fr), "+v"(fq));
        typedef float f32x2v __attribute__((ext_vector_type(2)));
        PG8_LAS f32x2v* P = (PG8_LAS f32x2v*)(size_t)xlds;
        const int rl0 = wr * 64 + fr, col0 = u.pn * BM + wc * 32 + 8 * fq;
        PG8_LAS f32x2t* T = (PG8_LAS f32x2t*)(size_t)(xlds + 8192);
        if (RESMODE == 1) panel_stats_to_lds(stprev, u.pm, T, (wr * 4 + wc) * 64 + fq * 16 + fr);
#pragma unroll
        for (int ai = 0; ai < 2; ++ai) {
            u32x4 raw[4][2];
#pragma unroll
            for (int m = 0; m < 4; ++m) { const size_t off = (size_t)(u.pm * BM + ai * HALF + m * 16 + rl0) * 1024 + col0;
                raw[m][0] = *(const u32x4*)(res + off); raw[m][1] = *(const u32x4*)(res + off + HALF); }
            __builtin_amdgcn_sched_barrier(0);
#pragma unroll
            for (int m = 0; m < 4; ++m) { const int rl = ai * HALF + m * 16 + rl0; const size_t off = (size_t)(u.pm * BM + rl) * 1024 + col0;
                float mu = 0.f, rs = 1.f; if (RESMODE == 1) { const f32x2t t = T[rl]; mu = t.x; rs = t.y; }
                float s = 0.f, q = 0.f;
#pragma unroll
                for (int bj = 0; bj < 2; ++bj) { const u32x4 rw = raw[m][bj];
                    f32x4 r0 = unpack4((u32x2){rw.x, rw.y}), r1 = unpack4((u32x2){rw.z, rw.w});
                    if (RESMODE == 1) { const float* gp = gamma + col0 + bj * HALF; const float* bp = beta + col0 + bj * HALF;
                        r0 = (r0 - mu) * rs * *(const f32x4*)gp + *(const f32x4*)bp; r1 = (r1 - mu) * rs * *(const f32x4*)(gp + 4) + *(const f32x4*)(bp + 4); }
                    const f32x4 z0 = r0 * kAlpha + acc[ai][bj][m][0] * racc, z1 = r1 * kAlpha + acc[ai][bj][m][1] * racc;
                    *(u32x4*)(Z + off + bj * HALF) = pack8(z0, z1);
#pragma unroll
                    for (int i = 0; i < 4; ++i) { s += z0[i] + z1[i]; q += z0[i] * z0[i] + z1[i] * z1[i]; } }
                s += __shfl_xor(s, 16); s += __shfl_xor(s, 32); q += __shfl_xor(q, 16); q += __shfl_xor(q, 32);
                const float mw = s * (1.0f / 64.0f); q = fmaxf(q - s * mw, 0.f);
                if (fq == 0) P[rl * 4 + wc] = (f32x2v){mw, q}; }
            asm volatile("" ::: "memory"); }
        asm volatile("s_waitcnt lgkmcnt(0)" ::: "memory"); __builtin_amdgcn_s_barrier(); asm volatile("" ::: "memory");
        const int tid = (wr * 4 + wc) * 64 + fq * 16 + fr;
        if (tid < 256) { const f32x2v a = P[tid * 4 + 0], b = P[tid * 4 + 1], c = P[tid * 4 + 2], d = P[tid * 4 + 3];
            const float mt = ((a.x + b.x) + (c.x + d.x)) * 0.25f; const float da = a.x - mt, db = b.x - mt, dc = c.x - mt, dd = d.x - mt;
            const float m2 = ((a.y + b.y) + (c.y + d.y)) + 64.0f * ((da * da + db * db) + (dc * dc + dd * dd));
            *(f32x2v*)(ST + ((size_t)(u.pm * BM + tid) * 4 + u.pn) * 2) = (f32x2v){mt, m2}; }
        asm volatile("s_waitcnt lgkmcnt(0)" ::: "memory"); __builtin_amdgcn_s_barrier(); asm volatile("" ::: "memory");
    }
};

template <bool FOLD> struct EpiSwiGLU {
    static constexpr bool PERM = true, AFTER_DRAIN = false;
    bf16_t* H; int ldh; const float* st; const float* c1; const float* c2; unsigned tlds;
    __device__ __forceinline__ void operator()(f32x4 (&acc)[2][2][4][2], const Unit& u, int wr, int wc, int fr, int fq) const {
        asm volatile("" : "+v"(fr), "+v"(fq));
        const int row0 = u.pm * BM + wr * 64 + fr, col0 = u.pn * HALF + wc * 32 + 8 * fq;
        if (FOLD) fold_ln(acc, st, c1, c2, u, wr, wc, fr, fq, tlds);
#ifdef PROBE_EPI2
#pragma unroll 1
        for (int rep = 0; rep < 2; ++rep)
#endif
#pragma unroll
        for (int ai = 0; ai < 2; ++ai)
#pragma unroll
            for (int m = 0; m < 4; ++m) {
                f32x4 h0, h1;
#pragma unroll
                for (int i = 0; i < 4; ++i) { h0[i] = silu_f(acc[ai][0][m][0][i]) * acc[ai][1][m][0][i]; h1[i] = silu_f(acc[ai][0][m][1][i]) * acc[ai][1][m][1][i]; }
                *(u32x4*)(H + (size_t)(row0 + ai * HALF + m * 16) * ldh + col0) = pack8(h0, h1);
            }
    }
};

template <bool OUT_F32, bool RES_F32> struct EpiLn {
    static constexpr bool PERM = false, AFTER_DRAIN = true;
    const void* res; float racc; const float* gamma; const float* beta; void* out; PanelStats st; unsigned poison; const float* rst; const float* rgamma; const float* rbeta;
    __device__ __forceinline__ void fused(f32x4 (&acc)[2][2][4][2], const Unit& u, int wr, int wc, int fr, int fq, PG8_LAS unsigned char* lds, int wid, int lane) const {
        asm volatile("" : "+v"(fr), "+v"(fq));
        typedef float f32x2v __attribute__((ext_vector_type(2)));
        const PG8_LAS f32x2v* S = (const PG8_LAS f32x2v*)(lds + 8192);
        const int col0 = u.pn * BM + wc * 32 + 4 * fq;
        PG8_LAS f32x2t* T = (PG8_LAS f32x2t*)(lds + 16384);
        if (!RES_F32) panel_stats_to_lds(rst, u.pm, T, wid * 64 + lane);
#pragma unroll
        for (int ai = 0; ai < 2; ++ai) {
            u32x2 raw[4][2][2];
            if (!RES_F32) {
#pragma unroll
                for (int m = 0; m < 4; ++m) { const size_t rowg = (size_t)(u.pm * BM + ai * HALF + wr * 64 + m * 16 + fr); const size_t off = rowg * 1024 + col0;
#pragma unroll
                    for (int bj = 0; bj < 2; ++bj)
#pragma unroll
                        for (int n = 0; n < 2; ++n) raw[m][bj][n] = *(const u32x2*)((const bf16_t*)res + off + bj * HALF + n * 16); }
                __builtin_amdgcn_sched_barrier(0);
            }
#pragma unroll
            for (int m = 0; m < 4; ++m) { const size_t rowg = (size_t)(u.pm * BM + ai * HALF + wr * 64 + m * 16 + fr); const size_t off = rowg * 1024 + col0;
                float mu = 0.f, rs = 1.f; if (!RES_F32) { const f32x2t t = T[ai * HALF + wr * 64 + m * 16 + fr]; mu = t.x; rs = t.y; }
#pragma unroll
                for (int bj = 0; bj < 2; ++bj)
#pragma unroll
                    for (int n = 0; n < 2; ++n) { f32x4 r;
                        if (RES_F32) r = *(const f32x4*)((const float*)res + off + bj * HALF + n * 16);
                        else r = (unpack4(raw[m][bj][n]) - mu) * rs * *(const f32x4*)(rgamma + col0 + bj * HALF + n * 16) + *(const f32x4*)(rbeta + col0 + bj * HALF + n * 16);
                        acc[ai][bj][m][n] = r * kAlpha + acc[ai][bj][m][n] * racc; }
                asm volatile("" : "+v"(acc[ai][0][m][0]), "+v"(acc[ai][0][m][1]), "+v"(acc[ai][1][m][0]), "+v"(acc[ai][1][m][1]));
                if (RES_F32 && (m & 1)) asm volatile("" ::: "memory"); }
            asm volatile("" ::: "memory");
        }
        const bool bad = st.run(acc, u, wr, wc, fr, fq, lds, wid, lane) || poison != 0u;
        const float qnan = __builtin_nanf("");
#pragma unroll
        for (int ai = 0; ai < 2; ++ai)
#pragma unroll
            for (int m = 0; m < 4; ++m) { const int r = ai * HALF + wr * 64 + m * 16 + fr; const f32x2v sr = S[r]; const size_t off = (size_t)(u.pm * BM + r) * 1024 + col0;
#pragma unroll
                for (int bj = 0; bj < 2; ++bj)
#pragma unroll
                    for (int n = 0; n < 2; ++n) { const f32x4 gv = *(const f32x4*)(gamma + col0 + bj * HALF + n * 16), bv = *(const f32x4*)(beta + col0 + bj * HALF + n * 16);
                        f32x4 o = (acc[ai][bj][m][n] - sr.x) * sr.y * gv + bv;
                        if (bad) o = (f32x4){qnan, qnan, qnan, qnan};
                        if (OUT_F32) *(f32x4*)((float*)out + off + bj * HALF + n * 16) = o;
                        else { u32x2 w; w.x = cvt_pk_bf16(o[0], o[1]); w.y = cvt_pk_bf16(o[2], o[3]); *(u32x2*)((bf16_t*)out + off + bj * HALF + n * 16) = w; } }
                asm volatile("" ::: "memory"); }
    }
};

struct EpiWin {
    static constexpr bool PERM = true, AFTER_DRAIN = false;
    bf16_t *U, *GV, *Q, *Kb, *VT, *QI, *KI; float *GVST, *WI, *outK, *outV, *outKI; const float *ropeC, *ropeS; const float *st, *c1, *c2; unsigned tlds; int pn_off;
    __device__ __forceinline__ void operator()(f32x4 (&acc)[2][2][4][2], const Unit& u, int wr, int wc, int fr, int fq) const {
        asm volatile("" : "+v"(fr), "+v"(fq));
        const int pn = u.pn + pn_off, rl0 = wr * 64 + fr, rowb = u.pm * BM + rl0, cl = wc * 32 + 8 * fq;
        const int j0 = 4 * (4 * (wc & 1) + fq);
        PG8_LAS f32x2t* T = (PG8_LAS f32x2t*)(size_t)tlds;
        panel_stats_to_lds(st, u.pm, T, (wr * 4 + wc) * 64 + fq * 16 + fr);
        const float* c1p = c1 + pn * BM + cl; const float* c2p = c2 + pn * BM + cl;
#define WIN_ROW(ai, m) const f32x2t tr_ = T[(ai) * HALF + (m) * 16 + rl0]; const float tq_ = -tr_.y * tr_.x
#define WIN_F(ai, bj, m, n) (acc[ai][bj][m][n] * tr_.y + (*(const f32x4*)(c1p + (bj) * HALF + 4 * (n)) * tq_ + *(const f32x4*)(c2p + (bj) * HALF + 4 * (n))))
        if (pn < 2) {
#pragma unroll
            for (int ai = 0; ai < 2; ++ai)
#pragma unroll
                for (int m = 0; m < 4; ++m) { WIN_ROW(ai, m); bf16_t* p = U + (size_t)(rowb + ai * HALF + m * 16) * 512 + pn * 256 + cl;
#pragma unroll
                    for (int bj = 0; bj < 2; ++bj) { const f32x4 x0 = WIN_F(ai, bj, m, 0), x1 = WIN_F(ai, bj, m, 1); f32x4 a, b;
#pragma unroll
                        for (int i = 0; i < 4; ++i) { a[i] = gelu_f(x0[i]); b[i] = gelu_f(x1[i]); }
                        *(u32x4*)(p + bj * HALF) = pack8(a, b); } }
        } else if (pn < 4) {
#pragma unroll
            for (int ai = 0; ai < 2; ++ai)
#pragma unroll
                for (int m = 0; m < 4; ++m) { WIN_ROW(ai, m); const size_t row = (size_t)(rowb + ai * HALF + m * 16); bf16_t* p = GV + row * 512 + (pn - 2) * 256 + cl;
                    f32x4 g[2][2]; float s = 0.f;
#pragma unroll
                    for (int bj = 0; bj < 2; ++bj) {
#pragma unroll
                        for (int n = 0; n < 2; ++n) { const f32x4 x = WIN_F(ai, bj, m, n);
#pragma unroll
                            for (int i = 0; i < 4; ++i) { g[bj][n][i] = gelu_f(x[i]); s += g[bj][n][i]; } }
                        *(u32x4*)(p + bj * HALF) = pack8(g[bj][0], g[bj][1]); }
                    s += __shfl_xor(s, 16); s += __shfl_xor(s, 32);
                    const float mw = s * (1.0f / 64.0f); float q = 0.f;
#pragma unroll
                    for (int bj = 0; bj < 2; ++bj)
#pragma unroll
                        for (int n = 0; n < 2; ++n)
#pragma unroll
                            for (int i = 0; i < 4; ++i) { const float d = g[bj][n][i] - mw; q += d * d; }
                    q += __shfl_xor(q, 16); q += __shfl_xor(q, 32);
                    if (fq == 0) *(f32x2t*)(GVST + ((row * 2 + (pn - 2)) * 4 + wc) * 2) = (f32x2t){mw, q}; }
        } else if (pn == 4 || pn == 5 || pn == 7) {
            bf16_t* dst = (pn == 7) ? QI : Q + (pn - 4) * 256; const int ld = (pn == 7) ? 256 : 512;
#pragma unroll
            for (int ai = 0; ai < 2; ++ai)
#pragma unroll
                for (int m = 0; m < 4; ++m) { WIN_ROW(ai, m); const int row = rowb + ai * HALF + m * 16; const int t = row & 2047;
                    const f32x4 c = *(const f32x4*)(ropeC + t * 32 + j0), s = *(const f32x4*)(ropeS + t * 32 + j0);
#pragma unroll
                    for (int bj = 0; bj < 2; ++bj) { const f32x4 x1 = WIN_F(ai, bj, m, 0), x2 = WIN_F(ai, bj, m, 1);
                        *(u32x4*)(dst + (size_t)row * ld + bj * HALF + cl) = pack8(x1 * c - x2 * s, x2 * c + x1 * s); } }
        } else if (pn == 6) {
#pragma unroll
            for (int ai = 0; ai < 2; ++ai)
#pragma unroll
                for (int m = 0; m < 4; ++m) { WIN_ROW(ai, m); const int row = rowb + ai * HALF + m * 16; const int t = row & 2047;
                    const f32x4 c = *(const f32x4*)(ropeC + t * 32 + j0), s = *(const f32x4*)(ropeS + t * 32 + j0);
                    const f32x4 x1 = WIN_F(ai, 0, m, 0), x2 = WIN_F(ai, 0, m, 1); const f32x4 o1 = x1 * c - x2 * s, o2 = x2 * c + x1 * s;
                    *(u32x4*)(Kb + (size_t)row * 128 + cl) = pack8(o1, o2);
                    float* ok = outK + (size_t)row * 128 + (wc >> 1) * 64 + j0; *(f32x4*)ok = o1; *(f32x4*)(ok + 32) = o2;
                    const f32x4 v0 = WIN_F(ai, 1, m, 0), v1 = WIN_F(ai, 1, m, 1);
                    float* ov = outV + (size_t)row * 128 + cl; *(f32x4*)ov = v0; *(f32x4*)(ov + 4) = v1;
                    bf16_t* vt = VT + ((size_t)((row >> 11) * 2 + (wc >> 1)) * 64 + (cl & 63)) * 2048 + t;
                    const u32x4 w = pack8(v0, v1);
                    vt[0 * 2048] = (bf16_t)(w.x & 0xffff); vt[1 * 2048] = (bf16_t)(w.x >> 16); vt[2 * 2048] = (bf16_t)(w.y & 0xffff); vt[3 * 2048] = (bf16_t)(w.y >> 16);
                    vt[4 * 2048] = (bf16_t)(w.z & 0xffff); vt[5 * 2048] = (bf16_t)(w.z >> 16); vt[6 * 2048] = (bf16_t)(w.w & 0xffff); vt[7 * 2048] = (bf16_t)(w.w >> 16); }
        } else {
            if (wc < 2) {
#pragma unroll
                for (int ai = 0; ai < 2; ++ai)
#pragma unroll
                    for (int m = 0; m < 4; ++m) { WIN_ROW(ai, m); const int row = rowb + ai * HALF + m * 16; const int t = row & 2047;
                        const f32x4 c = *(const f32x4*)(ropeC + t * 32 + j0), s = *(const f32x4*)(ropeS + t * 32 + j0);
                        const f32x4 x1 = WIN_F(ai, 0, m, 0), x2 = WIN_F(ai, 0, m, 1); const f32x4 o1 = x1 * c - x2 * s, o2 = x2 * c + x1 * s;
                        *(u32x4*)(KI + (size_t)row * 64 + cl) = pack8(o1, o2);
                        float* ok = outKI + (size_t)row * 64 + j0; *(f32x4*)ok = o1; *(f32x4*)(ok + 32) = o2; }
            } else if (wc == 2 && fq == 0) {
#pragma unroll
                for (int ai = 0; ai < 2; ++ai)
#pragma unroll
                    for (int m = 0; m < 4; ++m) { WIN_ROW(ai, m); const int row = rowb + ai * HALF + m * 16; *(f32x4*)(WI + (size_t)row * 4) = WIN_F(ai, 0, m, 0) * 0.0625f; }
            }
        }
#undef WIN_ROW
#undef WIN_F
    }
};
}
constexpr int NWAVES = 8;
#ifndef MK_N_LAUNCHES
#define MK_N_LAUNCHES 1
#endif
constexpr int N_PHASES = 9;
constexpr int N_LAUNCHES = MK_N_LAUNCHES;

constexpr int DM = 1024, NB = 16, SEQ = 2048, MP = NB * SEQ, NS = 128, FF = 2816, INW = 2116, INWP = 2304, PAST = 8192, NPAGE = 64;
constexpr float LN_EPS = 1e-5f, kAlpha = pg8::kAlpha;
constexpr size_t OUT_Y = 0, OUT_YS = 33554432, OUT_KP = 33685504, OUT_VP = 37879808, OUT_KIP = 42074112, OUT_KS = 44171264, OUT_VS = 44187648, OUT_KIS = 44204032, OUT_AV = 44212224, OUT_TOTAL = 44277760;

constexpr size_t MiB = 1u << 20;
constexpr size_t WS_CTL = 0, CTL_ZERO_BYTES = 1 * MiB;
constexpr size_t WS_ROPEC = 1 * MiB, WS_ROPES = WS_ROPEC + 2049 * 32 * 4;
constexpr size_t WS_W1UP = 2 * MiB, WS_W1DN = 13 * MiB, WS_WIN = 19 * MiB, WS_WOUT = 24 * MiB, WS_W2UP = 26 * MiB, WS_W2DN = 37 * MiB;
constexpr size_t WS_XB = 64 * MiB;
constexpr size_t WS_H = 128 * MiB;
constexpr size_t WS_Z1 = 304 * MiB;
constexpr size_t WS_U = 368 * MiB;
constexpr size_t WS_GV = 400 * MiB;
constexpr size_t WS_GVST = 432 * MiB;
constexpr size_t WS_Q = 434 * MiB;
constexpr size_t WS_K = 466 * MiB;
constexpr size_t WS_VT = 474 * MiB;
constexpr size_t WS_QI = 482 * MiB;
constexpr size_t WS_KI = 498 * MiB;
constexpr size_t WS_WI = 502 * MiB;
constexpr size_t WS_MASK = 503 * MiB;
constexpr size_t WS_MIX = 512 * MiB;
constexpr size_t WS_Z2 = 576 * MiB;
constexpr size_t WS_XCH = 640 * MiB;
constexpr size_t WS_SMP = 644 * MiB;
constexpr size_t SM_HS = WS_SMP, SM_Z1 = SM_HS + 128 * 2816 * 4, SM_ST1 = SM_Z1 + 128 * 1024 * 4, SM_US = SM_ST1 + 128 * 64 * 8, SM_GVS = SM_US + 128 * 512 * 4,
                 SM_QS = SM_GVS + 128 * 512 * 4, SM_QIS = SM_QS + 128 * 512 * 4, SM_WIS = SM_QIS + 128 * 256 * 4, SM_MIXS = SM_WIS + 128 * 4 * 4, SM_Z2 = SM_MIXS + 128 * 1024 * 4,
                 SM_ST2 = SM_Z2 + 128 * 1024 * 4, SM_Z3 = SM_ST2 + 128 * 64 * 8, SM_XSB = SM_Z3 + 128 * 1024 * 4, SM_MIXSB = SM_XSB + 128 * 1024 * 2, SM_Z1B = SM_MIXSB + 128 * 1024 * 2, SM_Z2B = SM_Z1B + 128 * 1024 * 2, SM_END = SM_Z2B + 128 * 1024 * 2;
constexpr size_t WS_Z3 = 304 * MiB;
constexpr size_t WS_STZ3 = 651 * MiB;
constexpr size_t WS_STZ1 = 652 * MiB, WS_STZ2 = 653 * MiB;
constexpr size_t WS_PS = 654 * MiB;
constexpr size_t PS_IN = WS_PS, PS_UP = WS_PS + 2 * 16 * 2304 * 4;
constexpr size_t WS_CV = 656 * MiB;
constexpr size_t CV_C1IN = WS_CV, CV_C2IN = CV_C1IN + 2304 * 4, CV_C1UP = CV_C2IN + 2304 * 4, CV_C2UP = CV_C1UP + 5632 * 4;
constexpr size_t WS_END = 658 * MiB;
static_assert(SM_END <= WS_END, "d_ws map");
constexpr int CW_TMO = 0, CW_CODE = 1;
constexpr int CW_BAR = 4096;
constexpr int CW_QUEUE = 64;
constexpr int CW_SEAM = 16384;

constexpr int RING_OFF = 0, RING_BYTES = 147968;
constexpr int XLDS_OFF = 131072;
constexpr int LDSCTL_OFF = RING_BYTES, MISC_OFF = LDSCTL_OFF + 320;
constexpr int LDS_BYTES = 163840;
static_assert(MISC_OFF + 128 <= LDS_BYTES, "LDS map");
#define GAS __attribute__((address_space(1)))
#define LAS __attribute__((address_space(3)))
typedef unsigned short bf16;
typedef unsigned v4u __attribute__((ext_vector_type(4)));
typedef float f32x4 __attribute__((ext_vector_type(4)));
typedef short bf16x8 __attribute__((ext_vector_type(8)));
typedef GAS unsigned gu32;
typedef GAS unsigned long long gu64;
#define RLX_AGENT __ATOMIC_RELAXED, __HIP_MEMORY_SCOPE_AGENT
#define LDS_WAIT() asm volatile("s_waitcnt lgkmcnt(0)" ::: "memory")
#define VM_WAIT() asm volatile("s_waitcnt vmcnt(0)" ::: "memory")
__device__ __forceinline__ unsigned long long rt() { return __builtin_amdgcn_s_memrealtime(); }
__device__ __forceinline__ unsigned f2bf(float f) { unsigned u = __builtin_bit_cast(unsigned, f); return (u + 0x7fffu + ((u >> 16) & 1u)) >> 16; }
__device__ __forceinline__ unsigned pk2(float lo, float hi) { return f2bf(lo) | (f2bf(hi) << 16); }

#define XB_TMO      128
#define XB_XCNT(j)  (256  + 64 * (j))
#define XB_XSUB(j)  (1280 + 64 * (j))
#define XB_XGEN(j)  (2304 + 64 * (j))
#define XB_TOP      3328
#define XB_TOPGEN   3392
#define XCD_BAR_WORDS 3456
#define XB_SPIN_CAP (1u << 18)

__device__ __forceinline__ unsigned xb_ld(unsigned* p)              { return __hip_atomic_load(p, __ATOMIC_RELAXED, __HIP_MEMORY_SCOPE_AGENT); }
__device__ __forceinline__ unsigned xb_add(unsigned* p, unsigned v) { return __hip_atomic_fetch_add(p, v, __ATOMIC_RELAXED, __HIP_MEMORY_SCOPE_AGENT); }
__device__ __forceinline__ unsigned xb_xcc_id() { return (unsigned)__builtin_amdgcn_s_getreg((3 << 11) | 20) & 0xFu; }
#define XB_SPIN(cond, bar) do { unsigned _sp = 0; while (cond) { __builtin_amdgcn_s_sleep(1); \
    if ((++_sp & 255u) == 0u) { if (xb_ld(&(bar)[XB_TMO])) break; if (_sp > XB_SPIN_CAP) { atomicAdd(&(bar)[XB_TMO], 1u); break; } } } } while (0)

struct XcdBarrier {
    unsigned* bar; unsigned x;
    volatile LAS unsigned* st;
};

__device__ __forceinline__ XcdBarrier xcd_barrier_post(unsigned* bar, volatile LAS unsigned* st) {
    XcdBarrier b; b.bar = bar; b.x = xb_xcc_id(); b.st = st;
    if (threadIdx.x == 0) (void)xb_add(&bar[XB_XCNT(b.x)], 1u);
    return b;
}
__device__ __forceinline__ void xcd_barrier_complete(unsigned* bar, unsigned x, unsigned& nloc, unsigned& nx) {
    const unsigned G = gridDim.x * gridDim.y * gridDim.z;
    unsigned sum, cnt, mine, sp = 0u;
    for (;;) {
        sum = 0u; cnt = 0u; mine = 0u;
#pragma unroll
        for (unsigned j = 0; j < 16; ++j) { const unsigned c = xb_ld(&bar[XB_XCNT(j)]); sum += c; cnt += (c > 0u) ? 1u : 0u; mine = (j == x) ? c : mine; }
        if (sum == G) break;
        __builtin_amdgcn_s_sleep(1);
        if ((++sp & 255u) == 0u) { if (xb_ld(&bar[XB_TMO])) break; if (sp > XB_SPIN_CAP) { atomicAdd(&bar[XB_TMO], 1u); break; } }
    }
    nloc = mine > 0u ? mine : 1u; nx = cnt > 0u ? cnt : 1u;
}

__device__ __forceinline__ void xcd_barrier(const XcdBarrier& b) {
    asm volatile("s_waitcnt vmcnt(0)" ::: "memory");
    __syncthreads();
    if (threadIdx.x == 0) {
        unsigned* bar = b.bar;
        __builtin_amdgcn_s_waitcnt(0);
        unsigned nloc = b.st[0], nx = b.st[1];
        if (nloc == 0u) { xcd_barrier_complete(bar, b.x, nloc, nx); b.st[0] = nloc; b.st[1] = nx; }
        const unsigned old = xb_add(&bar[XB_XSUB(b.x)], 1u);
        const unsigned gen = old / nloc;
        if (old + 1u == (gen + 1u) * nloc) {
            __builtin_amdgcn_fence(__ATOMIC_RELEASE, "agent");
            asm volatile("s_waitcnt vmcnt(0)" ::: "memory");
            const unsigned og = xb_add(&bar[XB_TOP], 1u);
            const unsigned tg = og / nx;
            if (og + 1u == (tg + 1u) * nx) xb_add(&bar[XB_TOPGEN], 1u);
            else XB_SPIN(xb_ld(&bar[XB_TOPGEN]) == tg, bar);
            __builtin_amdgcn_fence(__ATOMIC_ACQUIRE, "agent");
            xb_add(&bar[XB_XGEN(b.x)], 1u);
            asm volatile("s_waitcnt vmcnt(0)" ::: "memory");
        } else {
            XB_SPIN(xb_ld(&bar[XB_XGEN(b.x)]) == gen, bar);
            __builtin_amdgcn_fence(__ATOMIC_ACQUIRE, "agent");
            asm volatile("s_waitcnt vmcnt(0)" ::: "memory");
        }
    }
    __syncthreads();
}
typedef float f32x2 __attribute__((ext_vector_type(2)));
typedef unsigned u32x2 __attribute__((ext_vector_type(2)));
typedef float f32x16 __attribute__((ext_vector_type(16)));
struct Frame {
    LAS unsigned char* lds;
    volatile LAS unsigned* MISC;
    gu32* ctl;
    int tid, lane, wave, vcu, G;
    float* out; unsigned char* ws;
};
struct Args { const void* in[22]; float* out; unsigned char* ws; int ph_lo, ph_hi; };
#define IN_F(k) ((const float*)A.in[k])
__device__ __forceinline__ const float* in_lds(const Frame& F, int k) {
    const volatile LAS unsigned* t = (const volatile LAS unsigned*)(F.lds + LDSCTL_OFF);
    const unsigned lo = (unsigned)__builtin_amdgcn_readfirstlane((int)t[2 * k]), hi = (unsigned)__builtin_amdgcn_readfirstlane((int)t[2 * k + 1]);
    return (const float*)(const GAS float*)(((unsigned long long)hi << 32) | lo);
}
#define IN_L(k) in_lds(F, k)
__device__ __forceinline__ void launder(Frame& F) { unsigned long long w = (unsigned long long)F.ws, o = (unsigned long long)F.out; int t = F.tid, l = F.lane, wv = F.wave; asm volatile("" : "+s"(w), "+s"(o), "+v"(t), "+v"(l), "+s"(wv));
    F.ws = (unsigned char*)(GAS unsigned char*)w; F.out = (float*)(GAS float*)o; F.tid = t; F.lane = l; F.wave = wv; }
enum { I_XP = 0, I_XS, I_CK, I_CV, I_CKI, I_PT, I_LN1G, I_LN1B, I_W1UP, I_W1DN, I_LN2G, I_LN2B, I_WIN, I_ALNG, I_ALNB, I_AWS, I_ABS, I_WOUT, I_LN3G, I_LN3B, I_W2UP, I_W2DN };

__device__ __forceinline__ float wave_sum(float v) {
#pragma unroll
    for (int o = 1; o < 64; o <<= 1) v += __shfl_xor(v, o);
    return v;
}
__device__ __forceinline__ float wave_max(float v) {
#pragma unroll
    for (int o = 1; o < 64; o <<= 1) v = fmaxf(v, __shfl_xor(v, o));
    return v;
}
__device__ __forceinline__ f32x4 mfma16(const bf16x8 a, const bf16x8 b, const f32x4 c) { return __builtin_amdgcn_mfma_f32_16x16x32_bf16(a, b, c, 0, 0, 0); }
__device__ __forceinline__ f32x16 mfma32(const bf16x8 a, const bf16x8 b, const f32x16 c) { return __builtin_amdgcn_mfma_f32_32x32x16_bf16(a, b, c, 0, 0, 0); }
__device__ __forceinline__ bf16x8 as_bf16x8(const v4u w) { return __builtin_bit_cast(bf16x8, w); }

template <int MODE> __device__ __forceinline__ int dest_row(int n) {
    if (MODE == 1) { const int half = n >= FF ? 1 : 0, j = n - half * FF; return 256 * (j >> 7) + 128 * half + (j & 127); }
    if (MODE == 2) { const bool rp = (n >= 1024 && n < 1664) || (n >= 1792 && n < 2112);
        if (rp) { const int base = n & ~63, cc = n & 63; return base + 8 * ((cc & 31) >> 2) + 4 * (cc >> 5) + (cc & 3); }
        return n; }
    return n;
}
template <int MODE, bool FOLD> __device__ __forceinline__ void p0_item(const float* W, int K, int N, int Npad, bf16* WT, LAS float* scr, int item, int lane, const float* gamma, const float* beta, float* ps1, float* ps2) {
    const int nblk = Npad / 32, kb = item / nblk, nb = item % nblk, k0 = 64 * kb, n0 = 32 * nb;
    const int nsrc = n0 + (lane & 31); const bool ok = nsrc < N;
    { float wv[32];
#pragma unroll
      for (int i = 0; i < 32; ++i) { const int kk = 2 * i + (lane >> 5); wv[i] = ok ? __builtin_nontemporal_load(W + (size_t)(k0 + kk) * N + nsrc) : 0.f; }
      __builtin_amdgcn_sched_barrier(0);
#pragma unroll
      for (int i = 0; i < 32; ++i) { const int kk = 2 * i + (lane >> 5); scr[kk * 33 + (lane & 31)] = wv[i]; } }
    LDS_WAIT(); asm volatile("" ::: "memory");
    const int c = lane & 7;
    f32x4 g0 = (f32x4){1.f, 1.f, 1.f, 1.f}, g1 = g0, b0 = (f32x4){0.f, 0.f, 0.f, 0.f}, b1 = b0;
    if (FOLD) { g0 = *(const f32x4*)(gamma + k0 + 8 * c); g1 = *(const f32x4*)(gamma + k0 + 8 * c + 4); b0 = *(const f32x4*)(beta + k0 + 8 * c); b1 = *(const f32x4*)(beta + k0 + 8 * c + 4); }
#pragma unroll
    for (int j = 0; j < 4; ++j) { const int n = (lane >> 3) + 8 * j; const LAS float* s = scr + (8 * c) * 33 + n;
        const float w0 = s[0 * 33], w1 = s[1 * 33], w2 = s[2 * 33], w3 = s[3 * 33], w4 = s[4 * 33], w5 = s[5 * 33], w6 = s[6 * 33], w7 = s[7 * 33];
        v4u o; o.x = pk2(w0 * g0[0], w1 * g0[1]); o.y = pk2(w2 * g0[2], w3 * g0[3]); o.z = pk2(w4 * g1[0], w5 * g1[1]); o.w = pk2(w6 * g1[2], w7 * g1[3]);
        const int dr = dest_row<MODE>(n0 + n);
        *(GAS v4u*)(WT + (size_t)dr * K + k0 + 8 * c) = o;
        if (FOLD) {
            float s1 = ((__uint_as_float(o.x << 16) + __uint_as_float(o.x & 0xffff0000u)) + (__uint_as_float(o.y << 16) + __uint_as_float(o.y & 0xffff0000u)))
                     + ((__uint_as_float(o.z << 16) + __uint_as_float(o.z & 0xffff0000u)) + (__uint_as_float(o.w << 16) + __uint_as_float(o.w & 0xffff0000u)));
            float s2 = ((w0 * b0[0] + w1 * b0[1]) + (w2 * b0[2] + w3 * b0[3])) + ((w4 * b1[0] + w5 * b1[1]) + (w6 * b1[2] + w7 * b1[3]));
            s1 += __shfl_xor(s1, 1); s1 += __shfl_xor(s1, 2); s1 += __shfl_xor(s1, 4); s2 += __shfl_xor(s2, 1); s2 += __shfl_xor(s2, 2); s2 += __shfl_xor(s2, 4);
            if (c == 0) { ps1[(size_t)kb * Npad + dr] = s1; ps2[(size_t)kb * Npad + dr] = s2; }
        } }
    LDS_WAIT(); asm volatile("" ::: "memory");
}
__device__ const float ROPE_INV[32] = {
    1.0f, 0.7498942093324559f, 0.5623413251903491f, 0.4216965034285822f, 0.31622776601683794f, 0.23713737056616552f, 0.1778279410038923f, 0.1333521432163324f,
    0.1f, 0.07498942093324559f, 0.05623413251903491f, 0.04216965034285822f, 0.03162277660168379f, 0.023713737056616554f, 0.01778279410038923f, 0.01333521432163324f,
    0.01f, 0.007498942093324558f, 0.005623413251903491f, 0.004216965034285822f, 0.0031622776601683794f, 0.0023713737056616554f, 0.0017782794100389228f, 0.001333521432163324f,
    0.001f, 0.0007498942093324559f, 0.0005623413251903491f, 0.00042169650342858224f, 0.00031622776601683794f, 0.00023713737056616554f, 0.00017782794100389227f, 0.0001333521432163324f };
__device__ __forceinline__ void p0_prologue(Frame& F, const Args& A) {
    LAS float* scr = (LAS float*)(F.lds + RING_OFF + F.wave * 16384);
    const int gw = F.vcu * NWAVES + F.wave, NGW = F.G * NWAVES;
    unsigned char* ws = F.ws;
    constexpr int I_UP = (DM / 64) * (2 * FF / 32), I_DN = (FF / 64) * (DM / 32), I_IN = (DM / 64) * (INWP / 32);
    constexpr int NITEMS = I_UP + I_DN + I_IN;
    for (int it = gw; it < NITEMS; it += NGW) {
        int r = it;
        if (r < I_UP) { p0_item<1, false>(IN_F(I_W1UP), DM, 2 * FF, 2 * FF, (bf16*)(ws + WS_W1UP), scr, r, F.lane, nullptr, nullptr, nullptr, nullptr); continue; } r -= I_UP;
        if (r < I_DN) { p0_item<0, false>(IN_F(I_W1DN), FF, DM, DM, (bf16*)(ws + WS_W1DN), scr, r, F.lane, nullptr, nullptr, nullptr, nullptr); continue; } r -= I_DN;
        p0_item<2, true>(IN_F(I_WIN), DM, INW, INWP, (bf16*)(ws + WS_WIN), scr, r, F.lane, IN_F(I_LN1G), IN_F(I_LN1B), (float*)(ws + PS_IN), (float*)(ws + PS_IN) + 16 * INWP);
    }
    { const size_t gt = (size_t)F.vcu * (NWAVES * 64) + F.tid, NT = (size_t)F.G * NWAVES * 64; const float* x = IN_F(I_XP); bf16* xb = (bf16*)(ws + WS_XB);
      static_assert(((size_t)MP * DM / 8) % ((size_t)256 * NWAVES * 64 * 8) == 0, "x conversion: whole batches of 8 per thread on a 256-workgroup grid");
      for (size_t e0 = gt; e0 < (size_t)MP * DM / 8; e0 += 8 * NT) {
          f32x4 a[8], b[8];
#pragma unroll
          for (int i = 0; i < 8; ++i) { const size_t e = e0 + (size_t)i * NT; if (e < (size_t)MP * DM / 8) { a[i] = __builtin_nontemporal_load((const f32x4*)(x + e * 8)); b[i] = __builtin_nontemporal_load((const f32x4*)(x + e * 8 + 4)); } }
          __builtin_amdgcn_sched_barrier(0);
#pragma unroll
          for (int i = 0; i < 8; ++i) { const size_t e = e0 + (size_t)i * NT; if (e < (size_t)MP * DM / 8) {
              v4u o; o.x = pk2(a[i][0], a[i][1]); o.y = pk2(a[i][2], a[i][3]); o.z = pk2(b[i][0], b[i][1]); o.w = pk2(b[i][2], b[i][3]); *(GAS v4u*)(xb + e * 8) = o; } } } }
    { const int gt = F.vcu * (NWAVES * 64) + F.tid; const float* x = IN_F(I_XS); bf16* xb = (bf16*)(ws + SM_XSB);
      if (gt < NS * DM / 8) { const f32x4 a = *(const GAS f32x4*)(x + gt * 8), b = *(const GAS f32x4*)(x + gt * 8 + 4);
          v4u o; o.x = pk2(a[0], a[1]); o.y = pk2(a[2], a[3]); o.z = pk2(b[0], b[1]); o.w = pk2(b[2], b[3]); *(GAS v4u*)(xb + gt * 8) = o; } }
    { const int gt = F.vcu * (NWAVES * 64) + F.tid, NT = F.G * NWAVES * 64; float* rc = (float*)(ws + WS_ROPEC); float* rs = (float*)(ws + WS_ROPES);
      for (int e = gt; e < 2049 * 32; e += NT) { const int t = e >> 5, j = e & 31; const float pos = (t == 2048) ? 8192.f : (float)t; const float ang = pos * ROPE_INV[j];
          double rev = (double)ang * 0.15915494309189535; rev -= __builtin_floor(rev); const float fr = (float)rev;
          rc[e] = __builtin_amdgcn_cosf(fr); rs[e] = __builtin_amdgcn_sinf(fr); } }
}

__device__ __forceinline__ void p0_wout(Frame& F, const Args& A, int rank, int nrank) {
    launder(F); unsigned char* ws = F.ws; LAS float* scr = (LAS float*)(F.lds + RING_OFF + F.wave * 16384);
    constexpr int I_OUT = (DM / 64) * (DM / 32);
    for (int it = rank * NWAVES + F.wave; it < I_OUT; it += nrank * NWAVES) p0_item<0, false>(IN_L(I_WOUT), DM, DM, DM, (bf16*)(ws + WS_WOUT), scr, it, F.lane, nullptr, nullptr, nullptr, nullptr);
}
constexpr int LATE_ITEMS = (DM / 64) * (2 * FF / 32) + (FF / 64) * (DM / 32), LATE_UNITS = LATE_ITEMS / NWAVES;
static_assert(LATE_ITEMS % NWAVES == 0, "late weight units");
__device__ __forceinline__ void late_weight_unit(Frame& F, const Args& A, int unit) {
    launder(F); unsigned char* ws = F.ws; LAS float* scr = (LAS float*)(F.lds + RING_OFF + F.wave * 16384);
    constexpr int I_UP = (DM / 64) * (2 * FF / 32);
    const int r = unit * NWAVES + F.wave;
    if (r < I_UP) p0_item<1, true>(IN_L(I_W2UP), DM, 2 * FF, 2 * FF, (bf16*)(ws + WS_W2UP), scr, r, F.lane, IN_L(I_LN2G), IN_L(I_LN2B), (float*)(ws + PS_UP), (float*)(ws + PS_UP) + 16 * 2 * FF);
    else p0_item<0, false>(IN_L(I_W2DN), FF, DM, DM, (bf16*)(ws + WS_W2DN), scr, r - I_UP, F.lane, nullptr, nullptr, nullptr, nullptr);
    __syncthreads();
}
__device__ __forceinline__ void finalize_cvec(Frame& F, int sel) {
    unsigned char* ws = F.ws; const int gt = F.vcu * (NWAVES * 64) + F.tid + (sel ? 2 * INWP : 0);
    if (sel == 0 && gt >= 2 * INWP) return;
    if (gt < 2 * INWP) { const int which = gt / INWP, n = gt % INWP; const float* p = (const float*)(ws + PS_IN) + (size_t)which * 16 * INWP + n; float s = 0.f;
#pragma unroll
        for (int kb = 0; kb < 16; ++kb) s += p[(size_t)kb * INWP];
        ((float*)(ws + (which ? CV_C2IN : CV_C1IN)))[n] = s; }
    else if (gt < 2 * INWP + 4 * FF) { const int g2 = gt - 2 * INWP, which = g2 / (2 * FF), n = g2 % (2 * FF); const float* p = (const float*)(ws + PS_UP) + (size_t)which * 16 * 2 * FF + n; float s = 0.f;
#pragma unroll
        for (int kb = 0; kb < 16; ++kb) s += p[(size_t)kb * 2 * FF];
        ((float*)(ws + (which ? CV_C2UP : CV_C1UP)))[n] = s; }
}

constexpr int TH_RED = 0, TH_STAT = 131072;
__device__ __forceinline__ void thin_rowstats(const float* stat, int row, int fq, float& mean, float& rstd) {
    float s = 0.f, q = 0.f; const f32x2* p = (const f32x2*)stat + row * 64 + fq * 16;
#pragma unroll
    for (int i = 0; i < 16; ++i) { const f32x2 v = p[i]; s += v.x; q += v.y; }
    s += __shfl_xor(s, 16); s += __shfl_xor(s, 32); q += __shfl_xor(q, 16); q += __shfl_xor(q, 32);
    mean = s * (1.f / 1024.f); const float var = fmaxf(q * (1.f / 1024.f) - mean * mean, 0.f); rstd = 1.0f / sqrtf(var + LN_EPS);
}
__device__ __forceinline__ void thin_putstat(float* stat, int row, int unit, int fq, const f32x4 z) {
    float s = (z[0] + z[1]) + (z[2] + z[3]), q = (z[0] * z[0] + z[1] * z[1]) + (z[2] * z[2] + z[3] * z[3]);
    s += __shfl_xor(s, 16); s += __shfl_xor(s, 32); q += __shfl_xor(q, 16); q += __shfl_xor(q, 32);
    if (fq == 0) ((f32x2*)stat)[row * 64 + unit] = (f32x2){s, q};
}
template <int K, int NBR> __device__ __forceinline__ void thin_gemm(Frame& F, f32x4 (&out)[NBR], const bf16* Asrc, const bf16* const (&brow)[NBR]) {
    const int lane = F.lane, fr = lane & 15, fq = lane >> 4, w = F.wave;
    constexpr int KS = K / 8; static_assert(KS % 32 == 0, "K slice");
    f32x4 acc[8][NBR];
#pragma unroll
    for (int rt = 0; rt < 8; ++rt)
#pragma unroll
        for (int nb = 0; nb < NBR; ++nb) acc[rt][nb] = (f32x4){0.f, 0.f, 0.f, 0.f};
    constexpr int NSTEP = KS / 32, BATCH = (K == DM) ? 2 : 4;
#pragma unroll 1
    for (int s0 = 0; s0 < NSTEP; s0 += BATCH) {
        bf16x8 bf[BATCH][NBR], af[BATCH][8];
#pragma unroll
        for (int bi = 0; bi < BATCH; ++bi) if (s0 + bi < NSTEP) { const int k0 = w * KS + 32 * (s0 + bi) + 8 * fq;
#pragma unroll
            for (int nb = 0; nb < NBR; ++nb) bf[bi][nb] = *(const bf16x8*)(brow[nb] + k0);
#pragma unroll
            for (int rt = 0; rt < 8; ++rt) af[bi][rt] = *(const bf16x8*)(Asrc + (size_t)(16 * rt + fr) * K + k0); }
        __builtin_amdgcn_sched_barrier(0);
#pragma unroll
        for (int bi = 0; bi < BATCH; ++bi) if (s0 + bi < NSTEP) {
#pragma unroll
            for (int rt = 0; rt < 8; ++rt)
#pragma unroll
                for (int nb = 0; nb < NBR; ++nb) acc[rt][nb] = mfma16(bf[bi][nb], af[bi][rt], acc[rt][nb]); }
        __builtin_amdgcn_sched_barrier(0);
    }
    LAS f32x4* red = (LAS f32x4*)(F.lds + RING_OFF + TH_RED);
#pragma unroll
    for (int rt = 0; rt < 8; ++rt)
#pragma unroll
        for (int nb = 0; nb < NBR; ++nb) red[((nb * 8 + w) * 128 + 16 * rt + fr) * 4 + fq] = acc[rt][nb];
    __syncthreads();
#pragma unroll
    for (int nb = 0; nb < NBR; ++nb) { f32x4 s = red[((nb * 8 + 0) * 128 + 16 * w + fr) * 4 + fq];
#pragma unroll
        for (int ws = 1; ws < 8; ++ws) s = s + red[((nb * 8 + ws) * 128 + 16 * w + fr) * 4 + fq];
        out[nb] = s; }
    __syncthreads();
}
template <int STAGE> __device__ __forceinline__ void thin_stage(Frame& F, const Args& A, int unit0, int ustride) {
    launder(F); unsigned char* ws = F.ws; const int lane = F.lane, fr = lane & 15, fq = lane >> 4, w = F.wave; const int row = 16 * w + fr;
    constexpr int NU = (STAGE == 1 || STAGE == 7) ? FF / 16 : (STAGE == 3) ? (INW + 15) / 16 : DM / 16;
    bf16* HSB = (bf16*)(ws + SM_HS); float* Z1 = (float*)(ws + SM_Z1); float* ST1 = (float*)(ws + SM_ST1); float* Z2 = (float*)(ws + SM_Z2); float* ST2 = (float*)(ws + SM_ST2); float* Z3 = (float*)(ws + SM_Z3);
    if (unit0 < 0 || unit0 >= NU) return;
    float mean = 0.f, rstd = 1.f, mean1 = 0.f, rstd1 = 1.f;
    if (STAGE == 3 || STAGE == 6) thin_rowstats(ST1, row, fq, mean1, rstd1);
    if (STAGE == 7 || STAGE == 8) thin_rowstats(ST2, row, fq, mean, rstd);
    for (int unit = unit0; unit < NU; unit += ustride) {
        const int c0 = 16 * unit + 4 * fq;
        if (STAGE == 1 || STAGE == 7) {
            const bf16* Bt = (const bf16*)(ws + (STAGE == 1 ? WS_W1UP : WS_W2UP));
            const int rg = 256 * (unit >> 3) + 16 * (unit & 7) + fr;
            const bf16* const brow[2] = {Bt + (size_t)rg * DM, Bt + (size_t)(rg + 128) * DM};
            f32x4 acc[2]; f32x4 c1g = (f32x4){0.f, 0.f, 0.f, 0.f}, c1u = c1g, c2g = c1g, c2u = c1g;
            if (STAGE == 7) { const float* c1 = (const float*)(ws + CV_C1UP) + 256 * (unit >> 3) + 16 * (unit & 7) + 4 * fq; const float* c2 = (const float*)(ws + CV_C2UP) + 256 * (unit >> 3) + 16 * (unit & 7) + 4 * fq;
                c1g = *(const f32x4*)c1; c1u = *(const f32x4*)(c1 + 128); c2g = *(const f32x4*)c2; c2u = *(const f32x4*)(c2 + 128); }
            thin_gemm<DM, 2>(F, acc, (const bf16*)(ws + (STAGE == 1 ? SM_XSB : SM_Z2B)), brow);
            if (STAGE == 7) { const float rm = -rstd * mean;
                acc[0] = acc[0] * rstd + (c1g * rm + c2g); acc[1] = acc[1] * rstd + (c1u * rm + c2u); }
            f32x4 h;
#pragma unroll
            for (int i = 0; i < 4; ++i) h[i] = pg8::silu_f(acc[0][i]) * acc[1][i];
            u32x2 o; o.x = pk2(h[0], h[1]); o.y = pk2(h[2], h[3]); *(u32x2*)(HSB + (size_t)row * FF + c0) = o;
        } else if (STAGE == 2 || STAGE == 8) {
            const bf16* Bt = (const bf16*)(ws + (STAGE == 2 ? WS_W1DN : WS_W2DN));
            const bf16* const brow[1] = {Bt + (size_t)(16 * unit + fr) * FF};
            f32x4 acc[1];
            thin_gemm<FF, 1>(F, acc, HSB, brow);
            f32x4 res = *(const f32x4*)((STAGE == 2 ? IN_L(I_XS) : (const float*)Z2) + (size_t)row * DM + c0);
            if (STAGE == 8) res = (res - mean) * rstd * *(const f32x4*)(IN_L(I_LN2G) + c0) + *(const f32x4*)(IN_L(I_LN2B) + c0);
            const f32x4 z = res * kAlpha + acc[0] * 0.5f;
            *(f32x4*)((STAGE == 2 ? Z1 : Z3) + (size_t)row * DM + c0) = z;
            if (STAGE == 2) { thin_putstat(ST1, row, unit, fq, z); u32x2 o; o.x = pk2(z[0], z[1]); o.y = pk2(z[2], z[3]); *(u32x2*)((bf16*)(ws + SM_Z1B) + (size_t)row * DM + c0) = o; }
        } else if (STAGE == 6) {
            const bf16* Bt = (const bf16*)(ws + WS_WOUT);
            const bf16* const brow[1] = {Bt + (size_t)(16 * unit + fr) * DM};
            f32x4 acc[1];
            const f32x4 z1 = *(const f32x4*)(Z1 + (size_t)row * DM + c0);
            thin_gemm<DM, 1>(F, acc, (const bf16*)(ws + SM_MIXSB), brow);
            const f32x4 x1 = (z1 - mean1) * rstd1 * *(const f32x4*)(IN_L(I_LN1G) + c0) + *(const f32x4*)(IN_L(I_LN1B) + c0);
            const f32x4 z = x1 * kAlpha + acc[0];
            *(f32x4*)(Z2 + (size_t)row * DM + c0) = z;
            thin_putstat(ST2, row, unit, fq, z); { u32x2 o; o.x = pk2(z[0], z[1]); o.y = pk2(z[2], z[3]); *(u32x2*)((bf16*)(ws + SM_Z2B) + (size_t)row * DM + c0) = o; }
        } else {
            const bf16* Bt = (const bf16*)(ws + WS_WIN);
            const bf16* const brow[1] = {Bt + (size_t)(16 * unit + fr) * DM};
            f32x4 acc[1];
            const f32x4 c1v = *(const f32x4*)((const float*)(ws + CV_C1IN) + c0), c2v = *(const f32x4*)((const float*)(ws + CV_C2IN) + c0);
            thin_gemm<DM, 1>(F, acc, (const bf16*)(ws + SM_Z1B), brow);
            const f32x4 v = acc[0] * rstd1 + (c1v * (-rstd1 * mean1) + c2v);
            const bool roped = (c0 >= 1024 && c0 < 1664) || (c0 >= 1792 && c0 < 2112);
            f32x4 pr;
#pragma unroll
            for (int i = 0; i < 4; ++i) pr[i] = __shfl_xor(v[i], 16);
            if (c0 < 512) { f32x4 o;
#pragma unroll
                for (int i = 0; i < 4; ++i) o[i] = pg8::gelu_f(v[i]);
                *(f32x4*)((float*)(ws + SM_US) + (size_t)row * 512 + c0) = o;
            } else if (c0 < 1024) { f32x4 o;
#pragma unroll
                for (int i = 0; i < 4; ++i) o[i] = pg8::gelu_f(v[i]);
                *(f32x4*)((float*)(ws + SM_GVS) + (size_t)row * 512 + (c0 - 512)) = o;
            } else if (roped) {
                const int base = c0 & ~63, p = c0 & 63, g = p >> 3, n = (p >> 2) & 1;
                const f32x4 c = *(const f32x4*)((const float*)(ws + WS_ROPEC) + 2048 * 32 + 4 * g), s = *(const f32x4*)((const float*)(ws + WS_ROPES) + 2048 * 32 + 4 * g);
                const f32x4 o = n ? (v * c + pr * s) : (v * c - pr * s);
                const int oc = base + 32 * n + 4 * g;
                float* dst;
                if (oc < 1536) dst = (float*)(ws + SM_QS) + (size_t)row * 512 + (oc - 1024);
                else if (oc < 1664) dst = F.out + OUT_KS + (size_t)row * 128 + (oc - 1536);
                else if (oc < 2048) dst = (float*)(ws + SM_QIS) + (size_t)row * 256 + (oc - 1792);
                else dst = F.out + OUT_KIS + (size_t)row * 64 + (oc - 2048);
                *(f32x4*)dst = o;
            } else if (c0 < 1792) { *(f32x4*)(F.out + OUT_VS + (size_t)row * 128 + (c0 - 1664)) = v;
            } else if (c0 == 2112) { *(f32x4*)((float*)(ws + SM_WIS) + (size_t)row * 4) = v * 0.0625f; }
        }
    }
}
__device__ __forceinline__ void thin_final_ln(Frame& F, const Args& A) {
    const int gw = (F.G - 1 - F.vcu) * NWAVES + F.wave; if (gw >= NS) return;
    const float* z = (const float*)(F.ws + SM_Z3) + (size_t)gw * DM; const GAS f32x4* zr = (const GAS f32x4*)z + F.lane;
    f32x4 v[4]; float s = 0.f;
#pragma unroll
    for (int j = 0; j < 4; ++j) { v[j] = zr[64 * j]; s += (v[j].x + v[j].y) + (v[j].z + v[j].w); }
    const float mean = wave_sum(s) * (1.f / DM); float s2 = 0.f;
#pragma unroll
    for (int j = 0; j < 4; ++j) { v[j] = v[j] - mean; s2 += (v[j].x * v[j].x + v[j].y * v[j].y) + (v[j].z * v[j].z + v[j].w * v[j].w); }
    const float rstd = 1.f / sqrtf(wave_sum(s2) * (1.f / DM) + LN_EPS);
    const f32x4* g = (const f32x4*)IN_L(I_LN3G) + F.lane; const f32x4* b = (const f32x4*)IN_L(I_LN3B) + F.lane; f32x4* o = (f32x4*)(F.out + OUT_YS + (size_t)gw * DM) + F.lane;
#pragma unroll
    for (int j = 0; j < 4; ++j) o[64 * j] = v[j] * rstd * g[64 * j] + b[64 * j];
}

__device__ __forceinline__ void final_ln_rows(Frame& F, const Args& A) {
    launder(F); unsigned char* ws = F.ws; const int lane = F.lane;
    const int gw = F.vcu * NWAVES + F.wave, NGW = F.G * NWAVES;
    const float* g3 = IN_L(I_LN3G); const float* b3 = IN_L(I_LN3B);
    f32x4 gv[4], bv[4];
#pragma unroll
    for (int j = 0; j < 4; ++j) { gv[j] = *(const f32x4*)(g3 + 256 * j + 4 * lane); bv[j] = *(const f32x4*)(b3 + 256 * j + 4 * lane); }
    const bf16* Z = (const bf16*)(ws + WS_Z3); const float* ST = (const float*)(ws + WS_STZ3);
#pragma unroll 1
    for (int row0 = gw; row0 < MP; row0 += 4 * NGW) {
        u32x2 raw[4][4]; f32x4 sa[4], sb[4];
#pragma unroll
        for (int r = 0; r < 4; ++r) { const size_t row = (size_t)row0 + (size_t)r * NGW; if (row < (size_t)MP) { sa[r] = *(const f32x4*)(ST + row * 8); sb[r] = *(const f32x4*)(ST + row * 8 + 4);
#pragma unroll
            for (int j = 0; j < 4; ++j) raw[r][j] = __builtin_nontemporal_load((const u32x2*)(Z + row * DM + 256 * j + 4 * lane)); } }
        __builtin_amdgcn_sched_barrier(0);
#pragma unroll
        for (int r = 0; r < 4; ++r) { const size_t row = (size_t)row0 + (size_t)r * NGW; if (row < (size_t)MP) { float mu, rs; pg8::stats_from(sa[r], sb[r], mu, rs);
            float* o = F.out + OUT_Y + row * DM + 4 * lane;
#pragma unroll
            for (int j = 0; j < 4; ++j) __builtin_nontemporal_store((pg8::unpack4(raw[r][j]) - mu) * rs * gv[j] + bv[j], (f32x4*)(o + 256 * j)); } }
    }
}
constexpr int GM_LD = 136;
__device__ __forceinline__ void gmlp_unit(Frame& F, const Args& A, int b, int c, int g) {
    launder(F); unsigned char* ws = F.ws; const int tid = F.tid, lane = F.lane, fr = lane & 15, fq = lane >> 4, w = F.wave;
    LAS bf16* wsA = (LAS bf16*)(F.lds + RING_OFF); LAS bf16* vnT = wsA + 128 * GM_LD;
    const int m0 = b * SEQ + 128 * c;
    {
        const int t = tid >> 2, sb = 32 * (tid & 3); const float* src = IN_L(I_AWS) + ((size_t)(g * 128 + t) * 128 + sb);
        f32x4 wv8[8];
#pragma unroll
        for (int i = 0; i < 8; ++i) wv8[i] = *(const f32x4*)(src + 4 * i);
        __builtin_amdgcn_sched_barrier(0);
#pragma unroll
        for (int i = 0; i < 8; ++i) { f32x4 v = wv8[i]; const int s = sb + 4 * i;
#pragma unroll
            for (int e = 0; e < 4; ++e) if (s + e > t) v[e] = 0.f;
            u32x2 o; o.x = pk2(v[0], v[1]); o.y = pk2(v[2], v[3]); *(LAS u32x2*)(wsA + t * GM_LD + s) = o; }
    }
    {
        const int s = tid >> 2, dq = tid & 3; const size_t row = (size_t)(m0 + s);
        const f32x4* st = (const f32x4*)((const float*)(ws + WS_GVST) + row * 16);
        const f32x4 p0 = st[0], p1 = st[1], p2 = st[2], p3 = st[3];
        const float mean = ((p0[0] + p0[2]) + (p1[0] + p1[2]) + (p2[0] + p2[2]) + (p3[0] + p3[2])) * 0.125f;
        float m2 = (p0[1] + p0[3]) + (p1[1] + p1[3]) + (p2[1] + p2[3]) + (p3[1] + p3[3]);
        { const float d0 = p0[0] - mean, d1 = p0[2] - mean, d2 = p1[0] - mean, d3 = p1[2] - mean, d4 = p2[0] - mean, d5 = p2[2] - mean, d6 = p3[0] - mean, d7 = p3[2] - mean;
          m2 += 64.f * ((d0 * d0 + d1 * d1) + (d2 * d2 + d3 * d3) + (d4 * d4 + d5 * d5) + (d6 * d6 + d7 * d7)); }
        const float rstd = 1.0f / sqrtf(m2 * (1.f / 512.f) + LN_EPS);
        const bf16* gv = (const bf16*)(ws + WS_GV) + row * 512 + 128 * g + 32 * dq;
        const float* lg = IN_L(I_ALNG) + 128 * g + 32 * dq; const float* lb = IN_L(I_ALNB) + 128 * g + 32 * dq;
        v4u raw4[4];
#pragma unroll
        for (int i = 0; i < 4; ++i) raw4[i] = *(const v4u*)(gv + 8 * i);
        __builtin_amdgcn_sched_barrier(0);
#pragma unroll
        for (int i = 0; i < 4; ++i) { const v4u raw = raw4[i];
            const f32x4 x0 = pg8::unpack4((u32x2){raw.x, raw.y}), x1 = pg8::unpack4((u32x2){raw.z, raw.w});
            const f32x4 g0 = *(const f32x4*)(lg + 8 * i), g1 = *(const f32x4*)(lg + 8 * i + 4), b0 = *(const f32x4*)(lb + 8 * i), b1 = *(const f32x4*)(lb + 8 * i + 4);
            const f32x4 y0 = (x0 - mean) * rstd * g0 + b0, y1 = (x1 - mean) * rstd * g1 + b1;
            const int d = 32 * dq + 8 * i;
#pragma unroll
            for (int e = 0; e < 4; ++e) { vnT[(d + e) * GM_LD + s] = (bf16)f2bf(y0[e]); vnT[(d + 4 + e) * GM_LD + s] = (bf16)f2bf(y1[e]); } }
    }
    __syncthreads();
    {
        f32x4 acc[8];
#pragma unroll
        for (int dt = 0; dt < 8; ++dt) acc[dt] = (f32x4){0.f, 0.f, 0.f, 0.f};
        const int nsteps = (w + 2) >> 1;
        for (int st = 0; st < nsteps; ++st) { const int s0 = 32 * st + 8 * fq;
            const bf16x8 bfr = *(const LAS bf16x8*)(wsA + (16 * w + fr) * GM_LD + s0);
#pragma unroll
            for (int dt = 0; dt < 8; ++dt) { const bf16x8 afr = *(const LAS bf16x8*)(vnT + (16 * dt + fr) * GM_LD + s0); acc[dt] = mfma16(afr, bfr, acc[dt]); } }
        const int t = 16 * w + fr; const size_t row = (size_t)(m0 + t); const float bias = IN_L(I_ABS)[g * 128 + t];
        const bf16* up = (const bf16*)(ws + WS_U) + row * 512 + 128 * g + 4 * fq; bf16* op = (bf16*)(ws + WS_MIX) + row * 1024 + 128 * g + 4 * fq;
#pragma unroll
        for (int dt = 0; dt < 8; ++dt) { const f32x4 uu = pg8::unpack4(*(const u32x2*)(up + 16 * dt)); const f32x4 o = uu * (acc[dt] + bias);
            u32x2 wv; wv.x = pk2(o[0], o[1]); wv.y = pk2(o[2], o[3]); *(u32x2*)(op + 16 * dt) = wv; }
    }
    __syncthreads();
}

__device__ __forceinline__ unsigned ord_f32(float x) { unsigned u = __float_as_uint(x); if (u == 0x80000000u) u = 0u; return (u & 0x80000000u) ? ~u : (u | 0x80000000u); }
__device__ __forceinline__ unsigned ord_f32_nz(float x) { const unsigned u = __float_as_uint(x); return u ^ ((unsigned)((int)u >> 31) | 0x80000000u); }
constexpr int SC_LD = 2052;
constexpr int TA_SC = 0, TA_MASK = 16 * SC_LD * 4, TA_END = TA_MASK + 64 * 64 * 4;
static_assert(TA_END <= RING_BYTES, "topk/attention LDS");
__device__ __forceinline__ void cnt_ge(unsigned& c, unsigned x, unsigned T) {
    asm volatile("v_cmp_le_u32_e32 vcc, %2, %1\n\tv_addc_co_u32_e32 %0, vcc, 0, %0, vcc" : "+v"(c) : "v"(x), "s"(T) : "vcc");
}
__device__ __forceinline__ unsigned wave_sum_u32(unsigned v) {
    v += (unsigned)__builtin_amdgcn_update_dpp(0, (int)v, 0xB1, 0xF, 0xF, true);
    v += (unsigned)__builtin_amdgcn_update_dpp(0, (int)v, 0x4E, 0xF, 0xF, true);
    v += (unsigned)__builtin_amdgcn_update_dpp(0, (int)v, 0x141, 0xF, 0xF, true);
    v += (unsigned)__builtin_amdgcn_update_dpp(0, (int)v, 0x140, 0xF, 0xF, true);
    return (unsigned)__builtin_amdgcn_readlane((int)v, 0) + (unsigned)__builtin_amdgcn_readlane((int)v, 16) + (unsigned)__builtin_amdgcn_readlane((int)v, 32) + (unsigned)__builtin_amdgcn_readlane((int)v, 48);
}
template <int J> __device__ __forceinline__ void put_word(unsigned long long sel, int& wlo, int& whi) {
    asm volatile("s_nop 1\n\tv_writelane_b32 %0, %2, %4\n\tv_writelane_b32 %1, %3, %4" : "+v"(wlo), "+v"(whi) : "s"((int)(unsigned)sel), "s"((int)(unsigned)(sel >> 32)), "n"(J));
}
__device__ __forceinline__ void transpose32(unsigned (&a)[32]) {
#define T32_STAGE(J, M) _Pragma("unroll") for (int k = 0; k < 32; ++k) if (!(k & (J))) { const unsigned lo = a[k], hi = a[k + (J)]; a[k] = (lo & (M)) | ((hi << (J)) & ~(M)); a[k + (J)] = ((lo >> (J)) & (M)) | (hi & ~(M)); }
    T32_STAGE(16, 0x0000FFFFu) T32_STAGE(8, 0x00FF00FFu) T32_STAGE(4, 0x0F0F0F0Fu) T32_STAGE(2, 0x33333333u) T32_STAGE(1, 0x55555555u)
#undef T32_STAGE
}
template <int J> __device__ __forceinline__ void words_from_bits(unsigned sel, int& wlo, int& whi) {
    if constexpr (J < 32) { put_word<J>(__ballot(((sel >> J) & 1u) != 0u), wlo, whi); words_from_bits<J + 1>(sel, wlo, whi); }
}
template <int J> __device__ __forceinline__ void ties_by_index(unsigned cand, int need, int base, unsigned& sel) {
    if constexpr (J < 32) { const bool tb = ((cand >> J) & 1u) != 0u; const unsigned long long tie = __ballot(tb);
        const int rank = base + (int)__builtin_amdgcn_mbcnt_hi((unsigned)(tie >> 32), __builtin_amdgcn_mbcnt_lo((unsigned)tie, 0u));
        sel |= ((unsigned)tb & (unsigned)(rank < need)) << J;
        ties_by_index<J + 1>(cand, need, base + __builtin_popcountll(tie), sel); }
}
__device__ __forceinline__ void select_rows(const LAS float* sc, LAS unsigned* mask16, int qbase, int w, int lane) {
    const int ra = 2 * w, rb = 2 * w + 1, qa = qbase + ra, qb = qbase + rb;
    unsigned PA[32], PB[32];
#pragma unroll
    for (int i = 0; i < 32; ++i) { const int k = 64 * i + lane; const float va = sc[ra * SC_LD + k], vb = sc[rb * SC_LD + k]; PA[i] = (k <= qa) ? ord_f32_nz(va) : 0u; PB[i] = (k <= qb) ? ord_f32_nz(vb) : 0u; }
    transpose32(PA); transpose32(PB);
    unsigned candA = ~0u, candB = ~0u, selA = 0u, selB = 0u; int abA = 0, abB = 0;
#pragma unroll
    for (int b = 31; b >= 0; --b) {
        const unsigned tA = candA & PA[b], tB = candB & PB[b];
        const unsigned tot = wave_sum_u32((unsigned)__builtin_popcount(tA) | ((unsigned)__builtin_popcount(tB) << 16));
        { const int nA = abA + (int)(tot & 0xffffu); const bool take = nA >= 256, ex = nA == 256;
          selA |= (take && !ex) ? 0u : tA; candA = take ? (ex ? 0u : tA) : (candA & ~PA[b]); abA = take ? (ex ? 256 : abA) : nA; }
        { const int nB = abB + (int)(tot >> 16); const bool take = nB >= 256, ex = nB == 256;
          selB |= (take && !ex) ? 0u : tB; candB = take ? (ex ? 0u : tB) : (candB & ~PB[b]); abB = take ? (ex ? 256 : abB) : nB; }
        if (abA == 256 && abB == 256) break;
    }
    {
        const unsigned tot = wave_sum_u32((unsigned)__builtin_popcount(candA) | ((unsigned)__builtin_popcount(candB) << 16));
        const int needA = 256 - abA, needB = 256 - abB;
        if ((int)(tot & 0xffffu) == needA) selA |= candA; else ties_by_index<0>(candA, needA, 0, selA);
        if ((int)(tot >> 16) == needB) selB |= candB; else ties_by_index<0>(candB, needB, 0, selB);
    }
    mask16[ra * 64 + lane] = selA; mask16[rb * 64 + lane] = selB;
}
__device__ __forceinline__ void topk16(Frame& F, int b, int q0, LAS unsigned* mask16) {
    launder(F); unsigned char* ws = F.ws; const int lane = F.lane, fr = lane & 15, fq = lane >> 4, w = F.wave;
    const size_t rowq = (size_t)b * SEQ + q0;
    if (q0 < 256) {
#pragma unroll
        for (int rr = 0; rr < 2; ++rr) { const int r = 2 * w + rr, q = q0 + r; const int d = q - lane;
            mask16[r * 64 + lane] = (d < 0) ? 0u : ((2u << (d >> 6)) - 1u); }
        return;
    }
    LAS float* sc = (LAS float*)(F.lds + RING_OFF + TA_SC);
    {
        const bf16* qip = (const bf16*)(ws + WS_QI) + (rowq + fr) * 256 + 8 * fq;
        bf16x8 qf[4][2];
#pragma unroll
        for (int h = 0; h < 4; ++h) { qf[h][0] = *(const bf16x8*)(qip + 64 * h); qf[h][1] = *(const bf16x8*)(qip + 64 * h + 32); }
        const f32x4 wq = *(const f32x4*)((const float*)(ws + WS_WI) + (rowq + fr) * 4);
        const int ntile = (q0 >> 4) + 1;
        const bf16* kib = (const bf16*)(ws + WS_KI) + ((size_t)b * SEQ + fr) * 64 + 8 * fq;
#pragma unroll 1
        for (int kt0 = w; kt0 < ntile; kt0 += 8 * NWAVES) {
            bf16x8 k0[8], k1[8];
#pragma unroll
            for (int i = 0; i < 8; ++i) { const int kt = kt0 + NWAVES * i; if (kt < ntile) { const bf16* kp = kib + (size_t)kt * 16 * 64; k0[i] = *(const bf16x8*)kp; k1[i] = *(const bf16x8*)(kp + 32); } }
            __builtin_amdgcn_sched_barrier(0);
#pragma unroll
            for (int i = 0; i < 8; ++i) { const int kt = kt0 + NWAVES * i; if (kt < ntile) {
                f32x4 s = (f32x4){0.f, 0.f, 0.f, 0.f};
#pragma unroll
                for (int h = 0; h < 4; ++h) { f32x4 d = mfma16(k0[i], qf[h][0], (f32x4){0.f, 0.f, 0.f, 0.f}); d = mfma16(k1[i], qf[h][1], d);
#pragma unroll
                    for (int e = 0; e < 4; ++e) s[e] = __builtin_fmaf(wq[h], fmaxf(d[e], 0.f), s[e]); }
                *(LAS f32x4*)(sc + fr * SC_LD + 16 * kt + 4 * fq) = s; } }
        }
    }
    __syncthreads();
    select_rows(sc, mask16, q0, w, lane);
    __syncthreads();
}

typedef float f32x8 __attribute__((ext_vector_type(8)));
constexpr int AT_KLD = 72, AT_VLD = 68;
constexpr int AT_KBYTES = 64 * AT_KLD * 2, AT_VBYTES = 64 * AT_VLD * 2;
static_assert(2 * AT_KBYTES + 2 * AT_VBYTES <= TA_MASK, "attention tiles overlay the score image");
__device__ __forceinline__ void attn_unit(Frame& F, int b, int qt, int g, const LAS unsigned* mask64) {
    launder(F); unsigned char* ws = F.ws; const int tid = F.tid, lane = F.lane, w = F.wave, r = lane & 31, hf = lane >> 5;
    const int hh = w & 3, qs = w >> 2, head = 4 * g + hh, q0 = 64 * qt + 32 * qs; const size_t qrow = (size_t)b * SEQ + q0 + r;
    LAS bf16* Ks = (LAS bf16*)(F.lds + RING_OFF); LAS bf16* Vs = (LAS bf16*)(F.lds + RING_OFF + 2 * AT_KBYTES);
    bf16x8 qf[4];
    { const bf16* qp = (const bf16*)(ws + WS_Q) + qrow * 512 + 64 * head + 8 * hf;
#pragma unroll
      for (int ks = 0; ks < 4; ++ks) qf[ks] = *(const bf16x8*)(qp + 16 * ks); }
    v4u mk[2][4];
    { const LAS v4u* mp = (const LAS v4u*)(mask64 + (32 * qs + r) * 64 + 4 * hf);
#pragma unroll
      for (int kh = 0; kh < 2; ++kh)
#pragma unroll
          for (int i4 = 0; i4 < 4; ++i4) mk[kh][i4] = mp[8 * kh + 2 * i4]; }
    const int srow = tid >> 3, sch = tid & 7;
    const bf16* ksrc = (const bf16*)(ws + WS_K) + ((size_t)b * SEQ + srow) * 128 + 64 * g + 8 * sch;
    const bf16* vsrc = (const bf16*)(ws + WS_VT) + ((size_t)(b * 2 + g) * 64 + srow) * 2048 + 8 * sch;
    const int ntile = qt + 1;
    f32x16 o[2]; o[0] = f32x16{}; o[1] = f32x16{};
    float m = -1e30f, l = 0.f; constexpr float C = 0.125f * 1.4426950408889634f;
#define ATT_COMPUTE(t) \
        const LAS bf16* kb = Ks + buf * (64 * AT_KLD) + r * AT_KLD + 8 * hf; \
        f32x16 s0 = f32x16{}, s1 = f32x16{}; \
_Pragma("unroll") \
        for (int ks = 0; ks < 4; ++ks) { s0 = mfma32(*(const LAS bf16x8*)(kb + 16 * ks), qf[ks], s0); s1 = mfma32(*(const LAS bf16x8*)(kb + 32 * AT_KLD + 16 * ks), qf[ks], s1); } \
        float mt = fmaxf(s0[0], s1[0]); \
_Pragma("unroll") \
        for (int i = 1; i < 16; ++i) mt = fmaxf(mt, fmaxf(s0[i], s1[i])); \
        mt = fmaxf(mt, __shfl_xor(mt, 32)); \
        const float mn = fmaxf(m, mt), alpha = __builtin_amdgcn_exp2f((m - mn) * C); const bool grew = mn != m; m = mn; \
        const float mc = -mn * C; \
        s0 = s0 * C + mc; s1 = s1 * C + mc;                    \
_Pragma("unroll") \
        for (int i = 0; i < 16; ++i) { \
            s0[i] = __uint_as_float(__float_as_uint(__builtin_amdgcn_exp2f(s0[i])) & (unsigned)__builtin_amdgcn_sbfe((int)mk[0][i >> 2][i & 3], (t), 1)); \
            s1[i] = __uint_as_float(__float_as_uint(__builtin_amdgcn_exp2f(s1[i])) & (unsigned)__builtin_amdgcn_sbfe((int)mk[1][i >> 2][i & 3], (t), 1)); } \
        float ps; { const f32x16 t16 = s0 + s1; const f32x8 t8 = t16.lo + t16.hi; const f32x4 t4 = t8.lo + t8.hi; const f32x2 t2 = t4.lo + t4.hi; ps = t2.x + t2.y; } \
        ps += __shfl_xor(ps, 32); \
        l = l * alpha + ps; \
        if (__any(grew)) { o[0] = o[0] * alpha; o[1] = o[1] * alpha; } \
        bf16x8 pf[2][2]; \
        { v4u a; a.x = pg8::cvt_pk_bf16(s0[0], s0[1]); a.y = pg8::cvt_pk_bf16(s0[2], s0[3]); a.z = pg8::cvt_pk_bf16(s0[4], s0[5]); a.w = pg8::cvt_pk_bf16(s0[6], s0[7]); pf[0][0] = as_bf16x8(a); \
          a.x = pg8::cvt_pk_bf16(s0[8], s0[9]); a.y = pg8::cvt_pk_bf16(s0[10], s0[11]); a.z = pg8::cvt_pk_bf16(s0[12], s0[13]); a.w = pg8::cvt_pk_bf16(s0[14], s0[15]); pf[0][1] = as_bf16x8(a); \
          a.x = pg8::cvt_pk_bf16(s1[0], s1[1]); a.y = pg8::cvt_pk_bf16(s1[2], s1[3]); a.z = pg8::cvt_pk_bf16(s1[4], s1[5]); a.w = pg8::cvt_pk_bf16(s1[6], s1[7]); pf[1][0] = as_bf16x8(a); \
          a.x = pg8::cvt_pk_bf16(s1[8], s1[9]); a.y = pg8::cvt_pk_bf16(s1[10], s1[11]); a.z = pg8::cvt_pk_bf16(s1[12], s1[13]); a.w = pg8::cvt_pk_bf16(s1[14], s1[15]); pf[1][1] = as_bf16x8(a); } \
        const LAS bf16* vb = Vs + buf * (64 * AT_VLD) + r * AT_VLD + 4 * hf; \
_Pragma("unroll") \
        for (int db = 0; db < 2; ++db) \
_Pragma("unroll") \
            for (int kh = 0; kh < 2; ++kh) \
_Pragma("unroll") \
                for (int s2 = 0; s2 < 2; ++s2) { const LAS bf16* vp = vb + db * (32 * AT_VLD) + 32 * kh + 16 * s2; \
                    const u32x2 lo = *(const LAS u32x2*)vp, hi = *(const LAS u32x2*)(vp + 8); \
                    o[db] = mfma32(as_bf16x8((v4u){lo.x, lo.y, hi.x, hi.y}), pf[kh][s2], o[db]); }
    v4u kregA = *(const v4u*)ksrc, vregA = *(const v4u*)vsrc, kregB = kregA, vregB = vregA;
    *(LAS v4u*)(Ks + srow * AT_KLD + 8 * sch) = kregA;
    { LAS u32x2* vd = (LAS u32x2*)(Vs + srow * AT_VLD + 8 * sch); vd[0] = (u32x2){vregA.x, vregA.y}; vd[1] = (u32x2){vregA.z, vregA.w}; }
    if (ntile > 1) { kregB = *(const v4u*)(ksrc + (size_t)64 * 128); vregB = *(const v4u*)(vsrc + 64); }
    __syncthreads();
#define ATT_STEP(t, KR_NEXT, VR_NEXT, KR_LOAD, VR_LOAD) { const int buf = (t) & 1; \
        if ((t) + 2 < ntile) { KR_LOAD = *(const v4u*)(ksrc + (size_t)((t) + 2) * 64 * 128); VR_LOAD = *(const v4u*)(vsrc + ((t) + 2) * 64); } \
        ATT_COMPUTE(t) \
        if ((t) + 1 < ntile) { const int nb = buf ^ 1; \
            *(LAS v4u*)(Ks + nb * (64 * AT_KLD) + srow * AT_KLD + 8 * sch) = KR_NEXT; \
            LAS u32x2* vd = (LAS u32x2*)(Vs + nb * (64 * AT_VLD) + srow * AT_VLD + 8 * sch); vd[0] = (u32x2){VR_NEXT.x, VR_NEXT.y}; vd[1] = (u32x2){VR_NEXT.z, VR_NEXT.w}; } \
        __syncthreads(); }
    for (int t = 0; t < ntile; t += 2) {
        ATT_STEP(t, kregB, vregB, kregA, vregA)
        if (t + 1 < ntile) ATT_STEP(t + 1, kregA, vregA, kregB, vregB)
    }
#undef ATT_STEP
#undef ATT_COMPUTE
    {
        const float linv = 1.0f / l; bf16* op = (bf16*)(ws + WS_MIX) + qrow * 1024 + 512 + 64 * head + 4 * hf;
#pragma unroll
        for (int db = 0; db < 2; ++db)
#pragma unroll
            for (int i4 = 0; i4 < 4; ++i4) { u32x2 wv; wv.x = pg8::cvt_pk_bf16(o[db][4 * i4] * linv, o[db][4 * i4 + 1] * linv); wv.y = pg8::cvt_pk_bf16(o[db][4 * i4 + 2] * linv, o[db][4 * i4 + 3] * linv);
                *(u32x2*)(op + 32 * db + 8 * i4) = wv; }
    }
}
__device__ __forceinline__ void topk_attn_unit(Frame& F, int b, int qt) {
    LAS unsigned* mask64 = (LAS unsigned*)(F.lds + RING_OFF + TA_MASK);
#pragma unroll 1
    for (int sub = 0; sub < 4; ++sub) topk16(F, b, 64 * qt + 16 * sub, mask64 + sub * 16 * 64);
    __syncthreads();
#pragma unroll 1
#ifdef PROBE_ATT2
    for (int g = 0; g < 4; ++g) attn_unit(F, b, qt, g & 1, mask64);
#else
    for (int g = 0; g < 2; ++g) attn_unit(F, b, qt, g, mask64);
#endif
}

__device__ __forceinline__ float dpp_sum16(float v) {
    v += __builtin_bit_cast(float, __builtin_amdgcn_update_dpp(0, __builtin_bit_cast(int, v), 0xB1, 0xF, 0xF, true));
    v += __builtin_bit_cast(float, __builtin_amdgcn_update_dpp(0, __builtin_bit_cast(int, v), 0x4E, 0xF, 0xF, true));
    v += __builtin_bit_cast(float, __builtin_amdgcn_update_dpp(0, __builtin_bit_cast(int, v), 0x141, 0xF, 0xF, true));
    v += __builtin_bit_cast(float, __builtin_amdgcn_update_dpp(0, __builtin_bit_cast(int, v), 0x140, 0xF, 0xF, true));
    return v;
}
__device__ __forceinline__ float dot4(const f32x4 a, const f32x4 b) { return __builtin_fmaf(a[3], b[3], __builtin_fmaf(a[2], b[2], __builtin_fmaf(a[1], b[1], a[0] * b[0]))); }
constexpr int SU_SC = 0, SU_QI = 8208 * 4, SU_WI = SU_QI + 256 * 4, SU_Q = SU_WI + 16, SU_SEL = SU_Q + 512 * 4, SU_P = SU_SEL + 256 * 4, SU_CNT = SU_P + 8 * 256 * 4, SU_CW = SU_CNT + 64 * 4, SU_RED = SU_CW + 2 * 17 * 8 * 4, SU_END = SU_RED + 64 * 4;
static_assert(SU_END <= RING_BYTES, "sample-unit LDS");
__device__ __forceinline__ void sample_unit(Frame& F, const Args& A, int b) {
    launder(F); unsigned char* ws = F.ws; const int tid = F.tid, lane = F.lane, w = F.wave;
    LAS float* sc = (LAS float*)(F.lds + RING_OFF + SU_SC); LAS float* qi_s = (LAS float*)(F.lds + RING_OFF + SU_QI); LAS float* wi_s = (LAS float*)(F.lds + RING_OFF + SU_WI);
    LAS float* q_s = (LAS float*)(F.lds + RING_OFF + SU_Q); LAS int* sel = (LAS int*)(F.lds + RING_OFF + SU_SEL); LAS float* p_s = (LAS float*)(F.lds + RING_OFF + SU_P);
    LAS unsigned* cnts = (LAS unsigned*)(F.lds + RING_OFF + SU_CNT); LAS unsigned* cw = (LAS unsigned*)(F.lds + RING_OFF + SU_CW); LAS float* red = (LAS float*)(F.lds + RING_OFF + SU_RED);
    const int* pt = (const int*)IN_L(I_PT) + b * NPAGE;
    if (tid < 256) qi_s[tid] = ((const float*)(ws + SM_QIS))[b * 256 + tid];
    if (tid < 4) wi_s[tid] = ((const float*)(ws + SM_WIS))[b * 4 + tid];
    q_s[tid] = ((const float*)(ws + SM_QS))[b * 512 + tid];
    {
        const float gv = ((const float*)(ws + SM_GVS))[b * 512 + tid];
        const float s1 = wave_sum(gv); if (lane == 0) red[w] = s1;
        __syncthreads();
        float mean = 0.f;
#pragma unroll
        for (int i = 0; i < 8; ++i) mean += red[i];
        mean *= (1.f / 512.f);
        const float d = gv - mean; const float s2 = wave_sum(d * d); if (lane == 0) red[8 + w] = s2;
        __syncthreads();
        float var = 0.f;
#pragma unroll
        for (int i = 0; i < 8; ++i) var += red[8 + i];
        const float rstd = 1.0f / sqrtf(var * (1.f / 512.f) + LN_EPS);
        const float av = d * rstd * IN_L(I_ALNG)[tid] + IN_L(I_ALNB)[tid];
        F.out[OUT_AV + (size_t)b * 512 + tid] = av;
        const int g = tid >> 7; const float mixed = IN_L(I_AWS)[(size_t)g * 128 * 128] * av + IN_L(I_ABS)[g * 128];
        ((bf16*)(ws + SM_MIXSB))[(size_t)b * 1024 + tid] = (bf16)f2bf(((const float*)(ws + SM_US))[b * 512 + tid] * mixed);
    }
    {
        const int sub = lane & 15, kq = lane >> 4;
        f32x4 qh[4];
#pragma unroll
        for (int h = 0; h < 4; ++h) qh[h] = *(const LAS f32x4*)(qi_s + 64 * h + 4 * sub);
        const float w0 = wi_s[0], w1 = wi_s[1], w2 = wi_s[2], w3 = wi_s[3];
        for (int pg = w; pg < NPAGE; pg += NWAVES) {
            const int phys = pt[pg]; const float* base = IN_L(I_CKI) + (size_t)phys * (128 * 64) + 4 * sub;
            { f32x4 kvs[32];
#pragma unroll
              for (int it = 0; it < 32; ++it) kvs[it] = __builtin_nontemporal_load((const f32x4*)(base + (4 * it + kq) * 64));
              __builtin_amdgcn_sched_barrier(0);
#pragma unroll
              for (int it = 0; it < 32; ++it) { const int key = 4 * it + kq; const f32x4 kv = kvs[it];
                const float d0 = dpp_sum16(dot4(kv, qh[0])), d1 = dpp_sum16(dot4(kv, qh[1])), d2 = dpp_sum16(dot4(kv, qh[2])), d3 = dpp_sum16(dot4(kv, qh[3]));
                float s = w0 * fmaxf(d0, 0.f); s = __builtin_fmaf(w1, fmaxf(d1, 0.f), s); s = __builtin_fmaf(w2, fmaxf(d2, 0.f), s); s = __builtin_fmaf(w3, fmaxf(d3, 0.f), s);
                if (sub == 0) sc[pg * 128 + key] = s; } }
        }
        if (w == 0) { const f32x4 kv = *(const f32x4*)(F.out + OUT_KIS + (size_t)b * 64 + 4 * sub);
            const float d0 = dpp_sum16(dot4(kv, qh[0])), d1 = dpp_sum16(dot4(kv, qh[1])), d2 = dpp_sum16(dot4(kv, qh[2])), d3 = dpp_sum16(dot4(kv, qh[3]));
            float s = w0 * fmaxf(d0, 0.f); s = __builtin_fmaf(w1, fmaxf(d1, 0.f), s); s = __builtin_fmaf(w2, fmaxf(d2, 0.f), s); s = __builtin_fmaf(w3, fmaxf(d3, 0.f), s);
            if (lane == 0) sc[PAST] = s; }
    }
    __syncthreads();
    unsigned x[17];
#pragma unroll
    for (int i = 0; i < 17; ++i) { const int p = tid + 512 * i; x[i] = (p <= PAST) ? ord_f32(sc[p < PAST + 1 ? p : PAST]) : 0u; }
    unsigned prefix = 0u;
#pragma unroll 1
    for (int bit = 31; bit >= 0; --bit) { const unsigned T = prefix | (1u << bit); unsigned c = 0u;
#pragma unroll
        for (int i = 0; i < 17; ++i) cnt_ge(c, x[i], T);
        const unsigned cnt = wave_sum_u32(c);
        LAS unsigned* slot = cnts + 8 * (bit & 1);
        if (lane == 0) slot[w] = cnt;
        __syncthreads();
        unsigned tot = 0;
#pragma unroll
        for (int i = 0; i < 8; ++i) tot += slot[i];
        if (tot >= 256u) prefix = T;
        if (tot == 256u) break; }
    const unsigned thr = prefix;
    {
        const unsigned long long lt = (1ull << lane) - 1ull;
        int cg = 0;
#pragma unroll
        for (int i = 0; i < 17; ++i) cg += __builtin_popcountll(__ballot(x[i] > thr));
        if (lane == 0) cnts[16 + w] = (unsigned)cg;
#pragma unroll
        for (int i = 0; i < 17; ++i) { const unsigned long long gb = __ballot(x[i] > thr), tb = __ballot(x[i] == thr);
            if (lane == 0) { cw[(i * 8 + w) * 2] = (unsigned)__builtin_popcountll(gb); cw[(i * 8 + w) * 2 + 1] = (unsigned)__builtin_popcountll(tb); } }
        __syncthreads();
        unsigned ngt = 0;
#pragma unroll
        for (int i = 0; i < 8; ++i) ngt += cnts[16 + i];
        const unsigned need = 256u - ngt;
        unsigned run_gt = 0, run_ti = 0;
#pragma unroll
        for (int i = 0; i < 17; ++i) {
            unsigned my_g = run_gt, my_t = run_ti;
#pragma unroll
            for (int ww = 0; ww < 8; ++ww) { const unsigned a = cw[(i * 8 + ww) * 2], c = cw[(i * 8 + ww) * 2 + 1]; if (ww < w) { my_g += a; my_t += c; } run_gt += a; run_ti += c; }
            const unsigned long long gb = __ballot(x[i] > thr), tb = __ballot(x[i] == thr); const int p = tid + 512 * i;
            if ((gb >> lane) & 1ull) sel[my_g + (unsigned)__builtin_popcountll(gb & lt)] = p;
            else if ((tb >> lane) & 1ull) { const unsigned rk = my_t + (unsigned)__builtin_popcountll(tb & lt); if (rk < need) sel[ngt + rk] = p; }
            __builtin_amdgcn_sched_barrier(0);
        }
    }
    __syncthreads();
    {
        LAS int* ro_s = (LAS int*)cw;
        if (tid < 256) { const int p = sel[tid]; ro_s[tid] = (p < PAST) ? pt[p >> 7] * 128 + (p & 127) : -1; }
        __syncthreads();
        const int h = w, g = h >> 2; const float* ck = IN_L(I_CK); const float* cv = IN_L(I_CV);
        const int sub = lane & 15, kq = lane >> 4;
        const f32x4 qv = *(const LAS f32x4*)(q_s + 64 * h + 4 * sub);
        const float* knew = F.out + OUT_KS + ((size_t)b * 2 + g) * 64 + 4 * sub; const float* vnew = F.out + OUT_VS + ((size_t)b * 2 + g) * 64 + 4 * sub;
#pragma unroll 1
        for (int it0 = 0; it0 < 64; it0 += 16) { f32x4 kr16[16];
#pragma unroll
            for (int i = 0; i < 16; ++i) { const int ro = ro_s[4 * (it0 + i) + kq]; kr16[i] = *(const f32x4*)((ro >= 0) ? ck + ((size_t)ro * 2 + g) * 64 + 4 * sub : knew); }
            __builtin_amdgcn_sched_barrier(0);
#pragma unroll
            for (int i = 0; i < 16; ++i) { const float d = dpp_sum16(dot4(kr16[i], qv)); if (sub == 0) p_s[h * 256 + 4 * (it0 + i) + kq] = d * 0.125f; } }
        LDS_WAIT(); asm volatile("" ::: "memory");
        const float l0 = p_s[h * 256 + lane], l1 = p_s[h * 256 + lane + 64], l2 = p_s[h * 256 + lane + 128], l3 = p_s[h * 256 + lane + 192];
        const float mx = wave_max(fmaxf(fmaxf(l0, l1), fmaxf(l2, l3)));
        const float e0 = __expf(l0 - mx), e1 = __expf(l1 - mx), e2 = __expf(l2 - mx), e3 = __expf(l3 - mx);
        p_s[h * 256 + lane] = e0; p_s[h * 256 + lane + 64] = e1; p_s[h * 256 + lane + 128] = e2; p_s[h * 256 + lane + 192] = e3;
        const float ls = (e0 + e1) + (e2 + e3);
        const float linv = 1.0f / wave_sum(ls);
        LDS_WAIT(); asm volatile("" ::: "memory");
        f32x4 acc = (f32x4){0.f, 0.f, 0.f, 0.f};
#pragma unroll 1
        for (int it0 = 0; it0 < 64; it0 += 16) { f32x4 vr16[16];
#pragma unroll
            for (int i = 0; i < 16; ++i) { const int ro = ro_s[4 * (it0 + i) + kq]; vr16[i] = *(const f32x4*)((ro >= 0) ? cv + ((size_t)ro * 2 + g) * 64 + 4 * sub : vnew); }
            __builtin_amdgcn_sched_barrier(0);
#pragma unroll
            for (int i = 0; i < 16; ++i) acc = acc + vr16[i] * p_s[h * 256 + 4 * (it0 + i) + kq]; }
#pragma unroll
        for (int i = 0; i < 4; ++i) { acc[i] += __shfl_xor(acc[i], 16); acc[i] += __shfl_xor(acc[i], 32); }
        if (kq == 0) { const f32x4 o = acc * linv; u32x2 wv; wv.x = pk2(o[0], o[1]); wv.y = pk2(o[2], o[3]); *(u32x2*)((bf16*)(ws + SM_MIXSB) + (size_t)b * 1024 + 512 + 64 * h + 4 * sub) = wv; }
    }
    __syncthreads();
}

__device__ __forceinline__ gu32* seam_word(Frame& F, int k, int call) { return F.ctl + CW_SEAM + ((k * 2 + call) * 64) * 64; }

template <bool OUT_F32, bool RES_F32>
__device__ __forceinline__ void ln_gemm_phase(Frame& F, int k, const bf16* A, int K, const bf16* Bt, const void* res, float racc, const float* gamma, const float* beta, void* out, unsigned poison, const float* rst, const float* rgamma, const float* rbeta) {
#pragma unroll
    for (int call = 0; call < 2; ++call) {
        const size_t roff = (size_t)call * 16384;
        pg8::Gemm g{A + roff * K, Bt, 16384, DM, K}; pg8::StaticOrder S; S.init(16384, DM, F.G, (int)blockIdx.x);
        pg8::PanelStats st{(unsigned*)(F.ws + WS_XCH + (size_t)(k * 2 + call) * 512 * 1024), (unsigned*)seam_word(F, k, call), (unsigned*)(F.ctl + CW_TMO), DM / 256, LN_EPS, 0x700u + 0x40u * (unsigned)k + 0x20u * (unsigned)call};
        const void* resc = RES_F32 ? (const void*)((const float*)res + roff * DM) : (const void*)((const bf16*)res + roff * DM);
        void* outc = OUT_F32 ? (void*)((float*)out + roff * DM) : (void*)((bf16*)out + roff * DM);
        pg8::EpiLn<OUT_F32, RES_F32> E{resc, racc, gamma, beta, outc, st, poison, rst ? rst + roff * 8 : nullptr, rgamma, rbeta};
        pg8::gemm_phase<pg8::EpiLn<OUT_F32, RES_F32>, pg8::StaticOrder, false, true>(F.lds + RING_OFF, g, S, E);
        __syncthreads();
    }
}

__global__ void __launch_bounds__(NWAVES * 64, 2) hymba_fwd(Args args) {
    extern __shared__ __attribute__((aligned(16))) unsigned char lds[];
    Frame F;
    F.lds = (LAS unsigned char*)lds;
    F.MISC = (volatile LAS unsigned*)(F.lds + MISC_OFF);
    F.tid = threadIdx.x; F.lane = F.tid & 63; F.wave = __builtin_amdgcn_readfirstlane(F.tid >> 6);
    F.G = gridDim.x; { const int bx = blockIdx.x; F.vcu = (F.G % 8 == 0) ? (bx % 8) * (F.G / 8) + bx / 8 : bx; }
    F.out = args.out; F.ws = args.ws; const Args& A = args;
    unsigned char* ws = args.ws;
    F.ctl = (gu32*)(ws + WS_CTL);
    for (int u = F.tid; u < (LDS_BYTES - LDSCTL_OFF) / 4; u += NWAVES * 64) ((LAS unsigned*)(F.lds + LDSCTL_OFF))[u] = 0u;
    __syncthreads();
    if (F.tid < 22) { const unsigned long long* ka = (const unsigned long long*)__builtin_amdgcn_kernarg_segment_ptr();
        ((volatile LAS unsigned long long*)(F.lds + LDSCTL_OFF))[F.tid] = ka[F.tid]; }
    __syncthreads();
    XcdBarrier bar; bar.bar = (unsigned*)(F.ctl + CW_BAR); bar.x = 0; bar.st = nullptr;
    if (N_LAUNCHES == 1) bar = xcd_barrier_post((unsigned*)(F.ctl + CW_BAR), F.MISC + 8);
#define GRID_BAR() do { if (N_LAUNCHES == 1) xcd_barrier(bar); } while (0)
    const int lo = args.ph_lo, hi = args.ph_hi;
#ifdef ONLY_PHASE
#define IN(k) ((k) == ONLY_PHASE)
#else
#define IN(k) (lo <= (k) && (k) < hi)
#endif
#define BOTH(k) (IN(k) && IN((k) + 1))
    const int c = (int)blockIdx.x;
#ifndef PROBE_REP_PHASE
#define PROBE_REP_PHASE (-1)
#endif
#ifndef PROBE_P4_SUB
#define PROBE_P4_SUB 0
#endif
#ifndef PROBE_THIN_REP
#define PROBE_THIN_REP 1
#endif
#define NREP(k) (((k) == PROBE_REP_PHASE) ? 2 : 1)

    if (IN(0)) { p0_prologue(F, A); if (NREP(0) == 2) { __syncthreads(); p0_prologue(F, A); } if (BOTH(0)) GRID_BAR(); }

    if (IN(1)) {
        pg8::Gemm g{(const bf16*)(ws + WS_XB), (const bf16*)(ws + WS_W1UP), MP, 2 * FF, DM}; pg8::StaticOrder S; S.init(MP, 2 * FF, F.G, c);
        pg8::EpiSwiGLU<false> E{(bf16*)(ws + WS_H), FF, nullptr, nullptr, nullptr, 0u};
        pg8::gemm_phase<pg8::EpiSwiGLU<false>, pg8::StaticOrder, true, true>(F.lds + RING_OFF, g, S, E);
        finalize_cvec(F, 0);
#if PROBE_THIN_REP == 3
_Pragma("unroll 1") for (int rep = 0; rep < 2; ++rep) thin_stage<1>(F, A, F.G - 1 - F.vcu, F.G);
#else
        thin_stage<1>(F, A, F.G - 1 - F.vcu, F.G); if (PROBE_THIN_REP == 2) thin_stage<1>(F, A, F.G - 1 - F.vcu, F.G);
#endif
        if (BOTH(1)) GRID_BAR();
    }
    if (IN(2)) {
        pg8::Gemm g{(const bf16*)(ws + WS_H), (const bf16*)(ws + WS_W1DN), MP, DM, FF}; pg8::StaticOrder S; S.init(MP, DM, F.G, c);
        pg8::EpiZ<0, true> E{(const bf16*)(ws + WS_XB), nullptr, nullptr, nullptr, (bf16*)(ws + WS_Z1), (float*)(ws + WS_STZ1), (unsigned)(size_t)(F.lds + XLDS_OFF)};
        pg8::gemm_phase<pg8::EpiZ<0, true>, pg8::StaticOrder, true, true>(F.lds + RING_OFF, g, S, E);
        if (NREP(2) == 2) { __syncthreads(); pg8::gemm_phase<pg8::EpiZ<0, true>, pg8::StaticOrder, true, true>(F.lds + RING_OFF, g, S, E); }
        thin_stage<2>(F, A, F.G - 1 - F.vcu, F.G);
        if (BOTH(2)) GRID_BAR();
    }
    if (IN(3)) {
        pg8::EpiWin E{(bf16*)(ws + WS_U), (bf16*)(ws + WS_GV), (bf16*)(ws + WS_Q), (bf16*)(ws + WS_K), (bf16*)(ws + WS_VT), (bf16*)(ws + WS_QI), (bf16*)(ws + WS_KI),
                      (float*)(ws + WS_GVST), (float*)(ws + WS_WI), F.out + OUT_KP, F.out + OUT_VP, F.out + OUT_KIP, (const float*)(ws + WS_ROPEC), (const float*)(ws + WS_ROPES),
                      (const float*)(ws + WS_STZ1), (const float*)(ws + CV_C1IN), (const float*)(ws + CV_C2IN), (unsigned)(size_t)(F.lds + XLDS_OFF + 8192), 0};
        { pg8::Gemm g{(const bf16*)(ws + WS_Z1), (const bf16*)(ws + WS_WIN), MP, 2048, DM}; pg8::StaticOrder S; S.init(MP, 2048, F.G, c);
          pg8::gemm_phase<pg8::EpiWin, pg8::StaticOrder, true, true>(F.lds + RING_OFF, g, S, E); }
        __syncthreads();
        { pg8::Gemm g{(const bf16*)(ws + WS_Z1), (const bf16*)(ws + WS_WIN) + (size_t)2048 * DM, MP, 256, DM}; pg8::StaticOrder S; S.init(MP, 256, F.G, c);
          E.pn_off = 8;
          pg8::gemm_phase<pg8::EpiWin, pg8::StaticOrder, true, true, true>(F.lds + RING_OFF, g, S, E); }
        if (c >= 128) { thin_stage<3>(F, A, c - 128, 128); p0_wout(F, A, c - 128, 128); }
        if (BOTH(3)) GRID_BAR();
    }
    if (IN(4)) {
#ifndef PROBE_Q_DUP
#define PROBE_Q_DUP 0
#endif
        constexpr int N_SMP = NS * (PROBE_Q_DUP == 1 ? 2 : 1), N_ATT = NB * 32 * (PROBE_Q_DUP == 2 ? 2 : 1), N_GM = NB * 16 * 4 * (PROBE_Q_DUP == 3 ? 2 : 1);
        constexpr int Q_SAMPLE = N_SMP, Q_ATTN = Q_SAMPLE + N_ATT, Q_GM = Q_ATTN + N_GM, Q_TOTAL = Q_GM + LATE_UNITS;
        gu32* qhead = F.ctl + CW_QUEUE; volatile LAS unsigned* qslot = F.MISC + 16;
        if (F.tid == 0) qslot[0] = __hip_atomic_fetch_add(qhead, 1u, RLX_AGENT);
        __syncthreads();
        int item = __builtin_amdgcn_readfirstlane((int)qslot[0]); int par = 0;
        while (item < Q_TOTAL) {
            unsigned nxt = 0u; if (F.tid == 0) nxt = __hip_atomic_fetch_add(qhead, 1u, RLX_AGENT);
            if (item < Q_SAMPLE) sample_unit(F, A, item % NS);
            else if (item < Q_ATTN) { const int i = (item - Q_SAMPLE) % (NB * 32); topk_attn_unit(F, i & 15, 31 - (i >> 4)); }
            else if (item < Q_GM) { const int L = (item - Q_ATTN) % (NB * 16 * 4); gmlp_unit(F, A, L >> 6, (L >> 2) & 15, L & 3); }
            else late_weight_unit(F, A, item - Q_GM);
            par ^= 1; if (F.tid == 0) qslot[par] = nxt;
            __syncthreads();
            item = __builtin_amdgcn_readfirstlane((int)qslot[par]);
        }
        if (BOTH(4)) GRID_BAR();
    }
    if (IN(5)) {
        pg8::Gemm g{(const bf16*)(ws + WS_MIX), (const bf16*)(ws + WS_WOUT), MP, DM, DM}; pg8::StaticOrder S; S.init(MP, DM, F.G, c);
        pg8::EpiZ<1, false> E{(const bf16*)(ws + WS_Z1), (const float*)(ws + WS_STZ1), IN_F(I_LN1G), IN_F(I_LN1B), (bf16*)(ws + WS_Z2), (float*)(ws + WS_STZ2), (unsigned)(size_t)(F.lds + XLDS_OFF)};
        pg8::gemm_phase<pg8::EpiZ<1, false>, pg8::StaticOrder, true, true>(F.lds + RING_OFF, g, S, E);
        finalize_cvec(F, 1);
        thin_stage<6>(F, A, F.G - 1 - F.vcu, F.G);
        if (BOTH(5)) GRID_BAR();
    }
    if (IN(6)) {
        pg8::Gemm g{(const bf16*)(ws + WS_Z2), (const bf16*)(ws + WS_W2UP), MP, 2 * FF, DM}; pg8::StaticOrder S; S.init(MP, 2 * FF, F.G, c);
        pg8::EpiSwiGLU<true> E{(bf16*)(ws + WS_H), FF, (const float*)(ws + WS_STZ2), (const float*)(ws + CV_C1UP), (const float*)(ws + CV_C2UP), (unsigned)(size_t)(F.lds + XLDS_OFF + 8192)};
        pg8::gemm_phase<pg8::EpiSwiGLU<true>, pg8::StaticOrder, true, true>(F.lds + RING_OFF, g, S, E);
#if PROBE_THIN_REP == 3
_Pragma("unroll 1") for (int rep = 0; rep < 2; ++rep) thin_stage<7>(F, A, F.G - 1 - F.vcu, F.G);
#else
        thin_stage<7>(F, A, F.G - 1 - F.vcu, F.G); if (PROBE_THIN_REP == 2) thin_stage<7>(F, A, F.G - 1 - F.vcu, F.G);
#endif
        if (BOTH(6)) GRID_BAR();
    }
    if (IN(7)) {
        pg8::Gemm g{(const bf16*)(ws + WS_H), (const bf16*)(ws + WS_W2DN), MP, DM, FF}; pg8::StaticOrder S; S.init(MP, DM, F.G, c);
        pg8::EpiZ<1, true> E{(const bf16*)(ws + WS_Z2), (const float*)(ws + WS_STZ2), IN_F(I_LN2G), IN_F(I_LN2B), (bf16*)(ws + WS_Z3), (float*)(ws + WS_STZ3), (unsigned)(size_t)(F.lds + XLDS_OFF)};
        pg8::gemm_phase<pg8::EpiZ<1, true>, pg8::StaticOrder, true, true>(F.lds + RING_OFF, g, S, E);
        thin_stage<8>(F, A, F.G - 1 - F.vcu, F.G);
        if (BOTH(7)) GRID_BAR();
    }
    if (IN(8)) { thin_final_ln(F, A); final_ln_rows(F, A); }
#undef IN
#undef BOTH
#undef GRID_BAR
}

extern "C" void kernel_launch(void* const* d_in, const int* in_sizes, int n_in, void* d_out, int out_size, void* d_ws, size_t ws_size, hipStream_t stream) {
    static int grid = 0;
    if (grid == 0) {
        if (n_in != 22 || in_sizes[0] != MP * DM || (size_t)out_size != OUT_TOTAL || ws_size < WS_END) {
            fprintf(stderr, "kernel_launch: unexpected shapes (n_in %d, in0 %d, out %d, ws %zu); nothing launched\n", n_in, n_in > 0 ? in_sizes[0] : -1, out_size, ws_size); grid = -1; return; }
        int dev = 0, cus = 0, per_cu = 0;
        if (hipGetDevice(&dev) != hipSuccess || hipDeviceGetAttribute(&cus, hipDeviceAttributeMultiprocessorCount, dev) != hipSuccess) { fprintf(stderr, "kernel_launch: device query failed\n"); grid = -1; return; }
        if (hipFuncSetAttribute((const void*)hymba_fwd, hipFuncAttributeMaxDynamicSharedMemorySize, LDS_BYTES) != hipSuccess) { fprintf(stderr, "kernel_launch: hipFuncSetAttribute failed\n"); grid = -1; return; }
        if (hipOccupancyMaxActiveBlocksPerMultiprocessor(&per_cu, (const void*)hymba_fwd, NWAVES * 64, LDS_BYTES) != hipSuccess || per_cu < 1)
            fprintf(stderr, "kernel_launch: note: occupancy query reports %d workgroups per CU\n", per_cu);
        (void)hipGetLastError();
        grid = cus;
        if (grid != 256) fprintf(stderr, "kernel_launch: %d CUs; the fused LayerNorm phases need 256 workgroups: output will be NaN\n", grid);
    }
    if (grid < 0) return;
    if (hipMemsetAsync((char*)d_ws + WS_CTL, 0, CTL_ZERO_BYTES, stream) != hipSuccess) { fprintf(stderr, "kernel_launch: memset failed\n"); return; }
    Args a{};
    for (int i = 0; i < 22; ++i) a.in[i] = d_in[i];
    a.out = (float*)d_out; a.ws = (unsigned char*)d_ws;
    for (int li = 0; li < N_LAUNCHES; ++li) {
        a.ph_lo = (N_LAUNCHES == 1) ? 0 : li; a.ph_hi = (N_LAUNCHES == 1) ? N_PHASES : li + 1;
        hipLaunchKernelGGL(hymba_fwd, dim3(grid), dim3(NWAVES * 64), LDS_BYTES, stream, a);
        const hipError_t le = hipPeekAtLastError();
        if (le != hipSuccess) { fprintf(stderr, "kernel_launch: launch %d failed: %s\n", li, hipGetErrorName(le)); break; }
    }
}
```

```cpp
#include <hip/hip_runtime.h>
#include <cstdio>
#include <cstdint>
namespace pg8 {
#define PG8_LAS __attribute__((address_space(3)))
typedef unsigned short bf16_t;
typedef short bf16x8 __attribute__((ext_vector_type(8)));
typedef float f32x4 __attribute__((ext_vector_type(4)));
typedef unsigned u32x4 __attribute__((ext_vector_type(4)));
constexpr int BM = 256, BK = 64, HALF = 128, HTB = HALF * BK * 2  , STAGE_BYTES = 8 * HTB, NXCD = 8, WGM = 8;

__host__ __device__ __forceinline__ int lds_byte(int r, int c) { const int st = (r >> 4) * 2 + (c >> 5), rr = r & 15, cc = c & 31, ob = rr * 64 + cc * 2; return st * 1024 + (ob ^ (((ob >> 9) & 1) << 5)); }
__host__ __device__ __forceinline__ void stage_rc(int b, int& R, int& C) { const int st = b / 1024, sb = b % 1024, swz = sb ^ (((sb >> 9) & 1) << 5); R = (st >> 1) * 16 + swz / 64; C = (st & 1) * 32 + (swz % 64) / 2; }
__host__ __device__ __forceinline__ int perm32(int rho) { const int n = rho >> 4, i = rho & 15; return 8 * (i >> 2) + 4 * n + (i & 3); }

struct Unit { int pm, pn; };
struct Gemm { const bf16_t* A; const bf16_t* Bt; int M, N, K; };

struct StaticOrder {
    int nM, nN, nwg, G, c;
    __host__ __device__ void init(int M, int N, int G_, int c_) { nM = M / BM; nN = N / BM; nwg = nM * nN; G = G_; c = c_; }
    __host__ __device__ bool next(int i, Unit& u) const {
        const long L = (long)i * G + c; if (L >= nwg) return false;
        int wgid = (int)L; { const int q = nwg / NXCD, r = nwg % NXCD, xcd = wgid % NXCD, off = wgid / NXCD; wgid = (xcd < r ? xcd * (q + 1) : r * (q + 1) + (xcd - r) * q) + off; }
        const int nig = WGM * nN, gid = wgid / nig, fm = gid * WGM, gsz = (nM - fm) < WGM ? (nM - fm) : WGM;
        u.pm = fm + ((wgid % nig) % gsz); u.pn = (wgid % nig) / gsz; return true;
    }
    __device__ __forceinline__ void a_ready(const Unit&) const {}
    __device__ __forceinline__ void done(const Unit&) const {}
};

__device__ __forceinline__ unsigned cvt_pk_bf16(float lo, float hi) { unsigned r; asm volatile("v_cvt_pk_bf16_f32 %0, %1, %2" : "=v"(r) : "v"(lo), "v"(hi)); return r; }
typedef float f32x2 __attribute__((ext_vector_type(2)));
template <class Epi, class Sched, bool ALIGN_EPI = false, bool SP2 = false, bool HALF_N = false>
__device__ __forceinline__ void gemm_phase(PG8_LAS unsigned char* lds, const Gemm g, const Sched& S, const Epi& E) {
    int tid_ = threadIdx.x; asm volatile("" : "+v"(tid_));
    const int tid = tid_, wid = __builtin_amdgcn_readfirstlane(tid >> 6), lane = tid & 63, wr = wid >> 2, wc = wid & 3, fr = lane & 15, fq = lane >> 4;
    const int K = g.K, nt = K / BK;
    unsigned voffA[2], voffB[2];
#pragma unroll
    for (int i = 0; i < 2; ++i) { int R, C; stage_rc(tid * 16 + i * 8192, R, C); const int Rb = Epi::PERM ? ((R & ~31) + perm32(R & 31)) : R;
        voffA[i] = (unsigned)(R * K + C) * 2u; voffB[i] = (unsigned)(Rb * K + C) * 2u; }
    const size_t kstep = (size_t)(BK * 2);
    const size_t hstep = (size_t)HALF * K * 2;
    const size_t tstep = 2 * hstep;
    const unsigned ldsw = (unsigned)wid * 1024u;
    const int aoff = lds_byte(wr * 64 + fr, fq * 8), boff = lds_byte(wc * 32 + fr, fq * 8);
#define PG8_SA(b, h) (((b) * 2 + (h)) * HTB)
#define PG8_SB(b, h) ((4 + (b) * 2 + (h)) * HTB)
#define PG8_STAGE(bufoff, gbase, voff) do { _Pragma("unroll") for (int _i = 0; _i < 2; ++_i) \
        __builtin_amdgcn_global_load_lds((const unsigned*)((const char*)(gbase) + (voff)[_i]), (PG8_LAS unsigned*)(lds + (bufoff) + ldsw + _i * 8192), 16, 0, 0); } while (0)
#define PG8_LDA(dst, b, h) do { _Pragma("unroll") for (int m = 0; m < 4; ++m) _Pragma("unroll") for (int k = 0; k < 2; ++k) dst[m][k] = *(const PG8_LAS bf16x8*)(lds + PG8_SA(b, h) + aoff + m * 2048 + k * 1024); } while (0)
#define PG8_LDB(dst, b, h) do { _Pragma("unroll") for (int n = 0; n < 2; ++n) _Pragma("unroll") for (int k = 0; k < 2; ++k) dst[n][k] = *(const PG8_LAS bf16x8*)(lds + PG8_SB(b, h) + boff + n * 2048 + k * 1024); } while (0)
#define PG8_MMA(ai, bj, At, Bt) do { __builtin_amdgcn_s_setprio(1); _Pragma("unroll") for (int m = 0; m < 4; ++m) _Pragma("unroll") for (int n = 0; n < 2; ++n) _Pragma("unroll") for (int k = 0; k < 2; ++k) \
        acc[ai][bj][m][n] = __builtin_amdgcn_mfma_f32_16x16x32_bf16(Bt[n][k], At[m][k], acc[ai][bj][m][n], 0, 0, 0); __builtin_amdgcn_s_setprio(0); } while (0)
#define PG8_WAIT_V(n) asm volatile("s_waitcnt vmcnt(" #n ")" ::: "memory")
#define PG8_WAIT_L(n) asm volatile("s_waitcnt lgkmcnt(" #n ")" ::: "memory")
#define PG8_BAR __builtin_amdgcn_s_barrier()
#define PG8_SCHED __builtin_amdgcn_sched_barrier(0)
    Unit cur, nxt; int ui = 0;
    if (!S.next(0, cur)) return;
    f32x4 acc[2][2][4][2];
#pragma unroll
    for (int a = 0; a < 2; ++a)
#pragma unroll
        for (int b = 0; b < 2; ++b)
#pragma unroll
            for (int m = 0; m < 4; ++m)
#pragma unroll
                for (int n = 0; n < 2; ++n) acc[a][b][m][n] = (f32x4){0.f, 0.f, 0.f, 0.f};
    bf16x8 At[4][2], B0[2][2], B1[2][2];
    const char* cA = (const char*)g.A + (size_t)cur.pm * tstep; const char* cB = (const char*)g.Bt + (size_t)cur.pn * tstep;
    S.a_ready(cur);
    if constexpr (SP2) {
        PG8_STAGE(PG8_SB(0, 0), cB, voffB); PG8_STAGE(PG8_SB(0, 1), cB + hstep, voffB); PG8_STAGE(PG8_SA(0, 0), cA, voffA); PG8_STAGE(PG8_SA(0, 1), cA + hstep, voffA);
        if (wr == 1) PG8_BAR;
        PG8_WAIT_V(2); PG8_BAR;
        PG8_STAGE(PG8_SB(1, 0), cB + kstep, voffB); PG8_STAGE(PG8_SA(1, 0), cA + kstep, voffA); PG8_STAGE(PG8_SB(1, 1), cB + hstep + kstep, voffB);
        PG8_WAIT_V(6); PG8_BAR;
    } else {
        PG8_STAGE(PG8_SB(0, 0), cB, voffB); PG8_STAGE(PG8_SA(0, 0), cA, voffA); PG8_STAGE(PG8_SB(0, 1), cB + hstep, voffB); PG8_STAGE(PG8_SA(0, 1), cA + hstep, voffA);
        if (wr == 1) PG8_BAR;
        PG8_WAIT_V(4); PG8_BAR;
        PG8_STAGE(PG8_SB(1, 0), cB + kstep, voffB); PG8_STAGE(PG8_SA(1, 0), cA + kstep, voffA); PG8_STAGE(PG8_SB(1, 1), cB + hstep + kstep, voffB);
        PG8_WAIT_V(6); PG8_BAR;
    }
    for (;;) {
        const bool has_next = S.next(ui + 1, nxt);
        const char* nA = has_next ? (const char*)g.A + (size_t)nxt.pm * tstep : cA; const char* nB = has_next ? (const char*)g.Bt + (size_t)nxt.pn * tstep : cB;
        for (int t = 0; t < nt; t += 2) {
            const bool last = (t == nt - 2);
            const char* a1 = cA + (size_t)(t + 1) * kstep;
            const char* a2 = last ? nA : cA + (size_t)(t + 2) * kstep; const char* b2 = last ? nB : cB + (size_t)(t + 2) * kstep;
            const char* a3 = a2 + kstep; const char* b3 = b2 + kstep;
            if (last && has_next) S.a_ready(nxt);
            if constexpr (SP2) {
            PG8_LDB(B0, 0, 0); if constexpr (!HALF_N) PG8_LDB(B1, 0, 1); PG8_SCHED; PG8_LDA(At, 0, 0); PG8_STAGE(PG8_SA(1, 1), a1 + hstep, voffA);
            PG8_WAIT_V(8); PG8_WAIT_L(0); PG8_BAR; PG8_MMA(0, 0, At, B0); if constexpr (!HALF_N) PG8_MMA(0, 1, At, B1); PG8_BAR; PG8_SCHED;
            PG8_LDA(At, 0, 1); PG8_STAGE(PG8_SB(0, 0), b2, voffB); PG8_STAGE(PG8_SB(0, 1), b2 + hstep, voffB); PG8_STAGE(PG8_SA(0, 0), a2, voffA);
            PG8_WAIT_V(8); PG8_WAIT_L(0); PG8_BAR; PG8_MMA(1, 0, At, B0); if constexpr (!HALF_N) PG8_MMA(1, 1, At, B1); PG8_BAR; PG8_SCHED;
            PG8_LDB(B0, 1, 0); if constexpr (!HALF_N) PG8_LDB(B1, 1, 1); PG8_SCHED; PG8_LDA(At, 1, 0); PG8_STAGE(PG8_SA(0, 1), a2 + hstep, voffA);
            PG8_WAIT_V(8); PG8_WAIT_L(0); PG8_BAR; PG8_MMA(0, 0, At, B0); if constexpr (!HALF_N) PG8_MMA(0, 1, At, B1); PG8_BAR; PG8_SCHED;
            PG8_LDA(At, 1, 1); PG8_STAGE(PG8_SB(1, 0), b3, voffB); PG8_STAGE(PG8_SB(1, 1), b3 + hstep, voffB); PG8_STAGE(PG8_SA(1, 0), a3, voffA);
            PG8_WAIT_V(8); PG8_WAIT_L(0); PG8_BAR; PG8_MMA(1, 0, At, B0); if constexpr (!HALF_N) PG8_MMA(1, 1, At, B1); PG8_BAR; PG8_SCHED;
            } else {
            PG8_LDB(B0, 0, 0); PG8_SCHED; PG8_LDA(At, 0, 0); PG8_STAGE(PG8_SA(1, 1), a1 + hstep, voffA);
            PG8_WAIT_L(8); PG8_BAR; PG8_WAIT_L(0); PG8_MMA(0, 0, At, B0); PG8_BAR; PG8_SCHED;
            PG8_LDB(B1, 0, 1); PG8_STAGE(PG8_SB(0, 0), b2, voffB);
            PG8_BAR; PG8_WAIT_L(0); PG8_MMA(0, 1, At, B1); PG8_BAR;
            PG8_LDA(At, 0, 1); PG8_STAGE(PG8_SA(0, 0), a2, voffA);
            PG8_BAR; PG8_WAIT_L(0); PG8_MMA(1, 0, At, B0); PG8_BAR; PG8_SCHED;
            PG8_STAGE(PG8_SB(0, 1), b2 + hstep, voffB);
            PG8_WAIT_V(6); PG8_BAR; PG8_MMA(1, 1, At, B1); PG8_BAR;
            PG8_LDB(B0, 1, 0); PG8_SCHED; PG8_LDA(At, 1, 0); PG8_STAGE(PG8_SA(0, 1), a2 + hstep, voffA);
            PG8_WAIT_L(8); PG8_BAR; PG8_WAIT_L(0); PG8_MMA(0, 0, At, B0); PG8_BAR; PG8_SCHED;
            PG8_LDB(B1, 1, 1); PG8_STAGE(PG8_SB(1, 0), b3, voffB);
            PG8_BAR; PG8_WAIT_L(0); PG8_MMA(0, 1, At, B1); PG8_BAR;
            PG8_LDA(At, 1, 1); PG8_STAGE(PG8_SA(1, 0), a3, voffA);
            PG8_BAR; PG8_WAIT_L(0); PG8_MMA(1, 0, At, B0); PG8_BAR; PG8_SCHED;
            PG8_STAGE(PG8_SB(1, 1), b3 + hstep, voffB);
            PG8_WAIT_V(6); PG8_BAR; PG8_MMA(1, 1, At, B1); PG8_BAR;
            }
        }
        if constexpr (ALIGN_EPI) { if (wr == 0) PG8_BAR; }
        if constexpr (!Epi::AFTER_DRAIN) { E(acc, cur, wr, wc, fr, fq); S.done(cur); }
        if (!has_next) break;
#pragma unroll
        for (int a = 0; a < 2; ++a)
#pragma unroll
            for (int b = 0; b < 2; ++b)
#pragma unroll
                for (int m = 0; m < 4; ++m)
#pragma unroll
                    for (int n = 0; n < 2; ++n) acc[a][b][m][n] = (f32x4){0.f, 0.f, 0.f, 0.f};
        cur = nxt; cA = nA; cB = nB; ++ui;
        if constexpr (ALIGN_EPI) { if (wr == 1) PG8_BAR; }
    }
    PG8_WAIT_V(0);
    if constexpr (!ALIGN_EPI) { if (wr == 0) PG8_BAR; }
    PG8_BAR;
    if constexpr (Epi::AFTER_DRAIN) { E.fused(acc, cur, wr, wc, fr, fq, lds, wid, lane); S.done(cur); }
#undef PG8_SA
#undef PG8_SB
#undef PG8_STAGE
#undef PG8_LDA
#undef PG8_LDB
#undef PG8_MMA
#undef PG8_WAIT_V
#undef PG8_WAIT_L
#undef PG8_BAR
#undef PG8_SCHED
}
}
namespace pg8 {
typedef unsigned u32x2 __attribute__((ext_vector_type(2)));
constexpr float kAlpha = 1.189207115002721f;
__device__ __forceinline__ float silu_f(float x) { return x * __builtin_amdgcn_rcpf(1.f + __builtin_amdgcn_exp2f(-1.4426950408889634f * x)); }
__device__ __forceinline__ float gelu_f(float x) { const float t = x * (1.f + 0.044715f * x * x); return x * __builtin_amdgcn_rcpf(1.f + __builtin_amdgcn_exp2f(-2.3022081981f * t)); }
__device__ __forceinline__ f32x4 sigmoid_scaled4(const f32x4 t) {
    const f32x4 e = (f32x4){__builtin_amdgcn_exp2f(t[0]), __builtin_amdgcn_exp2f(t[1]), __builtin_amdgcn_exp2f(t[2]), __builtin_amdgcn_exp2f(t[3])} + 1.0f;
    return (f32x4){__builtin_amdgcn_rcpf(e[0]), __builtin_amdgcn_rcpf(e[1]), __builtin_amdgcn_rcpf(e[2]), __builtin_amdgcn_rcpf(e[3])};
}
__device__ __forceinline__ f32x4 silu4(const f32x4 x) { return x * sigmoid_scaled4(x * -1.4426950408889634f); }
__device__ __forceinline__ f32x4 gelu4(const f32x4 x) { return x * sigmoid_scaled4((x * (x * x * 0.044715f + 1.0f)) * -2.3022081981f); }
__device__ __forceinline__ u32x4 pack8(const f32x4 a, const f32x4 b) { u32x4 w; w.x = cvt_pk_bf16(a[0], a[1]); w.y = cvt_pk_bf16(a[2], a[3]); w.z = cvt_pk_bf16(b[0], b[1]); w.w = cvt_pk_bf16(b[2], b[3]); return w; }
__device__ __forceinline__ f32x4 unpack4(const u32x2 w) { f32x4 r; r[0] = __uint_as_float(w.x << 16); r[1] = __uint_as_float(w.x & 0xffff0000u); r[2] = __uint_as_float(w.y << 16); r[3] = __uint_as_float(w.y & 0xffff0000u); return r; }

__device__ __forceinline__ void stats_from(const f32x4 a, const f32x4 b, float& mean, float& rstd) {
    mean = ((a[0] + a[2]) + (b[0] + b[2])) * 0.25f;
    const float d0 = a[0] - mean, d1 = a[2] - mean, d2 = b[0] - mean, d3 = b[2] - mean;
    rstd = 1.0f / sqrtf((((a[1] + a[3]) + (b[1] + b[3])) + 256.f * ((d0 * d0 + d1 * d1) + (d2 * d2 + d3 * d3))) * (1.f / 1024.f) + 1e-5f);
}
typedef float f32x2t __attribute__((ext_vector_type(2)));
__device__ __forceinline__ void panel_stats_to_lds(const float* st, int pm, PG8_LAS f32x2t* T, int tid) {
    if (tid < 256) { const size_t row = (size_t)(pm * BM + tid); float mean, rstd; stats_from(*(const f32x4*)(st + row * 8), *(const f32x4*)(st + row * 8 + 4), mean, rstd); T[tid] = (f32x2t){mean, rstd}; }
    asm volatile("s_waitcnt lgkmcnt(0)" ::: "memory"); __builtin_amdgcn_s_barrier(); asm volatile("" ::: "memory");
}
__device__ __forceinline__ void fold_ln(f32x4 (&acc)[2][2][4][2], const float* st, const float* c1, const float* c2, const Unit& u, int wr, int wc, int fr, int fq, unsigned tlds) {
    PG8_LAS f32x2t* T = (PG8_LAS f32x2t*)(size_t)tlds;
    const int rl0 = wr * 64 + fr, col0 = u.pn * BM + wc * 32 + 8 * fq;
    f32x4 c1v[2][2], c2v[2][2];
#pragma unroll
    for (int bj = 0; bj < 2; ++bj)
#pragma unroll
        for (int n = 0; n < 2; ++n) { c1v[bj][n] = *(const f32x4*)(c1 + col0 + bj * HALF + 4 * n); c2v[bj][n] = *(const f32x4*)(c2 + col0 + bj * HALF + 4 * n); }
    __builtin_amdgcn_sched_barrier(0);
    panel_stats_to_lds(st, u.pm, T, (wr * 4 + wc) * 64 + fq * 16 + fr);
#pragma unroll
    for (int ai = 0; ai < 2; ++ai)
#pragma unroll
        for (int m = 0; m < 4; ++m) { const f32x2t t = T[ai * HALF + m * 16 + rl0]; const float tq = -t.y * t.x;
#pragma unroll
            for (int bj = 0; bj < 2; ++bj)
#pragma unroll
                for (int n = 0; n < 2; ++n) acc[ai][bj][m][n] = acc[ai][bj][m][n] * t.y + (c1v[bj][n] * tq + c2v[bj][n]); }
}

template <int RESMODE, bool HALFACC> struct EpiZ {
    static constexpr bool PERM = true, AFTER_DRAIN = false;
    const bf16_t* res; const float* stprev; const float* gamma; const float* beta; bf16_t* Z; float* ST; unsigned xlds; static constexpr float racc = HALFACC ? 0.5f : 1.0f;
    __device__ __forceinline__ void operator()(f32x4 (&acc)[2][2][4][2], const Unit& u, int wr, int wc, int fr, int fq) const {
        asm volatile("" : "+v"(fr), "+v"(fq));
        typedef float f32x2v __attribute__((ext_vector_type(2)));
        PG8_LAS f32x2v* P = (PG8_LAS f32x2v*)(size_t)xlds;
        const int rl0 = wr * 64 + fr, col0 = u.pn * BM + wc * 32 + 8 * fq;
        PG8_LAS f32x2t* T = (PG8_LAS f32x2t*)(size_t)(xlds + 8192);
        if (RESMODE == 1) panel_stats_to_lds(stprev, u.pm, T, (wr * 4 + wc) * 64 + fq * 16 + fr);
#pragma unroll
        for (int ai = 0; ai < 2; ++ai) {
            u32x4 raw[4][2];
#pragma unroll
            for (int m = 0; m < 4; ++m) { const size_t off = (size_t)(u.pm * BM + ai * HALF + m * 16 + rl0) * 1024 + col0;
                raw[m][0] = *(const u32x4*)(res + off); raw[m][1] = *(const u32x4*)(res + off + HALF); }
            __builtin_amdgcn_sched_barrier(0);
#pragma unroll
            for (int m = 0; m < 4; ++m) { const int rl = ai * HALF + m * 16 + rl0; const size_t off = (size_t)(u.pm * BM + rl) * 1024 + col0;
                float mu = 0.f, rs = 1.f; if (RESMODE == 1) { const f32x2t t = T[rl]; mu = t.x; rs = t.y; }
                float s = 0.f, q = 0.f;
#pragma unroll
                for (int bj = 0; bj < 2; ++bj) { const u32x4 rw = raw[m][bj];
                    f32x4 r0 = unpack4((u32x2){rw.x, rw.y}), r1 = unpack4((u32x2){rw.z, rw.w});
                    if (RESMODE == 1) { const float* gp = gamma + col0 + bj * HALF; const float* bp = beta + col0 + bj * HALF;
                        r0 = (r0 - mu) * rs * *(const f32x4*)gp + *(const f32x4*)bp; r1 = (r1 - mu) * rs * *(const f32x4*)(gp + 4) + *(const f32x4*)(bp + 4); }
                    const f32x4 z0 = r0 * kAlpha + acc[ai][bj][m][0] * racc, z1 = r1 * kAlpha + acc[ai][bj][m][1] * racc;
                    *(u32x4*)(Z + off + bj * HALF) = pack8(z0, z1);
#pragma unroll
                    for (int i = 0; i < 4; ++i) { s += z0[i] + z1[i]; q += z0[i] * z0[i] + z1[i] * z1[i]; } }
                s += __shfl_xor(s, 16); s += __shfl_xor(s, 32); q += __shfl_xor(q, 16); q += __shfl_xor(q, 32);
                const float mw = s * (1.0f / 64.0f); q = fmaxf(q - s * mw, 0.f);
                if (fq == 0) P[rl * 4 + wc] = (f32x2v){mw, q}; }
            asm volatile("" ::: "memory"); }
        asm volatile("s_waitcnt lgkmcnt(0)" ::: "memory"); __builtin_amdgcn_s_barrier(); asm volatile("" ::: "memory");
        const int tid = (wr * 4 + wc) * 64 + fq * 16 + fr;
        if (tid < 256) { const f32x2v a = P[tid * 4 + 0], b = P[tid * 4 + 1], c = P[tid * 4 + 2], d = P[tid * 4 + 3];
            const float mt = ((a.x + b.x) + (c.x + d.x)) * 0.25f; const float da = a.x - mt, db = b.x - mt, dc = c.x - mt, dd = d.x - mt;
            const float m2 = ((a.y + b.y) + (c.y + d.y)) + 64.0f * ((da * da + db * db) + (dc * dc + dd * dd));
            *(f32x2v*)(ST + ((size_t)(u.pm * BM + tid) * 4 + u.pn) * 2) = (f32x2v){mt, m2}; }
        asm volatile("s_waitcnt lgkmcnt(0)" ::: "memory"); __builtin_amdgcn_s_barrier(); asm volatile("" ::: "memory");
    }
};

template <bool FOLD> struct EpiSwiGLU {
    static constexpr bool PERM = true, AFTER_DRAIN = false;
    bf16_t* H; int ldh; const float* st; const float* c1; const float* c2; unsigned tlds;
    __device__ __forceinline__ void operator()(f32x4 (&acc)[2][2][4][2], const Unit& u, int wr, int wc, int fr, int fq) const {
        asm volatile("" : "+v"(fr), "+v"(fq));
        const int row0 = u.pm * BM + wr * 64 + fr, col0 = u.pn * HALF + wc * 32 + 8 * fq;
        if (FOLD) fold_ln(acc, st, c1, c2, u, wr, wc, fr, fq, tlds);
#pragma unroll
        for (int ai = 0; ai < 2; ++ai)
#pragma unroll
            for (int m = 0; m < 4; ++m) {
                const f32x4 h0 = silu4(acc[ai][0][m][0]) * acc[ai][1][m][0], h1 = silu4(acc[ai][0][m][1]) * acc[ai][1][m][1];
                *(u32x4*)(H + (size_t)(row0 + ai * HALF + m * 16) * ldh + col0) = pack8(h0, h1);
            }
    }
};

struct EpiWin {
    static constexpr bool PERM = true, AFTER_DRAIN = false;
    bf16_t *U, *GV, *Q, *Kb, *VT, *QI, *KI; float *GVST, *WI, *outK, *outV, *outKI; const float *ropeC, *ropeS; const float *st, *c1, *c2; unsigned tlds; int pn_off;
    __device__ __forceinline__ void operator()(f32x4 (&acc)[2][2][4][2], const Unit& u, int wr, int wc, int fr, int fq) const {
        asm volatile("" : "+v"(fr), "+v"(fq));
        const int pn = u.pn + pn_off, rl0 = wr * 64 + fr, rowb = u.pm * BM + rl0, cl = wc * 32 + 8 * fq;
        const int j0 = 4 * (4 * (wc & 1) + fq);
        PG8_LAS f32x2t* T = (PG8_LAS f32x2t*)(size_t)tlds;
        const float* c1p = c1 + pn * BM + cl; const float* c2p = c2 + pn * BM + cl;
        const bool roped = pn >= 4;
        f32x4 cc1[2][2], cc2[2][2];
#pragma unroll
        for (int bj = 0; bj < 2; ++bj)
#pragma unroll
            for (int n = 0; n < 2; ++n) { cc1[bj][n] = *(const f32x4*)(c1p + bj * HALF + 4 * n); cc2[bj][n] = *(const f32x4*)(c2p + bj * HALF + 4 * n); }
        f32x4 rc = (f32x4){1.f, 1.f, 1.f, 1.f}, rsn = (f32x4){0.f, 0.f, 0.f, 0.f};
        if (roped) { const int t0 = rowb & 2047; rc = *(const f32x4*)(ropeC + t0 * 32 + j0); rsn = *(const f32x4*)(ropeS + t0 * 32 + j0); }
        __builtin_amdgcn_sched_barrier(0);
        panel_stats_to_lds(st, u.pm, T, (wr * 4 + wc) * 64 + fq * 16 + fr);
#define WIN_ROW(ai, m) const f32x2t tr_ = T[(ai) * HALF + (m) * 16 + rl0]; const float tq_ = -tr_.y * tr_.x
#define WIN_F(ai, bj, m, n) (acc[ai][bj][m][n] * tr_.y + (cc1[bj][n] * tq_ + cc2[bj][n]))
#define WIN_ROPE_NEXT(ai, m) const f32x4 c = rc, s = rsn; if ((ai) * 4 + (m) < 7) { const int gn_ = (ai) * 4 + (m) + 1; const int tn_ = (rowb + (gn_ >> 2) * HALF + (gn_ & 3) * 16) & 2047; \
            rc = *(const f32x4*)(ropeC + tn_ * 32 + j0); rsn = *(const f32x4*)(ropeS + tn_ * 32 + j0); } __builtin_amdgcn_sched_barrier(0)
        if (pn < 2) {
#pragma unroll
            for (int ai = 0; ai < 2; ++ai)
#pragma unroll
                for (int m = 0; m < 4; ++m) { WIN_ROW(ai, m); bf16_t* p = U + (size_t)(rowb + ai * HALF + m * 16) * 512 + pn * 256 + cl;
#pragma unroll
                    for (int bj = 0; bj < 2; ++bj) { const f32x4 x0 = WIN_F(ai, bj, m, 0), x1 = WIN_F(ai, bj, m, 1);
                        *(u32x4*)(p + bj * HALF) = pack8(gelu4(x0), gelu4(x1)); } }
        } else if (pn < 4) {
#pragma unroll
            for (int ai = 0; ai < 2; ++ai)
#pragma unroll
                for (int m = 0; m < 4; ++m) { WIN_ROW(ai, m); const size_t row = (size_t)(rowb + ai * HALF + m * 16); bf16_t* p = GV + row * 512 + (pn - 2) * 256 + cl;
                    f32x4 g[2][2]; float s = 0.f;
#pragma unroll
                    for (int bj = 0; bj < 2; ++bj) {
#pragma unroll
                        for (int n = 0; n < 2; ++n) { g[bj][n] = gelu4(WIN_F(ai, bj, m, n)); s += (g[bj][n][0] + g[bj][n][1]) + (g[bj][n][2] + g[bj][n][3]); }
                        *(u32x4*)(p + bj * HALF) = pack8(g[bj][0], g[bj][1]); }
                    s += __shfl_xor(s, 16); s += __shfl_xor(s, 32);
                    const float mw = s * (1.0f / 64.0f); float q = 0.f;
#pragma unroll
                    for (int bj = 0; bj < 2; ++bj)
#pragma unroll
                        for (int n = 0; n < 2; ++n)
#pragma unroll
                            for (int i = 0; i < 4; ++i) { const float d = g[bj][n][i] - mw; q += d * d; }
                    q += __shfl_xor(q, 16); q += __shfl_xor(q, 32);
                    if (fq == 0) *(f32x2t*)(GVST + ((row * 2 + (pn - 2)) * 4 + wc) * 2) = (f32x2t){mw, q}; }
        } else if (pn == 4 || pn == 5 || pn == 7) {
            bf16_t* dst = (pn == 7) ? QI : Q + (pn - 4) * 256; const int ld = (pn == 7) ? 256 : 512;
            const float qsc = (pn == 7) ? 1.0f : 0.125f * 1.4426950408889634f;
#pragma unroll
            for (int ai = 0; ai < 2; ++ai)
#pragma unroll
                for (int m = 0; m < 4; ++m) { WIN_ROW(ai, m); const int row = rowb + ai * HALF + m * 16; WIN_ROPE_NEXT(ai, m);
#pragma unroll
                    for (int bj = 0; bj < 2; ++bj) { const f32x4 x1 = WIN_F(ai, bj, m, 0), x2 = WIN_F(ai, bj, m, 1);
                        *(u32x4*)(dst + (size_t)row * ld + bj * HALF + cl) = pack8((x1 * c - x2 * s) * qsc, (x2 * c + x1 * s) * qsc); } }
        } else if (pn == 6) {
#pragma unroll
            for (int ai = 0; ai < 2; ++ai)
#pragma unroll
                for (int m = 0; m < 4; ++m) { WIN_ROW(ai, m); const int row = rowb + ai * HALF + m * 16; const int t = row & 2047; WIN_ROPE_NEXT(ai, m);
                    const f32x4 x1 = WIN_F(ai, 0, m, 0), x2 = WIN_F(ai, 0, m, 1); const f32x4 o1 = x1 * c - x2 * s, o2 = x2 * c + x1 * s;
                    *(u32x4*)(Kb + (size_t)row * 128 + cl) = pack8(o1, o2);
                    float* ok = outK + (size_t)row * 128 + (wc >> 1) * 64 + j0; *(f32x4*)ok = o1; *(f32x4*)(ok + 32) = o2;
                    const f32x4 v0 = WIN_F(ai, 1, m, 0), v1 = WIN_F(ai, 1, m, 1);
                    float* ov = outV + (size_t)row * 128 + cl; *(f32x4*)ov = v0; *(f32x4*)(ov + 4) = v1;
                    bf16_t* vt = VT + ((size_t)((row >> 11) * 2 + (wc >> 1)) * 64 + (cl & 63)) * 2048 + t;
                    const u32x4 w = pack8(v0, v1);
                    vt[0 * 2048] = (bf16_t)(w.x & 0xffff); vt[1 * 2048] = (bf16_t)(w.x >> 16); vt[2 * 2048] = (bf16_t)(w.y & 0xffff); vt[3 * 2048] = (bf16_t)(w.y >> 16);
                    vt[4 * 2048] = (bf16_t)(w.z & 0xffff); vt[5 * 2048] = (bf16_t)(w.z >> 16); vt[6 * 2048] = (bf16_t)(w.w & 0xffff); vt[7 * 2048] = (bf16_t)(w.w >> 16); }
        } else {
            if (wc < 2) {
#pragma unroll
                for (int ai = 0; ai < 2; ++ai)
#pragma unroll
                    for (int m = 0; m < 4; ++m) { WIN_ROW(ai, m); const int row = rowb + ai * HALF + m * 16; WIN_ROPE_NEXT(ai, m);
                        const f32x4 x1 = WIN_F(ai, 0, m, 0), x2 = WIN_F(ai, 0, m, 1); const f32x4 o1 = x1 * c - x2 * s, o2 = x2 * c + x1 * s;
                        *(u32x4*)(KI + (size_t)row * 64 + cl) = pack8(o1, o2);
                        float* ok = outKI + (size_t)row * 64 + j0; *(f32x4*)ok = o1; *(f32x4*)(ok + 32) = o2; }
            } else if (wc == 2 && fq == 0) {
#pragma unroll
                for (int ai = 0; ai < 2; ++ai)
#pragma unroll
                    for (int m = 0; m < 4; ++m) { WIN_ROW(ai, m); const int row = rowb + ai * HALF + m * 16; *(f32x4*)(WI + (size_t)row * 4) = WIN_F(ai, 0, m, 0) * 0.0625f; }
            }
        }
#undef WIN_ROPE_NEXT
        __builtin_amdgcn_s_waitcnt(0x0F70);
#undef WIN_ROW
#undef WIN_F
    }
};
}
constexpr int NWAVES = 8;
#ifndef MK_N_LAUNCHES
#define MK_N_LAUNCHES 1
#endif
constexpr int N_PHASES = 9;
constexpr int N_LAUNCHES = MK_N_LAUNCHES;

constexpr int DM = 1024, NB = 16, SEQ = 2048, MP = NB * SEQ, NS = 128, FF = 2816, INW = 2116, INWP = 2304, PAST = 8192, NPAGE = 64;
constexpr float LN_EPS = 1e-5f, kAlpha = pg8::kAlpha;
constexpr size_t OUT_Y = 0, OUT_YS = 33554432, OUT_KP = 33685504, OUT_VP = 37879808, OUT_KIP = 42074112, OUT_KS = 44171264, OUT_VS = 44187648, OUT_KIS = 44204032, OUT_AV = 44212224, OUT_TOTAL = 44277760;

constexpr size_t MiB = 1u << 20;
constexpr size_t WS_CTL = 0, CTL_ZERO_BYTES = 1 * MiB;
constexpr size_t WS_ROPEC = 1 * MiB, WS_ROPES = WS_ROPEC + 2049 * 32 * 4;
constexpr size_t WS_W1UP = 2 * MiB, WS_W1DN = 13 * MiB, WS_WIN = 19 * MiB, WS_WOUT = 24 * MiB, WS_W2UP = 26 * MiB, WS_W2DN = 37 * MiB;
constexpr size_t WS_XB = 64 * MiB;
constexpr size_t WS_H = 128 * MiB;
constexpr size_t WS_Z1 = 304 * MiB;
constexpr size_t WS_U = 368 * MiB;
constexpr size_t WS_GV = 400 * MiB;
constexpr size_t WS_GVST = 432 * MiB;
constexpr size_t WS_Q = 434 * MiB;
constexpr size_t WS_K = 466 * MiB;
constexpr size_t WS_VT = 474 * MiB;
constexpr size_t WS_QI = 482 * MiB;
constexpr size_t WS_KI = 498 * MiB;
constexpr size_t WS_WI = 502 * MiB;
constexpr size_t WS_MASK = 503 * MiB;
constexpr size_t WS_MIX = 512 * MiB;
constexpr size_t WS_Z2 = 576 * MiB;
constexpr size_t WS_SMP = 644 * MiB;
constexpr size_t SM_HS = WS_SMP, SM_Z1 = SM_HS + 128 * 2816 * 4, SM_ST1 = SM_Z1 + 128 * 1024 * 4, SM_US = SM_ST1 + 128 * 64 * 8, SM_GVS = SM_US + 128 * 512 * 4,
                 SM_QS = SM_GVS + 128 * 512 * 4, SM_QIS = SM_QS + 128 * 512 * 4, SM_WIS = SM_QIS + 128 * 256 * 4, SM_MIXS = SM_WIS + 128 * 4 * 4, SM_Z2 = SM_MIXS + 128 * 1024 * 4,
                 SM_ST2 = SM_Z2 + 128 * 1024 * 4, SM_Z3 = SM_ST2 + 128 * 64 * 8, SM_XSB = SM_Z3 + 128 * 1024 * 4, SM_MIXSB = SM_XSB + 128 * 1024 * 2, SM_Z1B = SM_MIXSB + 128 * 1024 * 2, SM_Z2B = SM_Z1B + 128 * 1024 * 2, SM_END = SM_Z2B + 128 * 1024 * 2;
constexpr size_t WS_Z3 = 304 * MiB;
constexpr size_t WS_STZ3 = 651 * MiB;
constexpr size_t WS_STZ1 = 652 * MiB, WS_STZ2 = 653 * MiB;
constexpr size_t WS_PS = 654 * MiB;
constexpr size_t PS_IN = WS_PS, PS_UP = WS_PS + 2 * 16 * 2304 * 4;
constexpr size_t WS_CV = 656 * MiB;
constexpr size_t CV_C1IN = WS_CV, CV_C2IN = CV_C1IN + 2304 * 4, CV_C1UP = CV_C2IN + 2304 * 4, CV_C2UP = CV_C1UP + 5632 * 4;
constexpr size_t WS_AWSB = 657 * MiB;
constexpr size_t WS_END = 658 * MiB;
static_assert(SM_END <= WS_END, "d_ws map");
constexpr int CW_TMO = 0, CW_CODE = 1;
constexpr int CW_BAR = 4096;
constexpr int CW_QUEUE = 64;

constexpr int RING_OFF = 0, RING_BYTES = 147968;
constexpr int XLDS_OFF = 131072;
constexpr int LDSCTL_OFF = RING_BYTES, MISC_OFF = LDSCTL_OFF + 320;
constexpr int LDS_BYTES = 163840;
static_assert(MISC_OFF + 128 <= LDS_BYTES, "LDS map");
#define GAS __attribute__((address_space(1)))
#define LAS __attribute__((address_space(3)))
typedef unsigned short bf16;
typedef unsigned v4u __attribute__((ext_vector_type(4)));
typedef float f32x4 __attribute__((ext_vector_type(4)));
typedef short bf16x8 __attribute__((ext_vector_type(8)));
typedef GAS unsigned gu32;
typedef GAS unsigned long long gu64;
#define RLX_AGENT __ATOMIC_RELAXED, __HIP_MEMORY_SCOPE_AGENT
#define LDS_WAIT() asm volatile("s_waitcnt lgkmcnt(0)" ::: "memory")
#define VM_WAIT() asm volatile("s_waitcnt vmcnt(0)" ::: "memory")
__device__ __forceinline__ unsigned long long rt() { return __builtin_amdgcn_s_memrealtime(); }
__device__ __forceinline__ unsigned f2bf(float f) { unsigned u = __builtin_bit_cast(unsigned, f); return (u + 0x7fffu + ((u >> 16) & 1u)) >> 16; }
__device__ __forceinline__ unsigned pk2(float lo, float hi) { return f2bf(lo) | (f2bf(hi) << 16); }

#define XB_TMO      128
#define XB_XCNT(j)  (256  + 64 * (j))
#define XB_XSUB(j)  (1280 + 64 * (j))
#define XB_XGEN(j)  (2304 + 64 * (j))
#define XB_TOP      3328
#define XB_TOPGEN   3392
#define XCD_BAR_WORDS 3456
#define XB_SPIN_CAP (1u << 18)

__device__ __forceinline__ unsigned xb_ld(unsigned* p)              { return __hip_atomic_load(p, __ATOMIC_RELAXED, __HIP_MEMORY_SCOPE_AGENT); }
__device__ __forceinline__ unsigned xb_add(unsigned* p, unsigned v) { return __hip_atomic_fetch_add(p, v, __ATOMIC_RELAXED, __HIP_MEMORY_SCOPE_AGENT); }
__device__ __forceinline__ unsigned xb_xcc_id() { return (unsigned)__builtin_amdgcn_s_getreg((3 << 11) | 20) & 0xFu; }
#define XB_SPIN(cond, bar) do { unsigned _sp = 0; while (cond) { __builtin_amdgcn_s_sleep(1); \
    if ((++_sp & 255u) == 0u) { if (xb_ld(&(bar)[XB_TMO])) break; if (_sp > XB_SPIN_CAP) { atomicAdd(&(bar)[XB_TMO], 1u); break; } } } } while (0)

struct XcdBarrier {
    unsigned* bar; unsigned x;
    volatile LAS unsigned* st;
};

__device__ __forceinline__ XcdBarrier xcd_barrier_post(unsigned* bar, volatile LAS unsigned* st) {
    XcdBarrier b; b.bar = bar; b.x = xb_xcc_id(); b.st = st;
    if (threadIdx.x == 0) (void)xb_add(&bar[XB_XCNT(b.x)], 1u);
    return b;
}
__device__ __forceinline__ void xcd_barrier_complete(unsigned* bar, unsigned x, unsigned& nloc, unsigned& nx) {
    const unsigned G = gridDim.x * gridDim.y * gridDim.z;
    unsigned sum, cnt, mine, sp = 0u;
    for (;;) {
        sum = 0u; cnt = 0u; mine = 0u;
#pragma unroll
        for (unsigned j = 0; j < 16; ++j) { const unsigned c = xb_ld(&bar[XB_XCNT(j)]); sum += c; cnt += (c > 0u) ? 1u : 0u; mine = (j == x) ? c : mine; }
        if (sum == G) break;
        __builtin_amdgcn_s_sleep(1);
        if ((++sp & 255u) == 0u) { if (xb_ld(&bar[XB_TMO])) break; if (sp > XB_SPIN_CAP) { atomicAdd(&bar[XB_TMO], 1u); break; } }
    }
    nloc = mine > 0u ? mine : 1u; nx = cnt > 0u ? cnt : 1u;
}

__device__ __forceinline__ void xcd_barrier(const XcdBarrier& b) {
    asm volatile("s_waitcnt vmcnt(0)" ::: "memory");
    __syncthreads();
    if (threadIdx.x == 0) {
        unsigned* bar = b.bar;
        __builtin_amdgcn_s_waitcnt(0);
        unsigned nloc = b.st[0], nx = b.st[1];
        if (nloc == 0u) { xcd_barrier_complete(bar, b.x, nloc, nx); b.st[0] = nloc; b.st[1] = nx; }
        const unsigned old = xb_add(&bar[XB_XSUB(b.x)], 1u);
        const unsigned gen = old / nloc;
        if (old + 1u == (gen + 1u) * nloc) {
            __builtin_amdgcn_fence(__ATOMIC_RELEASE, "agent");
            asm volatile("s_waitcnt vmcnt(0)" ::: "memory");
            const unsigned og = xb_add(&bar[XB_TOP], 1u);
            const unsigned tg = og / nx;
            if (og + 1u == (tg + 1u) * nx) xb_add(&bar[XB_TOPGEN], 1u);
            else XB_SPIN(xb_ld(&bar[XB_TOPGEN]) == tg, bar);
            __builtin_amdgcn_fence(__ATOMIC_ACQUIRE, "agent");
            xb_add(&bar[XB_XGEN(b.x)], 1u);
            asm volatile("s_waitcnt vmcnt(0)" ::: "memory");
        } else {
            XB_SPIN(xb_ld(&bar[XB_XGEN(b.x)]) == gen, bar);
            __builtin_amdgcn_fence(__ATOMIC_ACQUIRE, "agent");
            asm volatile("s_waitcnt vmcnt(0)" ::: "memory");
        }
    }
    __syncthreads();
}
typedef float f32x2 __attribute__((ext_vector_type(2)));
typedef unsigned u32x2 __attribute__((ext_vector_type(2)));
typedef float f32x16 __attribute__((ext_vector_type(16)));
struct Frame {
    LAS unsigned char* lds;
    volatile LAS unsigned* MISC;
    gu32* ctl;
    int tid, lane, wave, vcu, G;
    float* out; unsigned char* ws;
};
struct Args { const void* in[22]; float* out; unsigned char* ws; int ph_lo, ph_hi; };
#define IN_F(k) ((const float*)A.in[k])
__device__ __forceinline__ const float* in_lds(const Frame& F, int k) {
    const volatile LAS unsigned* t = (const volatile LAS unsigned*)(F.lds + LDSCTL_OFF);
    const unsigned lo = (unsigned)__builtin_amdgcn_readfirstlane((int)t[2 * k]), hi = (unsigned)__builtin_amdgcn_readfirstlane((int)t[2 * k + 1]);
    return (const float*)(const GAS float*)(((unsigned long long)hi << 32) | lo);
}
#define IN_L(k) in_lds(F, k)
__device__ __forceinline__ void launder(Frame& F) { unsigned long long w = (unsigned long long)F.ws, o = (unsigned long long)F.out; int t = F.tid, l = F.lane, wv = F.wave; asm volatile("" : "+s"(w), "+s"(o), "+v"(t), "+v"(l), "+s"(wv));
    F.ws = (unsigned char*)(GAS unsigned char*)w; F.out = (float*)(GAS float*)o; F.tid = t; F.lane = l; F.wave = wv; }
enum { I_XP = 0, I_XS, I_CK, I_CV, I_CKI, I_PT, I_LN1G, I_LN1B, I_W1UP, I_W1DN, I_LN2G, I_LN2B, I_WIN, I_ALNG, I_ALNB, I_AWS, I_ABS, I_WOUT, I_LN3G, I_LN3B, I_W2UP, I_W2DN };

__device__ __forceinline__ float wave_sum(float v) {
#pragma unroll
    for (int o = 1; o < 64; o <<= 1) v += __shfl_xor(v, o);
    return v;
}
__device__ __forceinline__ float wave_max(float v) {
#pragma unroll
    for (int o = 1; o < 64; o <<= 1) v = fmaxf(v, __shfl_xor(v, o));
    return v;
}
__device__ __forceinline__ f32x4 mfma16(const bf16x8 a, const bf16x8 b, const f32x4 c) { return __builtin_amdgcn_mfma_f32_16x16x32_bf16(a, b, c, 0, 0, 0); }
__device__ __forceinline__ f32x16 mfma32(const bf16x8 a, const bf16x8 b, const f32x16 c) { return __builtin_amdgcn_mfma_f32_32x32x16_bf16(a, b, c, 0, 0, 0); }
__device__ __forceinline__ bf16x8 as_bf16x8(const v4u w) { return __builtin_bit_cast(bf16x8, w); }

template <int MODE> __device__ __forceinline__ int dest_row(int n) {
    if (MODE == 1) { const int half = n >= FF ? 1 : 0, j = n - half * FF; return 256 * (j >> 7) + 128 * half + (j & 127); }
    if (MODE == 2) { const bool rp = (n >= 1024 && n < 1664) || (n >= 1792 && n < 2112);
        if (rp) { const int base = n & ~63, cc = n & 63; return base + 8 * ((cc & 31) >> 2) + 4 * (cc >> 5) + (cc & 3); }
        return n; }
    return n;
}
template <int MODE, bool FOLD> __device__ __forceinline__ void p0_item(const float* W, int K, int N, int Npad, bf16* WT, LAS float* scr, int item, int lane, const float* gamma, const float* beta, float* ps1, float* ps2) {
    const int nblk = Npad / 32, kb = item / nblk, nb = item % nblk, k0 = 64 * kb, n0 = 32 * nb;
    const int nsrc = n0 + (lane & 31); const bool ok = nsrc < N;
    { float wv[32];
#pragma unroll
      for (int i = 0; i < 32; ++i) { const int kk = 2 * i + (lane >> 5); wv[i] = ok ? __builtin_nontemporal_load(W + (size_t)(k0 + kk) * N + nsrc) : 0.f; }
      __builtin_amdgcn_sched_barrier(0);
#pragma unroll
      for (int i = 0; i < 32; ++i) { const int kk = 2 * i + (lane >> 5); scr[kk * 33 + (lane & 31)] = wv[i]; } }
    LDS_WAIT(); asm volatile("" ::: "memory");
    const int c = lane & 7;
    f32x4 g0 = (f32x4){1.f, 1.f, 1.f, 1.f}, g1 = g0, b0 = (f32x4){0.f, 0.f, 0.f, 0.f}, b1 = b0;
    if (FOLD) { g0 = *(const f32x4*)(gamma + k0 + 8 * c); g1 = *(const f32x4*)(gamma + k0 + 8 * c + 4); b0 = *(const f32x4*)(beta + k0 + 8 * c); b1 = *(const f32x4*)(beta + k0 + 8 * c + 4); }
#pragma unroll
    for (int j = 0; j < 4; ++j) { const int n = (lane >> 3) + 8 * j; const LAS float* s = scr + (8 * c) * 33 + n;
        const float w0 = s[0 * 33], w1 = s[1 * 33], w2 = s[2 * 33], w3 = s[3 * 33], w4 = s[4 * 33], w5 = s[5 * 33], w6 = s[6 * 33], w7 = s[7 * 33];
        v4u o; o.x = pk2(w0 * g0[0], w1 * g0[1]); o.y = pk2(w2 * g0[2], w3 * g0[3]); o.z = pk2(w4 * g1[0], w5 * g1[1]); o.w = pk2(w6 * g1[2], w7 * g1[3]);
        const int dr = dest_row<MODE>(n0 + n);
        *(GAS v4u*)(WT + (size_t)dr * K + k0 + 8 * c) = o;
        if (FOLD) {
            float s1 = ((__uint_as_float(o.x << 16) + __uint_as_float(o.x & 0xffff0000u)) + (__uint_as_float(o.y << 16) + __uint_as_float(o.y & 0xffff0000u)))
                     + ((__uint_as_float(o.z << 16) + __uint_as_float(o.z & 0xffff0000u)) + (__uint_as_float(o.w << 16) + __uint_as_float(o.w & 0xffff0000u)));
            float s2 = ((w0 * b0[0] + w1 * b0[1]) + (w2 * b0[2] + w3 * b0[3])) + ((w4 * b1[0] + w5 * b1[1]) + (w6 * b1[2] + w7 * b1[3]));
            s1 += __shfl_xor(s1, 1); s1 += __shfl_xor(s1, 2); s1 += __shfl_xor(s1, 4); s2 += __shfl_xor(s2, 1); s2 += __shfl_xor(s2, 2); s2 += __shfl_xor(s2, 4);
            if (c == 0) { ps1[(size_t)kb * Npad + dr] = s1; ps2[(size_t)kb * Npad + dr] = s2; }
        } }
    LDS_WAIT(); asm volatile("" ::: "memory");
}
__device__ const float ROPE_INV[32] = {
    1.0f, 0.7498942093324559f, 0.5623413251903491f, 0.4216965034285822f, 0.31622776601683794f, 0.23713737056616552f, 0.1778279410038923f, 0.1333521432163324f,
    0.1f, 0.07498942093324559f, 0.05623413251903491f, 0.04216965034285822f, 0.03162277660168379f, 0.023713737056616554f, 0.01778279410038923f, 0.01333521432163324f,
    0.01f, 0.007498942093324558f, 0.005623413251903491f, 0.004216965034285822f, 0.0031622776601683794f, 0.0023713737056616554f, 0.0017782794100389228f, 0.001333521432163324f,
    0.001f, 0.0007498942093324559f, 0.0005623413251903491f, 0.00042169650342858224f, 0.00031622776601683794f, 0.00023713737056616554f, 0.00017782794100389227f, 0.0001333521432163324f };
__device__ __forceinline__ void p0_prologue(Frame& F, const Args& A) {
    LAS float* scr = (LAS float*)(F.lds + RING_OFF + F.wave * 16384);
    const int gw = F.vcu * NWAVES + F.wave, NGW = F.G * NWAVES;
    unsigned char* ws = F.ws;
    constexpr int I_UP = (DM / 64) * (2 * FF / 32), I_DN = (FF / 64) * (DM / 32), I_IN = (DM / 64) * (INWP / 32);
    constexpr int NITEMS = I_UP + I_DN + I_IN;
    for (int it = gw; it < NITEMS; it += NGW) {
        int r = it;
        if (r < I_UP) { p0_item<1, false>(IN_F(I_W1UP), DM, 2 * FF, 2 * FF, (bf16*)(ws + WS_W1UP), scr, r, F.lane, nullptr, nullptr, nullptr, nullptr); continue; } r -= I_UP;
        if (r < I_DN) { p0_item<0, false>(IN_F(I_W1DN), FF, DM, DM, (bf16*)(ws + WS_W1DN), scr, r, F.lane, nullptr, nullptr, nullptr, nullptr); continue; } r -= I_DN;
        p0_item<2, true>(IN_F(I_WIN), DM, INW, INWP, (bf16*)(ws + WS_WIN), scr, r, F.lane, IN_F(I_LN1G), IN_F(I_LN1B), (float*)(ws + PS_IN), (float*)(ws + PS_IN) + 16 * INWP);
    }
    { const size_t gt = (size_t)F.vcu * (NWAVES * 64) + F.tid, NT = (size_t)F.G * NWAVES * 64; const float* x = IN_F(I_XP); bf16* xb = (bf16*)(ws + WS_XB);
      static_assert(((size_t)MP * DM / 8) % ((size_t)256 * NWAVES * 64 * 8) == 0, "x conversion: whole batches of 8 per thread on a 256-workgroup grid");
      for (size_t e0 = gt; e0 < (size_t)MP * DM / 8; e0 += 8 * NT) {
          f32x4 a[8], b[8];
#pragma unroll
          for (int i = 0; i < 8; ++i) { const size_t e = e0 + (size_t)i * NT; if (e < (size_t)MP * DM / 8) { a[i] = __builtin_nontemporal_load((const f32x4*)(x + e * 8)); b[i] = __builtin_nontemporal_load((const f32x4*)(x + e * 8 + 4)); } }
          __builtin_amdgcn_sched_barrier(0);
#pragma unroll
          for (int i = 0; i < 8; ++i) { const size_t e = e0 + (size_t)i * NT; if (e < (size_t)MP * DM / 8) {
              v4u o; o.x = pk2(a[i][0], a[i][1]); o.y = pk2(a[i][2], a[i][3]); o.z = pk2(b[i][0], b[i][1]); o.w = pk2(b[i][2], b[i][3]); *(GAS v4u*)(xb + e * 8) = o; } } } }
    { const int gt = F.vcu * (NWAVES * 64) + F.tid; const float* x = IN_F(I_XS); bf16* xb = (bf16*)(ws + SM_XSB);
      if (gt < NS * DM / 8) { const f32x4 a = *(const GAS f32x4*)(x + gt * 8), b = *(const GAS f32x4*)(x + gt * 8 + 4);
          v4u o; o.x = pk2(a[0], a[1]); o.y = pk2(a[2], a[3]); o.z = pk2(b[0], b[1]); o.w = pk2(b[2], b[3]); *(GAS v4u*)(xb + gt * 8) = o; } }
    { const int gt = F.vcu * (NWAVES * 64) + F.tid; if (gt < 4 * 128 * 128) { const int t = (gt >> 7) & 127, s = gt & 127; const float v = IN_F(I_AWS)[gt];
          ((bf16*)(ws + WS_AWSB))[gt] = (bf16)f2bf((s > t) ? 0.f : v); } }
    { const int gt = F.vcu * (NWAVES * 64) + F.tid, NT = F.G * NWAVES * 64; float* rc = (float*)(ws + WS_ROPEC); float* rs = (float*)(ws + WS_ROPES);
      for (int e = gt; e < 2049 * 32; e += NT) { const int t = e >> 5, j = e & 31; const float pos = (t == 2048) ? 8192.f : (float)t; const float ang = pos * ROPE_INV[j];
          double rev = (double)ang * 0.15915494309189535; rev -= __builtin_floor(rev); const float fr = (float)rev;
          rc[e] = __builtin_amdgcn_cosf(fr); rs[e] = __builtin_amdgcn_sinf(fr); } }
}

__device__ __forceinline__ void p0_wout(Frame& F, const Args& A, int rank, int nrank) {
    launder(F); unsigned char* ws = F.ws; LAS float* scr = (LAS float*)(F.lds + RING_OFF + F.wave * 16384);
    constexpr int I_OUT = (DM / 64) * (DM / 32);
    for (int it = rank * NWAVES + F.wave; it < I_OUT; it += nrank * NWAVES) p0_item<0, false>(IN_L(I_WOUT), DM, DM, DM, (bf16*)(ws + WS_WOUT), scr, it, F.lane, nullptr, nullptr, nullptr, nullptr);
}
constexpr int LATE_ITEMS = (DM / 64) * (2 * FF / 32) + (FF / 64) * (DM / 32), LATE_UNITS = LATE_ITEMS / NWAVES;
static_assert(LATE_ITEMS % NWAVES == 0, "late weight units");
__device__ __forceinline__ void late_weight_unit(Frame& F, const Args& A, int unit) {
    launder(F); unsigned char* ws = F.ws; LAS float* scr = (LAS float*)(F.lds + RING_OFF + F.wave * 16384);
    constexpr int I_UP = (DM / 64) * (2 * FF / 32);
    const int r = unit * NWAVES + F.wave;
    if (r < I_UP) p0_item<1, true>(IN_L(I_W2UP), DM, 2 * FF, 2 * FF, (bf16*)(ws + WS_W2UP), scr, r, F.lane, IN_L(I_LN2G), IN_L(I_LN2B), (float*)(ws + PS_UP), (float*)(ws + PS_UP) + 16 * 2 * FF);
    else p0_item<0, false>(IN_L(I_W2DN), FF, DM, DM, (bf16*)(ws + WS_W2DN), scr, r - I_UP, F.lane, nullptr, nullptr, nullptr, nullptr);
    asm volatile("s_waitcnt lgkmcnt(0)\n\ts_barrier" ::: "memory");
}
__device__ __forceinline__ void finalize_cvec(Frame& F, int sel) {
    unsigned char* ws = F.ws; const int gt = F.vcu * (NWAVES * 64) + F.tid + (sel ? 2 * INWP : 0);
    if (sel == 0 && gt >= 2 * INWP) return;
    if (gt < 2 * INWP) { const int which = gt / INWP, n = gt % INWP; const float* p = (const float*)(ws + PS_IN) + (size_t)which * 16 * INWP + n; float s = 0.f;
#pragma unroll
        for (int kb = 0; kb < 16; ++kb) s += p[(size_t)kb * INWP];
        ((float*)(ws + (which ? CV_C2IN : CV_C1IN)))[n] = s; }
    else if (gt < 2 * INWP + 4 * FF) { const int g2 = gt - 2 * INWP, which = g2 / (2 * FF), n = g2 % (2 * FF); const float* p = (const float*)(ws + PS_UP) + (size_t)which * 16 * 2 * FF + n; float s = 0.f;
#pragma unroll
        for (int kb = 0; kb < 16; ++kb) s += p[(size_t)kb * 2 * FF];
        ((float*)(ws + (which ? CV_C2UP : CV_C1UP)))[n] = s; }
}

constexpr int TH_RED = 0, TH_STAT = 131072;
__device__ __forceinline__ void thin_rowstats(const float* stat, int row, int fq, float& mean, float& rstd) {
    float s = 0.f, q = 0.f; const f32x4* p = (const f32x4*)((const f32x2*)stat + row * 64 + fq * 16);
    f32x4 v8[8];
#pragma unroll
    for (int i = 0; i < 8; ++i) v8[i] = p[i];
    __builtin_amdgcn_sched_barrier(0);
#pragma unroll
    for (int i = 0; i < 8; ++i) { s += v8[i][0] + v8[i][2]; q += v8[i][1] + v8[i][3]; }
    s += __shfl_xor(s, 16); s += __shfl_xor(s, 32); q += __shfl_xor(q, 16); q += __shfl_xor(q, 32);
    mean = s * (1.f / 1024.f); const float var = fmaxf(q * (1.f / 1024.f) - mean * mean, 0.f); rstd = 1.0f / sqrtf(var + LN_EPS);
}
__device__ __forceinline__ void thin_putstat(float* stat, int row, int unit, int fq, const f32x4 z) {
    float s = (z[0] + z[1]) + (z[2] + z[3]), q = (z[0] * z[0] + z[1] * z[1]) + (z[2] * z[2] + z[3] * z[3]);
    s += __shfl_xor(s, 16); s += __shfl_xor(s, 32); q += __shfl_xor(q, 16); q += __shfl_xor(q, 32);
    if (fq == 0) ((f32x2*)stat)[row * 64 + unit] = (f32x2){s, q};
}
template <int K, int NBR> __device__ __forceinline__ void thin_gemm(Frame& F, f32x4 (&out)[NBR], const bf16* Asrc, const bf16* const (&brow)[NBR]) {
    const int lane = F.lane, fr = lane & 15, fq = lane >> 4, w = F.wave;
    constexpr int KS = K / 8; static_assert(KS % 32 == 0, "K slice");
    f32x4 acc[8][NBR];
#pragma unroll
    for (int rt = 0; rt < 8; ++rt)
#pragma unroll
        for (int nb = 0; nb < NBR; ++nb) acc[rt][nb] = (f32x4){0.f, 0.f, 0.f, 0.f};
    constexpr int NSTEP = KS / 32, BATCH = (K == DM) ? 2 : 4;
#pragma unroll 1
    for (int s0 = 0; s0 < NSTEP; s0 += BATCH) {
        bf16x8 bf[BATCH][NBR], af[BATCH][8];
#pragma unroll
        for (int bi = 0; bi < BATCH; ++bi) if (s0 + bi < NSTEP) { const int k0 = w * KS + 32 * (s0 + bi) + 8 * fq;
#pragma unroll
            for (int nb = 0; nb < NBR; ++nb) bf[bi][nb] = *(const bf16x8*)(brow[nb] + k0);
#pragma unroll
            for (int rt = 0; rt < 8; ++rt) af[bi][rt] = *(const bf16x8*)(Asrc + (size_t)(16 * rt + fr) * K + k0); }
        __builtin_amdgcn_sched_barrier(0);
#pragma unroll
        for (int bi = 0; bi < BATCH; ++bi) if (s0 + bi < NSTEP) {
#pragma unroll
            for (int rt = 0; rt < 8; ++rt)
#pragma unroll
                for (int nb = 0; nb < NBR; ++nb) acc[rt][nb] = mfma16(bf[bi][nb], af[bi][rt], acc[rt][nb]); }
        __builtin_amdgcn_sched_barrier(0);
    }
    LAS f32x4* red = (LAS f32x4*)(F.lds + RING_OFF + TH_RED);
#pragma unroll
    for (int rt = 0; rt < 8; ++rt)
#pragma unroll
        for (int nb = 0; nb < NBR; ++nb) red[((nb * 8 + w) * 128 + 16 * rt + fr) * 4 + fq] = acc[rt][nb];
    __syncthreads();
#pragma unroll
    for (int nb = 0; nb < NBR; ++nb) { f32x4 s = red[((nb * 8 + 0) * 128 + 16 * w + fr) * 4 + fq];
#pragma unroll
        for (int ws = 1; ws < 8; ++ws) s = s + red[((nb * 8 + ws) * 128 + 16 * w + fr) * 4 + fq];
        out[nb] = s; }
    __syncthreads();
}
template <int STAGE> __device__ __forceinline__ void thin_stage(Frame& F, const Args& A, int unit0, int ustride) {
    launder(F); unsigned char* ws = F.ws; const int lane = F.lane, fr = lane & 15, fq = lane >> 4, w = F.wave; const int row = 16 * w + fr;
    constexpr int NU = (STAGE == 1 || STAGE == 7) ? FF / 16 : (STAGE == 3) ? (INW + 15) / 16 : DM / 16;
    bf16* HSB = (bf16*)(ws + SM_HS); float* Z1 = (float*)(ws + SM_Z1); float* ST1 = (float*)(ws + SM_ST1); float* Z2 = (float*)(ws + SM_Z2); float* ST2 = (float*)(ws + SM_ST2); float* Z3 = (float*)(ws + SM_Z3);
    if (unit0 < 0 || unit0 >= NU) return;
    float mean = 0.f, rstd = 1.f, mean1 = 0.f, rstd1 = 1.f;
    if (STAGE == 3 || STAGE == 6) thin_rowstats(ST1, row, fq, mean1, rstd1);
    if (STAGE == 7 || STAGE == 8) thin_rowstats(ST2, row, fq, mean, rstd);
    for (int unit = unit0; unit < NU; unit += ustride) {
        const int c0 = 16 * unit + 4 * fq;
        if (STAGE == 1 || STAGE == 7) {
            const bf16* Bt = (const bf16*)(ws + (STAGE == 1 ? WS_W1UP : WS_W2UP));
            const int rg = 256 * (unit >> 3) + 16 * (unit & 7) + fr;
            const bf16* const brow[2] = {Bt + (size_t)rg * DM, Bt + (size_t)(rg + 128) * DM};
            f32x4 acc[2]; f32x4 c1g = (f32x4){0.f, 0.f, 0.f, 0.f}, c1u = c1g, c2g = c1g, c2u = c1g;
            if (STAGE == 7) { const float* c1 = (const float*)(ws + CV_C1UP) + 256 * (unit >> 3) + 16 * (unit & 7) + 4 * fq; const float* c2 = (const float*)(ws + CV_C2UP) + 256 * (unit >> 3) + 16 * (unit & 7) + 4 * fq;
                c1g = *(const f32x4*)c1; c1u = *(const f32x4*)(c1 + 128); c2g = *(const f32x4*)c2; c2u = *(const f32x4*)(c2 + 128); }
            thin_gemm<DM, 2>(F, acc, (const bf16*)(ws + (STAGE == 1 ? SM_XSB : SM_Z2B)), brow);
            if (STAGE == 7) { const float rm = -rstd * mean;
                acc[0] = acc[0] * rstd + (c1g * rm + c2g); acc[1] = acc[1] * rstd + (c1u * rm + c2u); }
            f32x4 h;
#pragma unroll
            for (int i = 0; i < 4; ++i) h[i] = pg8::silu_f(acc[0][i]) * acc[1][i];
            u32x2 o; o.x = pk2(h[0], h[1]); o.y = pk2(h[2], h[3]); *(u32x2*)(HSB + (size_t)row * FF + c0) = o;
        } else if (STAGE == 2 || STAGE == 8) {
            const bf16* Bt = (const bf16*)(ws + (STAGE == 2 ? WS_W1DN : WS_W2DN));
            const bf16* const brow[1] = {Bt + (size_t)(16 * unit + fr) * FF};
            f32x4 acc[1];
            thin_gemm<FF, 1>(F, acc, HSB, brow);
            f32x4 res = *(const f32x4*)((STAGE == 2 ? IN_L(I_XS) : (const float*)Z2) + (size_t)row * DM + c0);
            if (STAGE == 8) res = (res - mean) * rstd * *(const f32x4*)(IN_L(I_LN2G) + c0) + *(const f32x4*)(IN_L(I_LN2B) + c0);
            const f32x4 z = res * kAlpha + acc[0] * 0.5f;
            *(f32x4*)((STAGE == 2 ? Z1 : Z3) + (size_t)row * DM + c0) = z;
            if (STAGE == 2) { thin_putstat(ST1, row, unit, fq, z); u32x2 o; o.x = pk2(z[0], z[1]); o.y = pk2(z[2], z[3]); *(u32x2*)((bf16*)(ws + SM_Z1B) + (size_t)row * DM + c0) = o; }
        } else if (STAGE == 6) {
            const bf16* Bt = (const bf16*)(ws + WS_WOUT);
            const bf16* const brow[1] = {Bt + (size_t)(16 * unit + fr) * DM};
            f32x4 acc[1];
            const f32x4 z1 = *(const f32x4*)(Z1 + (size_t)row * DM + c0);
            thin_gemm<DM, 1>(F, acc, (const bf16*)(ws + SM_MIXSB), brow);
            const f32x4 x1 = (z1 - mean1) * rstd1 * *(const f32x4*)(IN_L(I_LN1G) + c0) + *(const f32x4*)(IN_L(I_LN1B) + c0);
            const f32x4 z = x1 * kAlpha + acc[0];
            *(f32x4*)(Z2 + (size_t)row * DM + c0) = z;
            thin_putstat(ST2, row, unit, fq, z); { u32x2 o; o.x = pk2(z[0], z[1]); o.y = pk2(z[2], z[3]); *(u32x2*)((bf16*)(ws + SM_Z2B) + (size_t)row * DM + c0) = o; }
        } else {
            const bf16* Bt = (const bf16*)(ws + WS_WIN);
            const bf16* const brow[1] = {Bt + (size_t)(16 * unit + fr) * DM};
            f32x4 acc[1];
            const f32x4 c1v = *(const f32x4*)((const float*)(ws + CV_C1IN) + c0), c2v = *(const f32x4*)((const float*)(ws + CV_C2IN) + c0);
            thin_gemm<DM, 1>(F, acc, (const bf16*)(ws + SM_Z1B), brow);
            const f32x4 v = acc[0] * rstd1 + (c1v * (-rstd1 * mean1) + c2v);
            const bool roped = (c0 >= 1024 && c0 < 1664) || (c0 >= 1792 && c0 < 2112);
            f32x4 pr;
#pragma unroll
            for (int i = 0; i < 4; ++i) pr[i] = __shfl_xor(v[i], 16);
            if (c0 < 512) { f32x4 o;
#pragma unroll
                for (int i = 0; i < 4; ++i) o[i] = pg8::gelu_f(v[i]);
                *(f32x4*)((float*)(ws + SM_US) + (size_t)row * 512 + c0) = o;
            } else if (c0 < 1024) { f32x4 o;
#pragma unroll
                for (int i = 0; i < 4; ++i) o[i] = pg8::gelu_f(v[i]);
                *(f32x4*)((float*)(ws + SM_GVS) + (size_t)row * 512 + (c0 - 512)) = o;
            } else if (roped) {
                const int base = c0 & ~63, p = c0 & 63, g = p >> 3, n = (p >> 2) & 1;
                const f32x4 c = *(const f32x4*)((const float*)(ws + WS_ROPEC) + 2048 * 32 + 4 * g), s = *(const f32x4*)((const float*)(ws + WS_ROPES) + 2048 * 32 + 4 * g);
                const f32x4 o = n ? (v * c + pr * s) : (v * c - pr * s);
                const int oc = base + 32 * n + 4 * g;
                float* dst;
                if (oc < 1536) dst = (float*)(ws + SM_QS) + (size_t)row * 512 + (oc - 1024);
                else if (oc < 1664) dst = F.out + OUT_KS + (size_t)row * 128 + (oc - 1536);
                else if (oc < 2048) dst = (float*)(ws + SM_QIS) + (size_t)row * 256 + (oc - 1792);
                else dst = F.out + OUT_KIS + (size_t)row * 64 + (oc - 2048);
                *(f32x4*)dst = o;
            } else if (c0 < 1792) { *(f32x4*)(F.out + OUT_VS + (size_t)row * 128 + (c0 - 1664)) = v;
            } else if (c0 == 2112) { *(f32x4*)((float*)(ws + SM_WIS) + (size_t)row * 4) = v * 0.0625f; }
        }
    }
}
__device__ __forceinline__ void thin_final_ln(Frame& F, const Args& A) {
    const int gw = (F.G - 1 - F.vcu) * NWAVES + F.wave; if (gw >= NS) return;
    const float* z = (const float*)(F.ws + SM_Z3) + (size_t)gw * DM; const GAS f32x4* zr = (const GAS f32x4*)z + F.lane;
    f32x4 v[4]; float s = 0.f;
#pragma unroll
    for (int j = 0; j < 4; ++j) { v[j] = zr[64 * j]; s += (v[j].x + v[j].y) + (v[j].z + v[j].w); }
    const float mean = wave_sum(s) * (1.f / DM); float s2 = 0.f;
#pragma unroll
    for (int j = 0; j < 4; ++j) { v[j] = v[j] - mean; s2 += (v[j].x * v[j].x + v[j].y * v[j].y) + (v[j].z * v[j].z + v[j].w * v[j].w); }
    const float rstd = 1.f / sqrtf(wave_sum(s2) * (1.f / DM) + LN_EPS);
    const f32x4* g = (const f32x4*)IN_L(I_LN3G) + F.lane; const f32x4* b = (const f32x4*)IN_L(I_LN3B) + F.lane; f32x4* o = (f32x4*)(F.out + OUT_YS + (size_t)gw * DM) + F.lane;
#pragma unroll
    for (int j = 0; j < 4; ++j) o[64 * j] = v[j] * rstd * g[64 * j] + b[64 * j];
}

__device__ __forceinline__ void final_ln_rows(Frame& F, const Args& A) {
    launder(F); unsigned char* ws = F.ws; const int lane = F.lane;
    const int gw = F.vcu * NWAVES + F.wave, NGW = F.G * NWAVES;
    const float* g3 = IN_L(I_LN3G); const float* b3 = IN_L(I_LN3B);
    f32x4 gv[4], bv[4];
#pragma unroll
    for (int j = 0; j < 4; ++j) { gv[j] = *(const f32x4*)(g3 + 256 * j + 4 * lane); bv[j] = *(const f32x4*)(b3 + 256 * j + 4 * lane); }
    const bf16* Z = (const bf16*)(ws + WS_Z3); const float* ST = (const float*)(ws + WS_STZ3);
#pragma unroll 1
    for (int row0 = gw; row0 < MP; row0 += 4 * NGW) {
        u32x2 raw[4][4]; f32x4 sa[4], sb[4];
#pragma unroll
        for (int r = 0; r < 4; ++r) { const size_t row = (size_t)row0 + (size_t)r * NGW; if (row < (size_t)MP) { sa[r] = *(const f32x4*)(ST + row * 8); sb[r] = *(const f32x4*)(ST + row * 8 + 4);
#pragma unroll
            for (int j = 0; j < 4; ++j) raw[r][j] = __builtin_nontemporal_load((const u32x2*)(Z + row * DM + 256 * j + 4 * lane)); } }
        __builtin_amdgcn_sched_barrier(0);
#pragma unroll
        for (int r = 0; r < 4; ++r) { const size_t row = (size_t)row0 + (size_t)r * NGW; if (row < (size_t)MP) { float mu, rs; pg8::stats_from(sa[r], sb[r], mu, rs);
            float* o = F.out + OUT_Y + row * DM + 4 * lane;
#pragma unroll
            for (int j = 0; j < 4; ++j) __builtin_nontemporal_store((pg8::unpack4(raw[r][j]) - mu) * rs * gv[j] + bv[j], (f32x4*)(o + 256 * j)); } }
    }
}
constexpr int GM_LD = 136;
__device__ __forceinline__ void gmlp_unit(Frame& F, const Args& A, int b, int c, int g) {
    launder(F); unsigned char* ws = F.ws; const int tid = F.tid, lane = F.lane, fr = lane & 15, fq = lane >> 4, w = F.wave;
    LAS bf16* wsA = (LAS bf16*)(F.lds + RING_OFF); LAS bf16* vnT = wsA + 128 * GM_LD;
    const int m0 = b * SEQ + 128 * c;
    const int s_ = tid >> 2, dq_ = tid & 3; const size_t row_ = (size_t)(m0 + s_);
    const f32x4* st = (const f32x4*)((const float*)(ws + WS_GVST) + row_ * 16);
    const bf16* gv = (const bf16*)(ws + WS_GV) + row_ * 512 + 128 * g + 32 * dq_;
    f32x4 stv[4]; v4u raw4[4];
    {
        const int t = tid >> 2, sb = 32 * (tid & 3); const bf16* src = (const bf16*)(ws + WS_AWSB) + ((size_t)(g * 128 + t) * 128 + sb);
        v4u wv4[4];
#pragma unroll
        for (int i = 0; i < 4; ++i) wv4[i] = *(const v4u*)(src + 8 * i);
#pragma unroll
        for (int i = 0; i < 4; ++i) { stv[i] = st[i]; raw4[i] = *(const v4u*)(gv + 8 * i); }
        __builtin_amdgcn_sched_barrier(0);
#pragma unroll
        for (int i = 0; i < 4; ++i) *(LAS v4u*)(wsA + t * GM_LD + sb + 8 * i) = wv4[i];
    }
    {
        const int s = s_, dq = dq_;
        const f32x4 p0 = stv[0], p1 = stv[1], p2 = stv[2], p3 = stv[3];
        const float mean = ((p0[0] + p0[2]) + (p1[0] + p1[2]) + (p2[0] + p2[2]) + (p3[0] + p3[2])) * 0.125f;
        float m2 = (p0[1] + p0[3]) + (p1[1] + p1[3]) + (p2[1] + p2[3]) + (p3[1] + p3[3]);
        { const float d0 = p0[0] - mean, d1 = p0[2] - mean, d2 = p1[0] - mean, d3 = p1[2] - mean, d4 = p2[0] - mean, d5 = p2[2] - mean, d6 = p3[0] - mean, d7 = p3[2] - mean;
          m2 += 64.f * ((d0 * d0 + d1 * d1) + (d2 * d2 + d3 * d3) + (d4 * d4 + d5 * d5) + (d6 * d6 + d7 * d7)); }
        const float rstd = 1.0f / sqrtf(m2 * (1.f / 512.f) + LN_EPS);
        const float* lg = IN_L(I_ALNG) + 128 * g + 32 * dq; const float* lb = IN_L(I_ALNB) + 128 * g + 32 * dq;
#pragma unroll
        for (int i = 0; i < 4; ++i) { const v4u raw = raw4[i];
            const f32x4 x0 = pg8::unpack4((u32x2){raw.x, raw.y}), x1 = pg8::unpack4((u32x2){raw.z, raw.w});
            const f32x4 g0 = *(const f32x4*)(lg + 8 * i), g1 = *(const f32x4*)(lg + 8 * i + 4), b0 = *(const f32x4*)(lb + 8 * i), b1 = *(const f32x4*)(lb + 8 * i + 4);
            const f32x4 y0 = (x0 - mean) * rstd * g0 + b0, y1 = (x1 - mean) * rstd * g1 + b1;
            const int d = 32 * dq + 8 * i;
#pragma unroll
            for (int e = 0; e < 4; ++e) { vnT[(d + e) * GM_LD + s] = (bf16)f2bf(y0[e]); vnT[(d + 4 + e) * GM_LD + s] = (bf16)f2bf(y1[e]); } }
    }
    __syncthreads();
    {
        f32x4 acc[8];
#pragma unroll
        for (int dt = 0; dt < 8; ++dt) acc[dt] = (f32x4){0.f, 0.f, 0.f, 0.f};
        const int t = 16 * w + fr; const size_t row = (size_t)(m0 + t); const float bias = IN_L(I_ABS)[g * 128 + t];
        const bf16* up = (const bf16*)(ws + WS_U) + row * 512 + 128 * g + 4 * fq; bf16* op = (bf16*)(ws + WS_MIX) + row * 1024 + 128 * g + 4 * fq;
        u32x2 u8[8];
#pragma unroll
        for (int dt = 0; dt < 8; ++dt) u8[dt] = *(const u32x2*)(up + 16 * dt);
        __builtin_amdgcn_sched_barrier(0);
        const int nsteps = (w + 2) >> 1;
        for (int st = 0; st < nsteps; ++st) { const int s0 = 32 * st + 8 * fq;
            const bf16x8 bfr = *(const LAS bf16x8*)(wsA + (16 * w + fr) * GM_LD + s0);
#pragma unroll
            for (int dt = 0; dt < 8; ++dt) { const bf16x8 afr = *(const LAS bf16x8*)(vnT + (16 * dt + fr) * GM_LD + s0); acc[dt] = mfma16(afr, bfr, acc[dt]); } }
        __builtin_amdgcn_sched_barrier(0);
#pragma unroll
        for (int dt = 0; dt < 8; ++dt) { const f32x4 uu = pg8::unpack4(u8[dt]); const f32x4 o = uu * (acc[dt] + bias);
            u32x2 wv; wv.x = pk2(o[0], o[1]); wv.y = pk2(o[2], o[3]); *(u32x2*)(op + 16 * dt) = wv; }
    }
    asm volatile("s_waitcnt lgkmcnt(0)\n\ts_barrier" ::: "memory");
}

__device__ __forceinline__ unsigned ord_f32(float x) { unsigned u = __float_as_uint(x); if (u == 0x80000000u) u = 0u; return (u & 0x80000000u) ? ~u : (u | 0x80000000u); }
__device__ __forceinline__ unsigned ord_f32_nz(float x) { const unsigned u = __float_as_uint(x); return u ^ ((unsigned)((int)u >> 31) | 0x80000000u); }
constexpr int SC_LD = 2052;
constexpr int TA_SC = 0, TA_MASK = 16 * SC_LD * 4, TA_END = TA_MASK + 64 * 64 * 4;
static_assert(TA_END <= RING_BYTES, "topk/attention LDS");
__device__ __forceinline__ void cnt_ge(unsigned& c, unsigned x, unsigned T) {
    asm volatile("v_cmp_le_u32_e32 vcc, %2, %1\n\ts_nop 1\n\tv_addc_co_u32_e32 %0, vcc, 0, %0, vcc" : "+v"(c) : "v"(x), "s"(T) : "vcc");
}
__device__ __forceinline__ unsigned wave_sum_u32(unsigned v) {
    v += (unsigned)__builtin_amdgcn_update_dpp(0, (int)v, 0xB1, 0xF, 0xF, true);
    v += (unsigned)__builtin_amdgcn_update_dpp(0, (int)v, 0x4E, 0xF, 0xF, true);
    v += (unsigned)__builtin_amdgcn_update_dpp(0, (int)v, 0x141, 0xF, 0xF, true);
    v += (unsigned)__builtin_amdgcn_update_dpp(0, (int)v, 0x140, 0xF, 0xF, true);
    return (unsigned)__builtin_amdgcn_readlane((int)v, 0) + (unsigned)__builtin_amdgcn_readlane((int)v, 16) + (unsigned)__builtin_amdgcn_readlane((int)v, 32) + (unsigned)__builtin_amdgcn_readlane((int)v, 48);
}
__device__ __forceinline__ void transpose32(unsigned (&a)[32]) {
#define T32_STAGE(J, M) _Pragma("unroll") for (int k = 0; k < 32; ++k) if (!(k & (J))) { const unsigned lo = a[k], hi = a[k + (J)]; a[k] = (lo & (M)) | ((hi << (J)) & ~(M)); a[k + (J)] = ((lo >> (J)) & (M)) | (hi & ~(M)); }
    T32_STAGE(16, 0x0000FFFFu) T32_STAGE(8, 0x00FF00FFu) T32_STAGE(4, 0x0F0F0F0Fu) T32_STAGE(2, 0x33333333u) T32_STAGE(1, 0x55555555u)
#undef T32_STAGE
}
template <int J> __device__ __forceinline__ void ties_by_index(unsigned cand, int need, int base, unsigned& sel) {
    if constexpr (J < 32) { const bool tb = ((cand >> J) & 1u) != 0u; const unsigned long long tie = __ballot(tb);
        const int rank = base + (int)__builtin_amdgcn_mbcnt_hi((unsigned)(tie >> 32), __builtin_amdgcn_mbcnt_lo((unsigned)tie, 0u));
        sel |= ((unsigned)tb & (unsigned)(rank < need)) << J;
        ties_by_index<J + 1>(cand, need, base + __builtin_popcountll(tie), sel); }
}
__device__ __forceinline__ void select_rows(const LAS float* sc, LAS unsigned* mask16, int qbase, int w, int lane) {
    const int ra = 2 * w, rb = 2 * w + 1, qa = qbase + ra, qb = qbase + rb;
    unsigned PA[32], PB[32];
#pragma unroll
    for (int i = 0; i < 32; ++i) { const int k = 64 * i + lane; PA[i] = __float_as_uint(sc[ra * SC_LD + k]); PB[i] = __float_as_uint(sc[rb * SC_LD + k]); }
    __builtin_amdgcn_sched_barrier(0);
#pragma unroll
    for (int i = 0; i < 32; ++i) { const int k = 64 * i + lane; PA[i] = (k <= qa) ? ord_f32_nz(__uint_as_float(PA[i])) : 0u; PB[i] = (k <= qb) ? ord_f32_nz(__uint_as_float(PB[i])) : 0u; }
    transpose32(PA); transpose32(PB);
    unsigned candA = ~0u, candB = ~0u, selA = 0u, selB = 0u; int abA = 0, abB = 0;
#pragma unroll
    for (int b = 31; b >= 0; --b) {
        const unsigned tA = candA & PA[b], tB = candB & PB[b];
        const unsigned tot = wave_sum_u32((unsigned)__builtin_popcount(tA) | ((unsigned)__builtin_popcount(tB) << 16));
        { const int nA = abA + (int)(tot & 0xffffu); const bool take = nA >= 256, ex = nA == 256;
          selA |= (take && !ex) ? 0u : tA; candA = take ? (ex ? 0u : tA) : (candA & ~PA[b]); abA = take ? (ex ? 256 : abA) : nA; }
        { const int nB = abB + (int)(tot >> 16); const bool take = nB >= 256, ex = nB == 256;
          selB |= (take && !ex) ? 0u : tB; candB = take ? (ex ? 0u : tB) : (candB & ~PB[b]); abB = take ? (ex ? 256 : abB) : nB; }
        if (abA == 256 && abB == 256) break;
    }
    {
        const unsigned tot = wave_sum_u32((unsigned)__builtin_popcount(candA) | ((unsigned)__builtin_popcount(candB) << 16));
        const int needA = 256 - abA, needB = 256 - abB;
        if ((int)(tot & 0xffffu) == needA) selA |= candA; else ties_by_index<0>(candA, needA, 0, selA);
        if ((int)(tot >> 16) == needB) selB |= candB; else ties_by_index<0>(candB, needB, 0, selB);
    }
    mask16[ra * 64 + lane] = selA; mask16[rb * 64 + lane] = selB;
}
__device__ __forceinline__ void topk_load_k(Frame& F, int b, int ntile_max, bf16x8 (&k0)[8], bf16x8 (&k1)[8]) {
    launder(F); const int lane = F.lane, fr = lane & 15, fq = lane >> 4, w = F.wave;
    const bf16* kib = (const bf16*)(F.ws + WS_KI) + ((size_t)b * SEQ + fr) * 64 + 8 * fq;
#pragma unroll
    for (int i = 0; i < 8; ++i) { const int kt = w + NWAVES * i; k0[i] = bf16x8{}; k1[i] = bf16x8{}; if (kt < ntile_max) { const bf16* kp = kib + (size_t)kt * 16 * 64; k0[i] = *(const bf16x8*)kp; k1[i] = *(const bf16x8*)(kp + 32); } }
    __builtin_amdgcn_sched_barrier(0);
}
__device__ __forceinline__ void topk16(Frame& F, int b, int q0, LAS unsigned* mask16, const bf16x8 (&kh0)[8], const bf16x8 (&kh1)[8]) {
    launder(F); unsigned char* ws = F.ws; const int lane = F.lane, fr = lane & 15, fq = lane >> 4, w = F.wave;
    const size_t rowq = (size_t)b * SEQ + q0;
    if (q0 < 256) {
#pragma unroll
        for (int rr = 0; rr < 2; ++rr) { const int r = 2 * w + rr, q = q0 + r; const int d = q - lane;
            mask16[r * 64 + lane] = (d < 0) ? 0u : ((2u << (d >> 6)) - 1u); }
        return;
    }
    LAS float* sc = (LAS float*)(F.lds + RING_OFF + TA_SC);
    {
        const bf16* qip = (const bf16*)(ws + WS_QI) + (rowq + fr) * 256 + 8 * fq;
        bf16x8 qf[4][2];
#pragma unroll
        for (int h = 0; h < 4; ++h) { qf[h][0] = *(const bf16x8*)(qip + 64 * h); qf[h][1] = *(const bf16x8*)(qip + 64 * h + 32); }
        const f32x4 wq = *(const f32x4*)((const float*)(ws + WS_WI) + (rowq + fr) * 4);
        const int ntile = (q0 >> 4) + 1;
        const bf16* kib = (const bf16*)(ws + WS_KI) + ((size_t)b * SEQ + fr) * 64 + 8 * fq;
        bf16x8 k0[8], k1[8];
#pragma unroll
        for (int i = 0; i < 8; ++i) { const int kt = w + 64 + NWAVES * i; if (kt < ntile) { const bf16* kp = kib + (size_t)kt * 16 * 64; k0[i] = *(const bf16x8*)kp; k1[i] = *(const bf16x8*)(kp + 32); } }
        __builtin_amdgcn_sched_barrier(0);
#define TOPK_TILE(KA, KB, kt) { f32x4 s = (f32x4){0.f, 0.f, 0.f, 0.f}; \
            _Pragma("unroll") for (int h = 0; h < 4; ++h) { f32x4 d = mfma16(KA, qf[h][0], (f32x4){0.f, 0.f, 0.f, 0.f}); d = mfma16(KB, qf[h][1], d); \
                _Pragma("unroll") for (int e = 0; e < 4; ++e) s[e] = __builtin_fmaf(wq[h], fmaxf(d[e], 0.f), s[e]); } \
            *(LAS f32x4*)(sc + fr * SC_LD + 16 * (kt) + 4 * fq) = s; }
#pragma unroll
        for (int i = 0; i < 8; ++i) { const int kt = w + NWAVES * i; if (kt < ntile) TOPK_TILE(kh0[i], kh1[i], kt) }
        __builtin_amdgcn_sched_barrier(0);
#pragma unroll
        for (int i = 0; i < 8; ++i) { const int kt = w + 64 + NWAVES * i; if (kt < ntile) TOPK_TILE(k0[i], k1[i], kt) }
#undef TOPK_TILE
    }
    __syncthreads();
    select_rows(sc, mask16, q0, w, lane);
    __syncthreads();
}

typedef float f32x8 __attribute__((ext_vector_type(8)));
constexpr int AT_SLOTB = 8192, AT_LK = 0, AT_LV = 3 * AT_SLOTB, AT_MT = 6 * AT_SLOTB, AT_QS = AT_MT + 32 * 128 * 4, AT_END = AT_QS + 8 * 4096;
static_assert(AT_END <= TA_MASK, "attention rings + tile-major mask overlay the score image");
__device__ __forceinline__ void at_glds16(const void* g, unsigned lds_dst) { unsigned keep;
    asm volatile("s_mov_b32 %0, m0\n\ts_mov_b32 m0, %2\n\ts_nop 0\n\tglobal_load_lds_dwordx4 %1, off\n\ts_mov_b32 m0, %0" : "=&s"(keep) : "v"(g), "s"(lds_dst) : "memory"); }
__device__ __forceinline__ void at_kload2(bf16x8* kf, const LAS char* kp, int j) { kf[2 * j] = *(const LAS bf16x8*)(kp + j * 2048); kf[2 * j + 1] = *(const LAS bf16x8*)(kp + j * 2048 + 512); }
#define AT_MX3(a, b, c) __builtin_fmaxf(__builtin_fmaxf((a), (b)), (c))
__device__ __forceinline__ float at_rowmax(const f32x16& p0, const f32x16& p1) {
    float a = AT_MX3(p0[0], p0[1], p1[0]), b = AT_MX3(p0[2], p0[3], p1[1]); a = AT_MX3(a, p1[2], p1[3]);
#pragma unroll
    for (int r = 4; r < 16; r += 4) { a = AT_MX3(a, p0[r], p0[r + 1]); b = AT_MX3(b, p0[r + 2], p0[r + 3]); a = AT_MX3(a, p1[r], p1[r + 1]); b = AT_MX3(b, p1[r + 2], p1[r + 3]); }
    const float m = __builtin_fmaxf(a, b); auto rr = __builtin_amdgcn_permlane32_swap(__float_as_uint(m), __float_as_uint(m), false, false);
    return __builtin_fmaxf(__uint_as_float(rr[0]), __uint_as_float(rr[1])); }
__device__ __forceinline__ void mask_to_tiles(Frame& F, const LAS unsigned* mask64) {
    const int tid = F.tid;
    if (tid < 128) { const int row = tid >> 1, hf = tid & 1;
        const LAS v4u* mp = (const LAS v4u*)(mask64 + row * 64 + 4 * hf);
        unsigned a[32];
#pragma unroll
        for (int kh = 0; kh < 2; ++kh)
#pragma unroll
            for (int i4 = 0; i4 < 4; ++i4) { const v4u v = mp[8 * kh + 2 * i4]; a[8 * kh + 2 * i4] = v.x; a[8 * kh + 2 * i4 + 16] = v.y; a[8 * kh + 2 * i4 + 1] = v.z; a[8 * kh + 2 * i4 + 17] = v.w; }
        transpose32(a);
        LAS unsigned* mt = (LAS unsigned*)(F.lds + RING_OFF + AT_MT) + tid;
#pragma unroll
        for (int t = 0; t < 32; ++t) mt[t * 128] = a[t]; }
}
#define AT_SBAR() __builtin_amdgcn_sched_barrier(0)
#define AT_PIN(x) asm volatile("" : "+v"(x))
#define AT_WAIT_BAR(N) asm volatile("s_waitcnt vmcnt(" #N ") lgkmcnt(0)\n\ts_barrier" ::: "memory")
#define AT_MEXP(v, pos, W) __uint_as_float(__float_as_uint(__builtin_amdgcn_exp2f(v)) & (unsigned)__builtin_amdgcn_sbfe((int)(W), (pos), 1))
#define AT_PMASK(j, W) ({ unsigned m_; if ((j) == 15) asm("v_pk_ashrrev_i16 %0, 15, %1 op_sel_hi:[0,1]" : "=v"(m_) : "v"(W)); \
    else asm("v_pk_lshlrev_b16 %0, %2, %1 op_sel_hi:[0,1]\n\tv_pk_ashrrev_i16 %0, 15, %0 op_sel_hi:[0,1]" : "=v"(m_) : "v"(W), "n"(15 - (j))); m_; })
#ifdef PROBE_DUPMASK
#define AT_MEXPC(v, pos, W) ({ unsigned m_, m2_; asm("v_bfe_i32 %0, %1, %2, 1" : "=v"(m_) : "v"(W), "n"(pos)); unsigned r_ = __float_as_uint(__builtin_amdgcn_exp2f(v)) & m_; asm volatile("v_bfe_i32 %0, %2, %3, 1\n\tv_and_b32 %1, %1, %0" : "=&v"(m2_), "+v"(r_) : "v"(W), "n"(pos)); __uint_as_float(r_); })
#else
#define AT_MEXPC(v, pos, W) ({ unsigned m_; asm("v_bfe_i32 %0, %1, %2, 1" : "=v"(m_) : "v"(W), "n"(pos)); __uint_as_float(__float_as_uint(__builtin_amdgcn_exp2f(v)) & m_); })
#endif
__device__ __forceinline__ void attn_unit(Frame& F, int b, int qt, int g) {
    launder(F); unsigned char* ws = F.ws; const int lane = F.lane, r32 = lane & 31, hi = lane >> 5; const int wid = __builtin_amdgcn_readfirstlane(F.wave);
    const int hh = wid & 3, qs = wid >> 2, head = 4 * g + hh, q0 = 64 * qt + 32 * qs; const size_t qrow = (size_t)b * SEQ + q0 + r32;
    const int NT = qt + 1;
    const LAS char* shm = (const LAS char*)(F.lds + RING_OFF); const unsigned lds0 = (unsigned)(size_t)shm;
    const bf16* ksrc = (const bf16*)(ws + WS_K) + ((size_t)b * SEQ + lane) * 128 + 64 * g + 8 * wid;
    const bf16* vsrc = (const bf16*)(ws + WS_VT) + ((size_t)(b * 2 + g) * 64 + lane) * 2048 + 8 * wid;
    const unsigned kdst = lds0 + AT_LK + wid * 1024, vdst = lds0 + AT_LV + wid * 1024;
#define DMA_K(t, slot) at_glds16(ksrc + (size_t)min((int)(t), NT - 1) * (64 * 128), (unsigned)__builtin_amdgcn_readfirstlane((int)(kdst + (slot))))
#define DMA_V(t, slot) at_glds16(vsrc + min((int)(t), NT - 1) * 64, (unsigned)__builtin_amdgcn_readfirstlane((int)(vdst + (slot))))
    const LAS char* kp0 = shm + AT_LK + hi * 1024 + r32 * 16;
    const LAS char* vp0 = shm + AT_LV + r32 * 16 + hi * 8;
    const LAS unsigned* mT = (const LAS unsigned*)(shm + AT_MT) + 2 * (32 * qs + r32) + hi;
    DMA_K(0, 0); DMA_V(0, 0); DMA_K(1, AT_SLOTB);
    bf16x8 qr[4];
    const LAS char* qsp = shm + AT_QS + wid * 4096 + lane * 16;
    { const bf16* qp = (const bf16*)(ws + WS_Q) + qrow * 512 + 64 * head + 8 * hi;
#pragma unroll
      for (int ks = 0; ks < 4; ++ks) qr[ks] = *(const bf16x8*)(qp + 16 * ks);
#pragma unroll
      for (int ks = 0; ks < 4; ++ks) *(LAS bf16x8*)(shm + AT_QS + wid * 4096 + lane * 16 + ks * 1024) = qr[ks]; }
#define QRD(i) do { qv[i] = *(const LAS bf16x8*)(qsp + ((i) & 3) * 1024); } while (0)
    float mhat = 0.f, fsc = 1.f; f32x16 o[2]; o[0] = f32x16{}; o[1] = f32x16{}; f32x16 negm = f32x16{}; AT_PIN(negm);
    f32x16 lacc = f32x16{};
    v4u onesw = (v4u){0x3F803F80u, 0x3F803F80u, 0x3F803F80u, 0x3F803F80u}; AT_PIN(onesw);
    bool resc = false;
    f32x16 pA0, pA1, pB0, pB1; bf16x8 kf[8]; u32x2 vlo[8], vhi[8]; v4u pw0, pw1, pw2, pw3;
    int sl_prev = 0, sl_cur = 0, sl_next = AT_SLOTB;
#define ROT() do { sl_prev = sl_cur; sl_cur = sl_next; sl_next = (sl_next == 2 * AT_SLOTB) ? 0 : sl_next + AT_SLOTB; } while (0)
#define RESC() do { if (resc) { o[0] = o[0] * fsc; o[1] = o[1] * fsc; lacc = lacc * fsc; } } while (0)
    DMA_K(2, 2 * AT_SLOTB);
    AT_WAIT_BAR(3);
#pragma unroll
    for (int d0 = 0; d0 < 4; ++d0) at_kload2(kf, kp0, d0);
    pA0 = mfma32(kf[0], qr[0], negm); pA1 = mfma32(kf[1], qr[0], negm); pA0 = mfma32(kf[2], qr[1], pA0); pA1 = mfma32(kf[3], qr[1], pA1);
    pA0 = mfma32(kf[4], qr[2], pA0); pA1 = mfma32(kf[5], qr[2], pA1); pA0 = mfma32(kf[6], qr[3], pA0); pA1 = mfma32(kf[7], qr[3], pA1);
    { const float rm = at_rowmax(pA0, pA1); mhat = rm;
#pragma unroll
      for (int r = 0; r < 16; ++r) negm[r] = -mhat;
      AT_PIN(negm);
#pragma unroll
      for (int r = 0; r < 16; ++r) { pA0[r] = __builtin_amdgcn_exp2f(pA0[r] - rm); pA1[r] = pA1[r] - rm; } }
    AT_WAIT_BAR(0);
    DMA_K(3, 0); DMA_V(1, AT_SLOTB); ROT();
#pragma unroll
    for (int d0 = 0; d0 < 4; ++d0) at_kload2(kf, kp0 + sl_cur, d0);
    AT_WAIT_BAR(2);
#define PKW(P, i) pg8::cvt_pk_bf16(P[i], P[(i) + 1])
#define PKM(P, i, J0) (PKW(P, i) & AT_PMASK((J0) + (i) / 2, mwp))
#define PAF(k) as_bf16x8(pw##k)
#define VFR(i) as_bf16x8((v4u){vlo[i].x, vlo[i].y, vhi[i].x, vhi[i].y})
#define VRD(i) do { vlo[i] = *(const LAS u32x2*)(vp_ + (((i) & 3) * 2048 + ((i) >> 2) * 512)); vhi[i] = *(const LAS u32x2*)(vp_ + (((i) & 3) * 2048 + ((i) >> 2) * 512 + 1024)); } while (0)
#define KRD(d0) do { at_kload2(kf, kp0 + sl_next, d0); AT_SBAR(); } while (0)
#define GAPA(MF, W0, W1, PW) do { MF; W0; W1; AT_PIN(PW); AT_SBAR(); } while (0)
#define MX1(X, i) X[i] = __builtin_amdgcn_exp2f(X[i])
#define GAPAX(MF, W0, W1, PW, X, EXPS) do { MF; W0; W1; AT_PIN(PW); EXPS; AT_PIN(X); AT_SBAR(); } while (0)
#define LSUM(k) do { lacc = mfma32(as_bf16x8(onesw), PAF(k), lacc); AT_SBAR(); } while (0)
#define GAPB(MF, X, i) do { MF; X[i] = __builtin_amdgcn_exp2f(X[i]); X[(i) + 1] = __builtin_amdgcn_exp2f(X[(i) + 1]); AT_PIN(X); AT_SBAR(); } while (0)
#define STEP(C0, C1, P0, P1, t) do { AT_SBAR(); \
    const LAS char* vp_ = vp0 + sl_prev; const unsigned mwp = mT[((t) - 1) * 128]; \
    bf16x8 qv[8]; QRD(0); QRD(1); AT_SBAR(); \
    QRD(2); AT_SBAR(); GAPAX(C0 = mfma32(kf[0], qv[0], negm), pw0[0] = PKM(P0, 0, 0),  pw0[1] = PKM(P0, 2, 0),  pw0, P1, MX1(P1, 0); MX1(P1, 1); MX1(P1, 2)); \
    QRD(3); AT_SBAR(); GAPAX(C0 = mfma32(kf[2], qv[1], C0),   pw0[2] = PKM(P0, 4, 0),  pw0[3] = PKM(P0, 6, 0),  pw0, P1, MX1(P1, 3); MX1(P1, 4); MX1(P1, 5)); \
    QRD(4); AT_SBAR(); GAPAX(C0 = mfma32(kf[4], qv[2], C0),   pw1[0] = PKM(P0, 8, 0),  pw1[1] = PKM(P0, 10, 0), pw1, P1, MX1(P1, 6); MX1(P1, 7)); LSUM(0); \
    QRD(5); AT_SBAR(); GAPAX(C0 = mfma32(kf[6], qv[3], C0),   pw1[2] = PKM(P0, 12, 0), pw1[3] = PKM(P0, 14, 0), pw1, P1, MX1(P1, 8); MX1(P1, 9)); \
    QRD(6); AT_SBAR(); GAPAX(C1 = mfma32(kf[1], qv[4], negm), pw2[0] = PKM(P1, 0, 8),  pw2[1] = PKM(P1, 2, 8),  pw2, P1, MX1(P1, 10); MX1(P1, 11)); LSUM(1); \
    QRD(7); AT_SBAR(); GAPAX(C1 = mfma32(kf[3], qv[5], C1),   pw2[2] = PKM(P1, 4, 8),  pw2[3] = PKM(P1, 6, 8),  pw2, P1, MX1(P1, 12); MX1(P1, 13)); \
    GAPAX(C1 = mfma32(kf[5], qv[6], C1),   pw3[0] = PKM(P1, 8, 8),  pw3[1] = PKM(P1, 10, 8), pw3, P1, MX1(P1, 14); MX1(P1, 15)); LSUM(2); \
    GAPA(C1 = mfma32(kf[7], qv[7], C1),    pw3[2] = PKM(P1, 12, 8), pw3[3] = PKM(P1, 14, 8), pw3); LSUM(3); \
    DMA_K((t) + 3, sl_cur); DMA_V((t) + 1, sl_next);                                                       \
    VRD(0); VRD(4); AT_SBAR();                                                                             \
    { const float rm = at_rowmax(C0, C1); resc = false;                                                    \
      if (__builtin_expect(__any(rm > 8.f), 0)) { const float dl = __builtin_fmaxf(rm, 0.f); mhat += dl;    \
          _Pragma("unroll") for (int r = 0; r < 16; ++r) { C0[r] -= dl; C1[r] -= dl; } \
          _Pragma("unroll") for (int r = 0; r < 16; ++r) negm[r] = -mhat; \
          AT_PIN(negm); fsc = __builtin_amdgcn_exp2f(-dl); resc = true; } } \
    AT_SBAR(); \
    VRD(1); AT_SBAR(); GAPB(o[0] = mfma32(VFR(0), PAF(0), o[0]), C0, 0); \
    VRD(5); AT_SBAR(); GAPB(o[1] = mfma32(VFR(4), PAF(0), o[1]), C0, 2); \
    KRD(0); VRD(2); AT_SBAR(); GAPB(o[0] = mfma32(VFR(1), PAF(1), o[0]), C0, 4); \
    KRD(1); VRD(6); AT_SBAR(); GAPB(o[1] = mfma32(VFR(5), PAF(1), o[1]), C0, 6); \
    KRD(2); VRD(3); AT_SBAR(); GAPB(o[0] = mfma32(VFR(2), PAF(2), o[0]), C0, 8); \
    KRD(3); VRD(7); AT_SBAR(); GAPB(o[1] = mfma32(VFR(6), PAF(2), o[1]), C0, 10); \
    GAPB(o[0] = mfma32(VFR(3), PAF(3), o[0]), C0, 12);              GAPB(o[1] = mfma32(VFR(7), PAF(3), o[1]), C0, 14); \
    } while (0)
    int t = 1;
    for (; t + 1 < NT; t += 2) {
        STEP(pB0, pB1, pA0, pA1, t);     AT_WAIT_BAR(2); RESC(); ROT();
        STEP(pA0, pA1, pB0, pB1, t + 1); AT_WAIT_BAR(2); RESC(); ROT();
    }
    if (t < NT) { STEP(pB0, pB1, pA0, pA1, t); AT_WAIT_BAR(2); RESC(); ROT(); pA0 = pB0; pA1 = pB1; }
    {
#pragma unroll
      for (int r = 0; r < 16; ++r) pA1[r] = __builtin_amdgcn_exp2f(pA1[r]);
      const unsigned mwp = mT[(NT - 1) * 128];
      pw0 = (v4u){PKM(pA0, 0, 0), PKM(pA0, 2, 0), PKM(pA0, 4, 0), PKM(pA0, 6, 0)}; pw1 = (v4u){PKM(pA0, 8, 0), PKM(pA0, 10, 0), PKM(pA0, 12, 0), PKM(pA0, 14, 0)};
      pw2 = (v4u){PKM(pA1, 0, 8), PKM(pA1, 2, 8), PKM(pA1, 4, 8), PKM(pA1, 6, 8)}; pw3 = (v4u){PKM(pA1, 8, 8), PKM(pA1, 10, 8), PKM(pA1, 12, 8), PKM(pA1, 14, 8)};
      const LAS char* vp_ = vp0 + sl_prev;
#pragma unroll
      for (int i = 0; i < 8; ++i) VRD(i);
      o[0] = mfma32(VFR(0), PAF(0), o[0]); o[1] = mfma32(VFR(4), PAF(0), o[1]); o[0] = mfma32(VFR(1), PAF(1), o[0]); o[1] = mfma32(VFR(5), PAF(1), o[1]);
      o[0] = mfma32(VFR(2), PAF(2), o[0]); o[1] = mfma32(VFR(6), PAF(2), o[1]); o[0] = mfma32(VFR(3), PAF(3), o[0]); o[1] = mfma32(VFR(7), PAF(3), o[1]);
      lacc = mfma32(as_bf16x8(onesw), PAF(0), lacc); lacc = mfma32(as_bf16x8(onesw), PAF(1), lacc); lacc = mfma32(as_bf16x8(onesw), PAF(2), lacc); lacc = mfma32(as_bf16x8(onesw), PAF(3), lacc); }
    const float l_reg = lacc[0];
    asm volatile("s_waitcnt vmcnt(0)" ::: "memory");
    {
        const float linv = 1.0f / l_reg; bf16* op = (bf16*)(ws + WS_MIX) + qrow * 1024 + 512 + 64 * head + 8 * hi;
#pragma unroll
        for (int k = 0; k < 8; k += 2) {
            const int dba = k >> 2, ia = k & 3, ib = ia + 1;
            unsigned ax = pg8::cvt_pk_bf16(o[dba][4 * ia] * linv, o[dba][4 * ia + 1] * linv), ay = pg8::cvt_pk_bf16(o[dba][4 * ia + 2] * linv, o[dba][4 * ia + 3] * linv);
            unsigned bx = pg8::cvt_pk_bf16(o[dba][4 * ib] * linv, o[dba][4 * ib + 1] * linv), by = pg8::cvt_pk_bf16(o[dba][4 * ib + 2] * linv, o[dba][4 * ib + 3] * linv);
            { auto r = __builtin_amdgcn_permlane32_swap(ax, bx, false, false); ax = r[0]; bx = r[1]; }
            { auto r = __builtin_amdgcn_permlane32_swap(ay, by, false, false); ay = r[0]; by = r[1]; }
            *(v4u*)(op + 8 * k) = (v4u){ax, ay, bx, by}; }
    }
    asm volatile("s_waitcnt lgkmcnt(0)\n\ts_barrier" ::: "memory");
#undef DMA_K
#undef DMA_V
#undef ROT
#undef RESC
#undef PKW
#undef PKM
#undef PAF
#undef VFR
#undef VRD
#undef KRD
#undef GAPA
#undef GAPAX
#undef MX1
#undef QRD
#undef LSUM
#undef GAPB
#undef STEP
}
__device__ __forceinline__ void topk_attn_unit(Frame& F, int b, int qt) {
    LAS unsigned* mask64 = (LAS unsigned*)(F.lds + RING_OFF + TA_MASK);
    bf16x8 kh0[8], kh1[8];
    topk_load_k(F, b, (qt < 4) ? 0 : 4 * qt + 4, kh0, kh1);
#pragma unroll 1
    for (int sub = 0; sub < 4; ++sub) topk16(F, b, 64 * qt + 16 * sub, mask64 + sub * 16 * 64, kh0, kh1);
    __syncthreads();
    mask_to_tiles(F, mask64);
    __syncthreads();
#pragma unroll 1
#ifdef PROBE_ATT2
    for (int g = 0; g < 4; ++g) attn_unit(F, b, qt, g & 1);
#else
    for (int g = 0; g < 2; ++g) attn_unit(F, b, qt, g);
#endif
}

__device__ __forceinline__ float dpp_sum16(float v) {
    v += __builtin_bit_cast(float, __builtin_amdgcn_update_dpp(0, __builtin_bit_cast(int, v), 0xB1, 0xF, 0xF, true));
    v += __builtin_bit_cast(float, __builtin_amdgcn_update_dpp(0, __builtin_bit_cast(int, v), 0x4E, 0xF, 0xF, true));
    v += __builtin_bit_cast(float, __builtin_amdgcn_update_dpp(0, __builtin_bit_cast(int, v), 0x141, 0xF, 0xF, true));
    v += __builtin_bit_cast(float, __builtin_amdgcn_update_dpp(0, __builtin_bit_cast(int, v), 0x140, 0xF, 0xF, true));
    return v;
}
__device__ __forceinline__ float dot4(const f32x4 a, const f32x4 b) { return __builtin_fmaf(a[3], b[3], __builtin_fmaf(a[2], b[2], __builtin_fmaf(a[1], b[1], a[0] * b[0]))); }
constexpr int SU_SC = 0, SU_QI = 8208 * 4, SU_WI = SU_QI + 256 * 4, SU_Q = SU_WI + 16, SU_SEL = SU_Q + 512 * 4, SU_P = SU_SEL + 256 * 4, SU_CNT = SU_P + 8 * 256 * 4, SU_CW = SU_CNT + 64 * 4, SU_RED = SU_CW + 2 * 17 * 8 * 4, SU_END = SU_RED + 64 * 4;
static_assert(SU_END <= RING_BYTES, "sample-unit LDS");
__device__ __forceinline__ void sample_unit(Frame& F, const Args& A, int b) {
    launder(F); unsigned char* ws = F.ws; const int tid = F.tid, lane = F.lane, w = F.wave;
    LAS float* sc = (LAS float*)(F.lds + RING_OFF + SU_SC); LAS float* qi_s = (LAS float*)(F.lds + RING_OFF + SU_QI); LAS float* wi_s = (LAS float*)(F.lds + RING_OFF + SU_WI);
    LAS float* q_s = (LAS float*)(F.lds + RING_OFF + SU_Q); LAS int* sel = (LAS int*)(F.lds + RING_OFF + SU_SEL); LAS float* p_s = (LAS float*)(F.lds + RING_OFF + SU_P);
    LAS unsigned* cnts = (LAS unsigned*)(F.lds + RING_OFF + SU_CNT); LAS unsigned* cw = (LAS unsigned*)(F.lds + RING_OFF + SU_CW); LAS float* red = (LAS float*)(F.lds + RING_OFF + SU_RED);
    const int* pt = (const int*)IN_L(I_PT) + b * NPAGE;
    if (tid < 256) qi_s[tid] = ((const float*)(ws + SM_QIS))[b * 256 + tid];
    if (tid < 4) wi_s[tid] = ((const float*)(ws + SM_WIS))[b * 4 + tid];
    q_s[tid] = ((const float*)(ws + SM_QS))[b * 512 + tid];
    {
        const float gv = ((const float*)(ws + SM_GVS))[b * 512 + tid];
        const float s1 = wave_sum(gv); if (lane == 0) red[w] = s1;
        __syncthreads();
        float mean = 0.f;
#pragma unroll
        for (int i = 0; i < 8; ++i) mean += red[i];
        mean *= (1.f / 512.f);
        const float d = gv - mean; const float s2 = wave_sum(d * d); if (lane == 0) red[8 + w] = s2;
        __syncthreads();
        float var = 0.f;
#pragma unroll
        for (int i = 0; i < 8; ++i) var += red[8 + i];
        const float rstd = 1.0f / sqrtf(var * (1.f / 512.f) + LN_EPS);
        const float av = d * rstd * IN_L(I_ALNG)[tid] + IN_L(I_ALNB)[tid];
        F.out[OUT_AV + (size_t)b * 512 + tid] = av;
        const int g = tid >> 7; const float mixed = IN_L(I_AWS)[(size_t)g * 128 * 128] * av + IN_L(I_ABS)[g * 128];
        ((bf16*)(ws + SM_MIXSB))[(size_t)b * 1024 + tid] = (bf16)f2bf(((const float*)(ws + SM_US))[b * 512 + tid] * mixed);
    }
    {
        const int sub = lane & 15, kq = lane >> 4;
        f32x4 qh[4];
#pragma unroll
        for (int h = 0; h < 4; ++h) qh[h] = *(const LAS f32x4*)(qi_s + 64 * h + 4 * sub);
        const float w0 = wi_s[0], w1 = wi_s[1], w2 = wi_s[2], w3 = wi_s[3];
        const float* cki = IN_L(I_CKI) + 4 * sub;
#define SU_LOAD(buf, phys, half) { const float* base_ = cki + (size_t)(phys) * (128 * 64) + (half) * (64 * 64); \
            _Pragma("unroll") for (int it = 0; it < 16; ++it) buf[it] = __builtin_nontemporal_load((const f32x4*)(base_ + (4 * it + kq) * 64)); }
#define SU_SCORE(buf, pg_, half) { \
            _Pragma("unroll") for (int it = 0; it < 16; ++it) { const int key = (half) * 64 + 4 * it + kq; const f32x4 kv = buf[it]; \
                const float d0 = dpp_sum16(dot4(kv, qh[0])), d1 = dpp_sum16(dot4(kv, qh[1])), d2 = dpp_sum16(dot4(kv, qh[2])), d3 = dpp_sum16(dot4(kv, qh[3])); \
                float s = w0 * fmaxf(d0, 0.f); s = __builtin_fmaf(w1, fmaxf(d1, 0.f), s); s = __builtin_fmaf(w2, fmaxf(d2, 0.f), s); s = __builtin_fmaf(w3, fmaxf(d3, 0.f), s); \
                if (sub == 0) sc[(pg_) * 128 + key] = s; } }
        {
            f32x4 kvA[16], kvB[16];
            int phys_cur = __builtin_amdgcn_readfirstlane(pt[w]);
            SU_LOAD(kvA, phys_cur, 0)
#pragma unroll 1
            for (int pg = w; pg < NPAGE; pg += NWAVES) {
                const int pgn = (pg + NWAVES < NPAGE) ? pg + NWAVES : pg;
                const int phys_nv = pt[pgn];
                SU_LOAD(kvB, phys_cur, 1)
                __builtin_amdgcn_sched_barrier(0);
                SU_SCORE(kvA, pg, 0)
                const int phys_next = __builtin_amdgcn_readfirstlane(phys_nv);
                if (pg + NWAVES < NPAGE) SU_LOAD(kvA, phys_next, 0)
                __builtin_amdgcn_sched_barrier(0);
                SU_SCORE(kvB, pg, 1)
                phys_cur = phys_next;
            }
        }
#undef SU_LOAD
#undef SU_SCORE
        if (w == 0) { const f32x4 kv = *(const f32x4*)(F.out + OUT_KIS + (size_t)b * 64 + 4 * sub);
            const float d0 = dpp_sum16(dot4(kv, qh[0])), d1 = dpp_sum16(dot4(kv, qh[1])), d2 = dpp_sum16(dot4(kv, qh[2])), d3 = dpp_sum16(dot4(kv, qh[3]));
            float s = w0 * fmaxf(d0, 0.f); s = __builtin_fmaf(w1, fmaxf(d1, 0.f), s); s = __builtin_fmaf(w2, fmaxf(d2, 0.f), s); s = __builtin_fmaf(w3, fmaxf(d3, 0.f), s);
            if (lane == 0) sc[PAST] = s; }
    }
    __syncthreads();
    unsigned x[17];
#pragma unroll
    for (int i = 0; i < 17; ++i) { const int p = tid + 512 * i; x[i] = __float_as_uint(sc[p < PAST + 1 ? p : PAST]); }
    __builtin_amdgcn_sched_barrier(0);
#pragma unroll
    for (int i = 0; i < 17; ++i) { const int p = tid + 512 * i; x[i] = (p <= PAST) ? ord_f32(__uint_as_float(x[i])) : 0u; }
    unsigned prefix = 0u;
#pragma unroll 1
    for (int bit = 31; bit >= 0; --bit) { const unsigned T = prefix | (1u << bit); unsigned c = 0u;
#pragma unroll
        for (int i = 0; i < 17; ++i) cnt_ge(c, x[i], T);
        const unsigned cnt = wave_sum_u32(c);
        LAS unsigned* slot = cnts + 8 * (bit & 1);
        if (lane == 0) slot[w] = cnt;
        __syncthreads();
        unsigned tot = 0;
#pragma unroll
        for (int i = 0; i < 8; ++i) tot += slot[i];
        if (tot >= 256u) prefix = T;
        if (tot == 256u) break; }
    const unsigned thr = prefix;
    {
        const unsigned long long lt = (1ull << lane) - 1ull;
        int cg = 0;
#pragma unroll
        for (int i = 0; i < 17; ++i) cg += __builtin_popcountll(__ballot(x[i] > thr));
        if (lane == 0) cnts[16 + w] = (unsigned)cg;
#pragma unroll
        for (int i = 0; i < 17; ++i) { const unsigned long long gb = __ballot(x[i] > thr), tb = __ballot(x[i] == thr);
            if (lane == 0) { cw[(i * 8 + w) * 2] = (unsigned)__builtin_popcountll(gb); cw[(i * 8 + w) * 2 + 1] = (unsigned)__builtin_popcountll(tb); } }
        __syncthreads();
        unsigned ngt = 0;
#pragma unroll
        for (int i = 0; i < 8; ++i) ngt += cnts[16 + i];
        const unsigned need = 256u - ngt;
        unsigned run_gt = 0, run_ti = 0;
#pragma unroll
        for (int i = 0; i < 17; ++i) {
            unsigned my_g = run_gt, my_t = run_ti;
#pragma unroll
            for (int ww = 0; ww < 8; ++ww) { const unsigned a = cw[(i * 8 + ww) * 2], c = cw[(i * 8 + ww) * 2 + 1]; if (ww < w) { my_g += a; my_t += c; } run_gt += a; run_ti += c; }
            const unsigned long long gb = __ballot(x[i] > thr), tb = __ballot(x[i] == thr); const int p = tid + 512 * i;
            if ((gb >> lane) & 1ull) sel[my_g + (unsigned)__builtin_popcountll(gb & lt)] = p;
            else if ((tb >> lane) & 1ull) { const unsigned rk = my_t + (unsigned)__builtin_popcountll(tb & lt); if (rk < need) sel[ngt + rk] = p; }
            __builtin_amdgcn_sched_barrier(0);
        }
    }
    __syncthreads();
    {
        LAS int* ro_s = (LAS int*)cw;
        if (tid < 256) { const int p = sel[tid]; ro_s[tid] = (p < PAST) ? pt[p >> 7] * 128 + (p & 127) : -1; }
        __syncthreads();
        const int h = w, g = h >> 2; const float* ck = IN_L(I_CK); const float* cv = IN_L(I_CV);
        const int sub = lane & 15, kq = lane >> 4;
        const f32x4 qv = *(const LAS f32x4*)(q_s + 64 * h + 4 * sub);
        const float* knew = F.out + OUT_KS + ((size_t)b * 2 + g) * 64 + 4 * sub; const float* vnew = F.out + OUT_VS + ((size_t)b * 2 + g) * 64 + 4 * sub;
#pragma unroll 1
        for (int it0 = 0; it0 < 64; it0 += 32) { f32x4 kr16[32];
#pragma unroll
            for (int i = 0; i < 32; ++i) { const int ro = ro_s[4 * (it0 + i) + kq]; kr16[i] = *(const f32x4*)((ro >= 0) ? ck + ((size_t)ro * 2 + g) * 64 + 4 * sub : knew); }
            __builtin_amdgcn_sched_barrier(0);
#pragma unroll
            for (int i = 0; i < 32; ++i) { const float d = dpp_sum16(dot4(kr16[i], qv)); if (sub == 0) p_s[h * 256 + 4 * (it0 + i) + kq] = d * 0.125f; } }
        LDS_WAIT(); asm volatile("" ::: "memory");
        const float l0 = p_s[h * 256 + lane], l1 = p_s[h * 256 + lane + 64], l2 = p_s[h * 256 + lane + 128], l3 = p_s[h * 256 + lane + 192];
        const float mx = wave_max(fmaxf(fmaxf(l0, l1), fmaxf(l2, l3)));
        const float e0 = __expf(l0 - mx), e1 = __expf(l1 - mx), e2 = __expf(l2 - mx), e3 = __expf(l3 - mx);
        p_s[h * 256 + lane] = e0; p_s[h * 256 + lane + 64] = e1; p_s[h * 256 + lane + 128] = e2; p_s[h * 256 + lane + 192] = e3;
        const float ls = (e0 + e1) + (e2 + e3);
        const float linv = 1.0f / wave_sum(ls);
        LDS_WAIT(); asm volatile("" ::: "memory");
        f32x4 acc = (f32x4){0.f, 0.f, 0.f, 0.f};
#pragma unroll 1
        for (int it0 = 0; it0 < 64; it0 += 32) { f32x4 vr16[32];
#pragma unroll
            for (int i = 0; i < 32; ++i) { const int ro = ro_s[4 * (it0 + i) + kq]; vr16[i] = *(const f32x4*)((ro >= 0) ? cv + ((size_t)ro * 2 + g) * 64 + 4 * sub : vnew); }
            __builtin_amdgcn_sched_barrier(0);
#pragma unroll
            for (int i = 0; i < 32; ++i) acc = acc + vr16[i] * p_s[h * 256 + 4 * (it0 + i) + kq]; }
#pragma unroll
        for (int i = 0; i < 4; ++i) { acc[i] += __shfl_xor(acc[i], 16); acc[i] += __shfl_xor(acc[i], 32); }
        if (kq == 0) { const f32x4 o = acc * linv; u32x2 wv; wv.x = pk2(o[0], o[1]); wv.y = pk2(o[2], o[3]); *(u32x2*)((bf16*)(ws + SM_MIXSB) + (size_t)b * 1024 + 512 + 64 * h + 4 * sub) = wv; }
    }
    asm volatile("s_waitcnt lgkmcnt(0)\n\ts_barrier" ::: "memory");
}

__global__ void __launch_bounds__(NWAVES * 64, 2) hymba_fwd(Args args) {
    extern __shared__ __attribute__((aligned(16))) unsigned char lds[];
    Frame F;
    F.lds = (LAS unsigned char*)lds;
    F.MISC = (volatile LAS unsigned*)(F.lds + MISC_OFF);
    F.tid = threadIdx.x; F.lane = F.tid & 63; F.wave = __builtin_amdgcn_readfirstlane(F.tid >> 6);
    F.G = gridDim.x; { const int bx = blockIdx.x; F.vcu = (F.G % 8 == 0) ? (bx % 8) * (F.G / 8) + bx / 8 : bx; }
    F.out = args.out; F.ws = args.ws; const Args& A = args;
    unsigned char* ws = args.ws;
    F.ctl = (gu32*)(ws + WS_CTL);
    for (int u = F.tid; u < (LDS_BYTES - LDSCTL_OFF) / 4; u += NWAVES * 64) ((LAS unsigned*)(F.lds + LDSCTL_OFF))[u] = 0u;
    __syncthreads();
    if (F.tid < 22) { const unsigned long long* ka = (const unsigned long long*)__builtin_amdgcn_kernarg_segment_ptr();
        ((volatile LAS unsigned long long*)(F.lds + LDSCTL_OFF))[F.tid] = ka[F.tid]; }
    __syncthreads();
    XcdBarrier bar; bar.bar = (unsigned*)(F.ctl + CW_BAR); bar.x = 0; bar.st = nullptr;
    if (N_LAUNCHES == 1) bar = xcd_barrier_post((unsigned*)(F.ctl + CW_BAR), F.MISC + 8);
#define GRID_BAR() do { if (N_LAUNCHES == 1) xcd_barrier(bar); } while (0)
    const int lo = args.ph_lo, hi = args.ph_hi;
#define IN(k) (lo <= (k) && (k) < hi)
#define BOTH(k) (IN(k) && IN((k) + 1))
    const int c = (int)blockIdx.x;

    if (IN(0)) { p0_prologue(F, A); if (BOTH(0)) GRID_BAR(); }

    if (IN(1)) {
        pg8::Gemm g{(const bf16*)(ws + WS_XB), (const bf16*)(ws + WS_W1UP), MP, 2 * FF, DM}; pg8::StaticOrder S; S.init(MP, 2 * FF, F.G, c);
        pg8::EpiSwiGLU<false> E{(bf16*)(ws + WS_H), FF, nullptr, nullptr, nullptr, 0u};
        pg8::gemm_phase<pg8::EpiSwiGLU<false>, pg8::StaticOrder, true, true>(F.lds + RING_OFF, g, S, E);
        finalize_cvec(F, 0);
        thin_stage<1>(F, A, F.G - 1 - F.vcu, F.G);
        if (BOTH(1)) GRID_BAR();
    }
    if (IN(2)) {
        pg8::Gemm g{(const bf16*)(ws + WS_H), (const bf16*)(ws + WS_W1DN), MP, DM, FF}; pg8::StaticOrder S; S.init(MP, DM, F.G, c);
        pg8::EpiZ<0, true> E{(const bf16*)(ws + WS_XB), nullptr, nullptr, nullptr, (bf16*)(ws + WS_Z1), (float*)(ws + WS_STZ1), (unsigned)(size_t)(F.lds + XLDS_OFF)};
        pg8::gemm_phase<pg8::EpiZ<0, true>, pg8::StaticOrder, true, true>(F.lds + RING_OFF, g, S, E);
        thin_stage<2>(F, A, F.G - 1 - F.vcu, F.G);
        if (BOTH(2)) GRID_BAR();
    }
    if (IN(3)) {
        pg8::EpiWin E{(bf16*)(ws + WS_U), (bf16*)(ws + WS_GV), (bf16*)(ws + WS_Q), (bf16*)(ws + WS_K), (bf16*)(ws + WS_VT), (bf16*)(ws + WS_QI), (bf16*)(ws + WS_KI),
                      (float*)(ws + WS_GVST), (float*)(ws + WS_WI), F.out + OUT_KP, F.out + OUT_VP, F.out + OUT_KIP, (const float*)(ws + WS_ROPEC), (const float*)(ws + WS_ROPES),
                      (const float*)(ws + WS_STZ1), (const float*)(ws + CV_C1IN), (const float*)(ws + CV_C2IN), (unsigned)(size_t)(F.lds + XLDS_OFF + 8192), 0};
        { pg8::Gemm g{(const bf16*)(ws + WS_Z1), (const bf16*)(ws + WS_WIN), MP, 2048, DM}; pg8::StaticOrder S; S.init(MP, 2048, F.G, c);
          pg8::gemm_phase<pg8::EpiWin, pg8::StaticOrder, true, true>(F.lds + RING_OFF, g, S, E); }
        __syncthreads();
        { pg8::Gemm g{(const bf16*)(ws + WS_Z1), (const bf16*)(ws + WS_WIN) + (size_t)2048 * DM, MP, 256, DM}; pg8::StaticOrder S; S.init(MP, 256, F.G, c);
          E.pn_off = 8;
          pg8::gemm_phase<pg8::EpiWin, pg8::StaticOrder, true, true, true>(F.lds + RING_OFF, g, S, E); }
        if (c >= 128) { thin_stage<3>(F, A, c - 128, 128); p0_wout(F, A, c - 128, 128); }
        if (BOTH(3)) GRID_BAR();
    }
    if (IN(4)) {
#ifndef PROBE_Q_DUP
#define PROBE_Q_DUP 0
#endif
        constexpr int N_SMP = NS * (PROBE_Q_DUP == 1 ? 2 : 1), N_ATT = NB * 32 * (PROBE_Q_DUP == 2 ? 2 : 1), N_GM = NB * 16 * 4 * (PROBE_Q_DUP == 3 ? 2 : 1);
        constexpr int Q_SAMPLE = N_SMP, Q_ATTN = Q_SAMPLE + N_ATT, Q_GM = Q_ATTN + N_GM, Q_TOTAL = Q_GM + LATE_UNITS;
        gu32* qhead = F.ctl + CW_QUEUE; volatile LAS unsigned* qslot = F.MISC + 16;
        if (F.tid == 0) qslot[0] = __hip_atomic_fetch_add(qhead, 1u, RLX_AGENT);
        __syncthreads();
        int item = __builtin_amdgcn_readfirstlane((int)qslot[0]); int par = 0;
        while (item < Q_TOTAL) {
            unsigned nxt = 0u; if (F.tid == 0) nxt = __hip_atomic_fetch_add(qhead, 1u, RLX_AGENT);
            if (item < Q_SAMPLE) sample_unit(F, A, item % NS);
            else if (item < Q_ATTN) { const int i = (item - Q_SAMPLE) % (NB * 32); topk_attn_unit(F, i & 15, 31 - (i >> 4)); }
            else if (item < Q_GM) { const int L = (item - Q_ATTN) % (NB * 16 * 4); gmlp_unit(F, A, L >> 6, (L >> 2) & 15, L & 3); }
            else late_weight_unit(F, A, item - Q_GM);
            par ^= 1; if (F.tid == 0) qslot[par] = nxt;
            asm volatile("s_waitcnt lgkmcnt(0)\n\ts_barrier" ::: "memory");
            item = __builtin_amdgcn_readfirstlane((int)qslot[par]);
        }
        if (BOTH(4)) GRID_BAR();
    }
    if (IN(5)) {
        pg8::Gemm g{(const bf16*)(ws + WS_MIX), (const bf16*)(ws + WS_WOUT), MP, DM, DM}; pg8::StaticOrder S; S.init(MP, DM, F.G, c);
        pg8::EpiZ<1, false> E{(const bf16*)(ws + WS_Z1), (const float*)(ws + WS_STZ1), IN_F(I_LN1G), IN_F(I_LN1B), (bf16*)(ws + WS_Z2), (float*)(ws + WS_STZ2), (unsigned)(size_t)(F.lds + XLDS_OFF)};
        pg8::gemm_phase<pg8::EpiZ<1, false>, pg8::StaticOrder, true, true>(F.lds + RING_OFF, g, S, E);
        finalize_cvec(F, 1);
        thin_stage<6>(F, A, F.G - 1 - F.vcu, F.G);
        if (BOTH(5)) GRID_BAR();
    }
    if (IN(6)) {
        pg8::Gemm g{(const bf16*)(ws + WS_Z2), (const bf16*)(ws + WS_W2UP), MP, 2 * FF, DM}; pg8::StaticOrder S; S.init(MP, 2 * FF, F.G, c);
        pg8::EpiSwiGLU<true> E{(bf16*)(ws + WS_H), FF, (const float*)(ws + WS_STZ2), (const float*)(ws + CV_C1UP), (const float*)(ws + CV_C2UP), (unsigned)(size_t)(F.lds + XLDS_OFF + 8192)};
        pg8::gemm_phase<pg8::EpiSwiGLU<true>, pg8::StaticOrder, true, true>(F.lds + RING_OFF, g, S, E);
        thin_stage<7>(F, A, F.G - 1 - F.vcu, F.G);
        if (BOTH(6)) GRID_BAR();
    }
    if (IN(7)) {
        pg8::Gemm g{(const bf16*)(ws + WS_H), (const bf16*)(ws + WS_W2DN), MP, DM, FF}; pg8::StaticOrder S; S.init(MP, DM, F.G, c);
        pg8::EpiZ<1, true> E{(const bf16*)(ws + WS_Z2), (const float*)(ws + WS_STZ2), IN_F(I_LN2G), IN_F(I_LN2B), (bf16*)(ws + WS_Z3), (float*)(ws + WS_STZ3), (unsigned)(size_t)(F.lds + XLDS_OFF)};
        pg8::gemm_phase<pg8::EpiZ<1, true>, pg8::StaticOrder, true, true>(F.lds + RING_OFF, g, S, E);
        thin_stage<8>(F, A, F.G - 1 - F.vcu, F.G);
        if (BOTH(7)) GRID_BAR();
    }
    if (IN(8)) { thin_final_ln(F, A); final_ln_rows(F, A); }
#undef IN
#undef BOTH
#undef GRID_BAR
}

extern "C" void kernel_launch(void* const* d_in, const int* in_sizes, int n_in, void* d_out, int out_size, void* d_ws, size_t ws_size, hipStream_t stream) {
    static int grid = 0;
    if (grid == 0) {
        if (n_in != 22 || in_sizes[0] != MP * DM || (size_t)out_size != OUT_TOTAL || ws_size < WS_END) {
            fprintf(stderr, "kernel_launch: unexpected shapes (n_in %d, in0 %d, out %d, ws %zu); nothing launched\n", n_in, n_in > 0 ? in_sizes[0] : -1, out_size, ws_size); grid = -1; return; }
        int dev = 0, cus = 0, per_cu = 0;
        if (hipGetDevice(&dev) != hipSuccess || hipDeviceGetAttribute(&cus, hipDeviceAttributeMultiprocessorCount, dev) != hipSuccess) { fprintf(stderr, "kernel_launch: device query failed\n"); grid = -1; return; }
        if (hipFuncSetAttribute((const void*)hymba_fwd, hipFuncAttributeMaxDynamicSharedMemorySize, LDS_BYTES) != hipSuccess) { fprintf(stderr, "kernel_launch: hipFuncSetAttribute failed\n"); grid = -1; return; }
        if (hipOccupancyMaxActiveBlocksPerMultiprocessor(&per_cu, (const void*)hymba_fwd, NWAVES * 64, LDS_BYTES) != hipSuccess || per_cu < 1)
            fprintf(stderr, "kernel_launch: note: occupancy query reports %d workgroups per CU\n", per_cu);
        (void)hipGetLastError();
        grid = cus;
        if (grid != 256) fprintf(stderr, "kernel_launch: %d CUs; the fused LayerNorm phases need 256 workgroups: output will be NaN\n", grid);
    }
    if (grid < 0) return;
    if (hipMemsetAsync((char*)d_ws + WS_CTL, 0, CTL_ZERO_BYTES, stream) != hipSuccess) { fprintf(stderr, "kernel_launch: memset failed\n"); return; }
    Args a{};
    for (int i = 0; i < 22; ++i) a.in[i] = d_in[i];
    a.out = (float*)d_out; a.ws = (unsigned char*)d_ws;
    for (int li = 0; li < N_LAUNCHES; ++li) {
        a.ph_lo = (N_LAUNCHES == 1) ? 0 : li; a.ph_hi = (N_LAUNCHES == 1) ? N_PHASES : li + 1;
        hipLaunchKernelGGL(hymba_fwd, dim3(grid), dim3(NWAVES * 64), LDS_BYTES, stream, a);
        const hipError_t le = hipPeekAtLastError();
        if (le != hipSuccess) { fprintf(stderr, "kernel_launch: launch %d failed: %s\n", li, hipGetErrorName(le)); break; }
    }
}
```

```cpp
#include <hip/hip_runtime.h>
#include <cstdio>
#include <cstdint>
namespace pg8 {
#define PG8_LAS __attribute__((address_space(3)))
typedef unsigned short bf16_t;
typedef short bf16x8 __attribute__((ext_vector_type(8)));
typedef float f32x4 __attribute__((ext_vector_type(4)));
typedef unsigned u32x4 __attribute__((ext_vector_type(4)));
constexpr int BM = 256, BK = 64, HALF = 128, HTB = HALF * BK * 2  , STAGE_BYTES = 8 * HTB, NXCD = 8, WGM = 8;

__host__ __device__ __forceinline__ int lds_byte(int r, int c) { const int st = (r >> 4) * 2 + (c >> 5), rr = r & 15, cc = c & 31, ob = rr * 64 + cc * 2; return st * 1024 + (ob ^ (((ob >> 9) & 1) << 5)); }
__host__ __device__ __forceinline__ void stage_rc(int b, int& R, int& C) { const int st = b / 1024, sb = b % 1024, swz = sb ^ (((sb >> 9) & 1) << 5); R = (st >> 1) * 16 + swz / 64; C = (st & 1) * 32 + (swz % 64) / 2; }
__host__ __device__ __forceinline__ int perm32(int rho) { const int n = rho >> 4, i = rho & 15; return 8 * (i >> 2) + 4 * n + (i & 3); }

struct Unit { int pm, pn; };
struct Gemm { const bf16_t* A; const bf16_t* Bt; int M, N, K; };

struct StaticOrder {
    int nM, nN, nwg, G, c;
    __host__ __device__ void init(int M, int N, int G_, int c_) { nM = M / BM; nN = N / BM; nwg = nM * nN; G = G_; c = c_; }
    __host__ __device__ bool next(int i, Unit& u) const {
        const long L = (long)i * G + c; if (L >= nwg) return false;
        int wgid = (int)L; { const int q = nwg / NXCD, r = nwg % NXCD, xcd = wgid % NXCD, off = wgid / NXCD; wgid = (xcd < r ? xcd * (q + 1) : r * (q + 1) + (xcd - r) * q) + off; }
        const int nig = WGM * nN, gid = wgid / nig, fm = gid * WGM, gsz = (nM - fm) < WGM ? (nM - fm) : WGM;
        u.pm = fm + ((wgid % nig) % gsz); u.pn = (wgid % nig) / gsz; return true;
    }
    __device__ __forceinline__ void a_ready(const Unit&) const {}
    __device__ __forceinline__ void done(const Unit&) const {}
};

__device__ __forceinline__ unsigned cvt_pk_bf16(float lo, float hi) { unsigned r; asm volatile("v_cvt_pk_bf16_f32 %0, %1, %2" : "=v"(r) : "v"(lo), "v"(hi)); return r; }
typedef float f32x2 __attribute__((ext_vector_type(2)));
template <class Epi, class Sched, bool ALIGN_EPI = false, bool SP2 = false, bool HALF_N = false>
__device__ __forceinline__ void gemm_phase(PG8_LAS unsigned char* lds, const Gemm g, const Sched& S, const Epi& E) {
    int tid_ = threadIdx.x; asm volatile("" : "+v"(tid_));
    const int tid = tid_, wid = __builtin_amdgcn_readfirstlane(tid >> 6), lane = tid & 63, wr = wid >> 2, wc = wid & 3, fr = lane & 15, fq = lane >> 4;
    const int K = g.K, nt = K / BK;
    unsigned voffA[2], voffB[2];
#pragma unroll
    for (int i = 0; i < 2; ++i) { int R, C; stage_rc(tid * 16 + i * 8192, R, C); const int Rb = Epi::PERM ? ((R & ~31) + perm32(R & 31)) : R;
        voffA[i] = (unsigned)(R * K + C) * 2u; voffB[i] = (unsigned)(Rb * K + C) * 2u; }
    const size_t kstep = (size_t)(BK * 2);
    const size_t hstep = (size_t)HALF * K * 2;
    const size_t tstep = 2 * hstep;
    const unsigned ldsw = (unsigned)wid * 1024u;
    const int aoff = lds_byte(wr * 64 + fr, fq * 8), boff = lds_byte(wc * 32 + fr, fq * 8);
#define PG8_SA(b, h) (((b) * 2 + (h)) * HTB)
#define PG8_SB(b, h) ((4 + (b) * 2 + (h)) * HTB)
#define PG8_STAGE(bufoff, gbase, voff) do { _Pragma("unroll") for (int _i = 0; _i < 2; ++_i) \
        __builtin_amdgcn_global_load_lds((const unsigned*)((const char*)(gbase) + (voff)[_i]), (PG8_LAS unsigned*)(lds + (bufoff) + ldsw + _i * 8192), 16, 0, 0); } while (0)
#define PG8_LDA(dst, b, h) do { _Pragma("unroll") for (int m = 0; m < 4; ++m) _Pragma("unroll") for (int k = 0; k < 2; ++k) dst[m][k] = *(const PG8_LAS bf16x8*)(lds + PG8_SA(b, h) + aoff + m * 2048 + k * 1024); } while (0)
#define PG8_LDB(dst, b, h) do { _Pragma("unroll") for (int n = 0; n < 2; ++n) _Pragma("unroll") for (int k = 0; k < 2; ++k) dst[n][k] = *(const PG8_LAS bf16x8*)(lds + PG8_SB(b, h) + boff + n * 2048 + k * 1024); } while (0)
#define PG8_MMA(ai, bj, At, Bt) do { __builtin_amdgcn_s_setprio(1); _Pragma("unroll") for (int m = 0; m < 4; ++m) _Pragma("unroll") for (int n = 0; n < 2; ++n) _Pragma("unroll") for (int k = 0; k < 2; ++k) \
        acc[ai][bj][m][n] = __builtin_amdgcn_mfma_f32_16x16x32_bf16(Bt[n][k], At[m][k], acc[ai][bj][m][n], 0, 0, 0); __builtin_amdgcn_s_setprio(0); } while (0)
#define PG8_WAIT_V(n) asm volatile("s_waitcnt vmcnt(" #n ")" ::: "memory")
#define PG8_WAIT_L(n) asm volatile("s_waitcnt lgkmcnt(" #n ")" ::: "memory")
#define PG8_BAR __builtin_amdgcn_s_barrier()
#define PG8_SCHED __builtin_amdgcn_sched_barrier(0)
    Unit cur, nxt; int ui = 0;
    if (!S.next(0, cur)) return;
    f32x4 acc[2][2][4][2];
#pragma unroll
    for (int a = 0; a < 2; ++a)
#pragma unroll
        for (int b = 0; b < 2; ++b)
#pragma unroll
            for (int m = 0; m < 4; ++m)
#pragma unroll
                for (int n = 0; n < 2; ++n) acc[a][b][m][n] = (f32x4){0.f, 0.f, 0.f, 0.f};
    bf16x8 At[4][2], B0[2][2], B1[2][2];
    const char* cA = (const char*)g.A + (size_t)cur.pm * tstep; const char* cB = (const char*)g.Bt + (size_t)cur.pn * tstep;
    S.a_ready(cur);
    if constexpr (SP2) {
        PG8_STAGE(PG8_SB(0, 0), cB, voffB); PG8_STAGE(PG8_SB(0, 1), cB + hstep, voffB); PG8_STAGE(PG8_SA(0, 0), cA, voffA); PG8_STAGE(PG8_SA(0, 1), cA + hstep, voffA);
        if (wr == 1) PG8_BAR;
        PG8_WAIT_V(2); PG8_BAR;
        PG8_STAGE(PG8_SB(1, 0), cB + kstep, voffB); PG8_STAGE(PG8_SA(1, 0), cA + kstep, voffA); PG8_STAGE(PG8_SB(1, 1), cB + hstep + kstep, voffB);
        PG8_WAIT_V(6); PG8_BAR;
    } else {
        PG8_STAGE(PG8_SB(0, 0), cB, voffB); PG8_STAGE(PG8_SA(0, 0), cA, voffA); PG8_STAGE(PG8_SB(0, 1), cB + hstep, voffB); PG8_STAGE(PG8_SA(0, 1), cA + hstep, voffA);
        if (wr == 1) PG8_BAR;
        PG8_WAIT_V(4); PG8_BAR;
        PG8_STAGE(PG8_SB(1, 0), cB + kstep, voffB); PG8_STAGE(PG8_SA(1, 0), cA + kstep, voffA); PG8_STAGE(PG8_SB(1, 1), cB + hstep + kstep, voffB);
        PG8_WAIT_V(6); PG8_BAR;
    }
    for (;;) {
        const bool has_next = S.next(ui + 1, nxt);
        const char* nA = has_next ? (const char*)g.A + (size_t)nxt.pm * tstep : cA; const char* nB = has_next ? (const char*)g.Bt + (size_t)nxt.pn * tstep : cB;
        for (int t = 0; t < nt; t += 2) {
            const bool last = (t == nt - 2);
            const char* a1 = cA + (size_t)(t + 1) * kstep;
            const char* a2 = last ? nA : cA + (size_t)(t + 2) * kstep; const char* b2 = last ? nB : cB + (size_t)(t + 2) * kstep;
            const char* a3 = a2 + kstep; const char* b3 = b2 + kstep;
            if (last && has_next) S.a_ready(nxt);
            if constexpr (SP2) {
            PG8_LDB(B0, 0, 0); if constexpr (!HALF_N) PG8_LDB(B1, 0, 1); PG8_SCHED; PG8_LDA(At, 0, 0); PG8_STAGE(PG8_SA(1, 1), a1 + hstep, voffA);
            PG8_WAIT_V(8); PG8_WAIT_L(0); PG8_BAR; PG8_MMA(0, 0, At, B0); if constexpr (!HALF_N) PG8_MMA(0, 1, At, B1); PG8_BAR; PG8_SCHED;
            PG8_LDA(At, 0, 1); PG8_STAGE(PG8_SB(0, 0), b2, voffB); PG8_STAGE(PG8_SB(0, 1), b2 + hstep, voffB); PG8_STAGE(PG8_SA(0, 0), a2, voffA);
            PG8_WAIT_V(8); PG8_WAIT_L(0); PG8_BAR; PG8_MMA(1, 0, At, B0); if constexpr (!HALF_N) PG8_MMA(1, 1, At, B1); PG8_BAR; PG8_SCHED;
            PG8_LDB(B0, 1, 0); if constexpr (!HALF_N) PG8_LDB(B1, 1, 1); PG8_SCHED; PG8_LDA(At, 1, 0); PG8_STAGE(PG8_SA(0, 1), a2 + hstep, voffA);
            PG8_WAIT_V(8); PG8_WAIT_L(0); PG8_BAR; PG8_MMA(0, 0, At, B0); if constexpr (!HALF_N) PG8_MMA(0, 1, At, B1); PG8_BAR; PG8_SCHED;
            PG8_LDA(At, 1, 1); PG8_STAGE(PG8_SB(1, 0), b3, voffB); PG8_STAGE(PG8_SB(1, 1), b3 + hstep, voffB); PG8_STAGE(PG8_SA(1, 0), a3, voffA);
            PG8_WAIT_V(8); PG8_WAIT_L(0); PG8_BAR; PG8_MMA(1, 0, At, B0); if constexpr (!HALF_N) PG8_MMA(1, 1, At, B1); PG8_BAR; PG8_SCHED;
            } else {
            PG8_LDB(B0, 0, 0); PG8_SCHED; PG8_LDA(At, 0, 0); PG8_STAGE(PG8_SA(1, 1), a1 + hstep, voffA);
            PG8_WAIT_L(8); PG8_BAR; PG8_WAIT_L(0); PG8_MMA(0, 0, At, B0); PG8_BAR; PG8_SCHED;
            PG8_LDB(B1, 0, 1); PG8_STAGE(PG8_SB(0, 0), b2, voffB);
            PG8_BAR; PG8_WAIT_L(0); PG8_MMA(0, 1, At, B1); PG8_BAR;
            PG8_LDA(At, 0, 1); PG8_STAGE(PG8_SA(0, 0), a2, voffA);
            PG8_BAR; PG8_WAIT_L(0); PG8_MMA(1, 0, At, B0); PG8_BAR; PG8_SCHED;
            PG8_STAGE(PG8_SB(0, 1), b2 + hstep, voffB);
            PG8_WAIT_V(6); PG8_BAR; PG8_MMA(1, 1, At, B1); PG8_BAR;
            PG8_LDB(B0, 1, 0); PG8_SCHED; PG8_LDA(At, 1, 0); PG8_STAGE(PG8_SA(0, 1), a2 + hstep, voffA);
            PG8_WAIT_L(8); PG8_BAR; PG8_WAIT_L(0); PG8_MMA(0, 0, At, B0); PG8_BAR; PG8_SCHED;
            PG8_LDB(B1, 1, 1); PG8_STAGE(PG8_SB(1, 0), b3, voffB);
            PG8_BAR; PG8_WAIT_L(0); PG8_MMA(0, 1, At, B1); PG8_BAR;
            PG8_LDA(At, 1, 1); PG8_STAGE(PG8_SA(1, 0), a3, voffA);
            PG8_BAR; PG8_WAIT_L(0); PG8_MMA(1, 0, At, B0); PG8_BAR; PG8_SCHED;
            PG8_STAGE(PG8_SB(1, 1), b3 + hstep, voffB);
            PG8_WAIT_V(6); PG8_BAR; PG8_MMA(1, 1, At, B1); PG8_BAR;
            }
        }
        if constexpr (ALIGN_EPI) { if (wr == 0) PG8_BAR; }
        if constexpr (!Epi::AFTER_DRAIN) { E(acc, cur, wr, wc, fr, fq); S.done(cur); }
        if (!has_next) break;
#pragma unroll
        for (int a = 0; a < 2; ++a)
#pragma unroll
            for (int b = 0; b < 2; ++b)
#pragma unroll
                for (int m = 0; m < 4; ++m)
#pragma unroll
                    for (int n = 0; n < 2; ++n) acc[a][b][m][n] = (f32x4){0.f, 0.f, 0.f, 0.f};
        cur = nxt; cA = nA; cB = nB; ++ui;
        if constexpr (ALIGN_EPI) { if (wr == 1) PG8_BAR; }
    }
    PG8_WAIT_V(0);
    if constexpr (!ALIGN_EPI) { if (wr == 0) PG8_BAR; }
    PG8_BAR;
    if constexpr (Epi::AFTER_DRAIN) { E.fused(acc, cur, wr, wc, fr, fq, lds, wid, lane); S.done(cur); }
#undef PG8_SA
#undef PG8_SB
#undef PG8_STAGE
#undef PG8_LDA
#undef PG8_LDB
#undef PG8_MMA
#undef PG8_WAIT_V
#undef PG8_WAIT_L
#undef PG8_BAR
#undef PG8_SCHED
}
}
namespace pg8 {
typedef unsigned u32x2 __attribute__((ext_vector_type(2)));
constexpr float kAlpha = 1.189207115002721f;
__device__ __forceinline__ float silu_f(float x) { return x * __builtin_amdgcn_rcpf(1.f + __builtin_amdgcn_exp2f(-1.4426950408889634f * x)); }
__device__ __forceinline__ float gelu_f(float x) { const float t = x * (1.f + 0.044715f * x * x); return x * __builtin_amdgcn_rcpf(1.f + __builtin_amdgcn_exp2f(-2.3022081981f * t)); }
__device__ __forceinline__ f32x4 sigmoid_scaled4(const f32x4 t) {
    const f32x4 e = (f32x4){__builtin_amdgcn_exp2f(t[0]), __builtin_amdgcn_exp2f(t[1]), __builtin_amdgcn_exp2f(t[2]), __builtin_amdgcn_exp2f(t[3])} + 1.0f;
    return (f32x4){__builtin_amdgcn_rcpf(e[0]), __builtin_amdgcn_rcpf(e[1]), __builtin_amdgcn_rcpf(e[2]), __builtin_amdgcn_rcpf(e[3])};
}
__device__ __forceinline__ f32x4 silu4(const f32x4 x) { return x * sigmoid_scaled4(x * -1.4426950408889634f); }
__device__ __forceinline__ f32x4 gelu4(const f32x4 x) { return x * sigmoid_scaled4((x * (x * x * 0.044715f + 1.0f)) * -2.3022081981f); }
__device__ __forceinline__ u32x4 pack8(const f32x4 a, const f32x4 b) { u32x4 w; w.x = cvt_pk_bf16(a[0], a[1]); w.y = cvt_pk_bf16(a[2], a[3]); w.z = cvt_pk_bf16(b[0], b[1]); w.w = cvt_pk_bf16(b[2], b[3]); return w; }
__device__ __forceinline__ f32x4 unpack4(const u32x2 w) { f32x4 r; r[0] = __uint_as_float(w.x << 16); r[1] = __uint_as_float(w.x & 0xffff0000u); r[2] = __uint_as_float(w.y << 16); r[3] = __uint_as_float(w.y & 0xffff0000u); return r; }

__device__ __forceinline__ void stats_from(const f32x4 a, const f32x4 b, float& mean, float& rstd) {
    mean = ((a[0] + a[2]) + (b[0] + b[2])) * 0.25f;
    const float d0 = a[0] - mean, d1 = a[2] - mean, d2 = b[0] - mean, d3 = b[2] - mean;
    rstd = 1.0f / sqrtf((((a[1] + a[3]) + (b[1] + b[3])) + 256.f * ((d0 * d0 + d1 * d1) + (d2 * d2 + d3 * d3))) * (1.f / 1024.f) + 1e-5f);
}
typedef float f32x2t __attribute__((ext_vector_type(2)));
__device__ __forceinline__ void panel_stats_to_lds(const float* st, int pm, PG8_LAS f32x2t* T, int tid) {
    if (tid < 256) { const size_t row = (size_t)(pm * BM + tid); float mean, rstd; stats_from(*(const f32x4*)(st + row * 8), *(const f32x4*)(st + row * 8 + 4), mean, rstd); T[tid] = (f32x2t){mean, rstd}; }
    asm volatile("s_waitcnt lgkmcnt(0)" ::: "memory"); __builtin_amdgcn_s_barrier(); asm volatile("" ::: "memory");
}
__device__ __forceinline__ void fold_ln(f32x4 (&acc)[2][2][4][2], const float* st, const float* c1, const float* c2, const Unit& u, int wr, int wc, int fr, int fq, unsigned tlds) {
    PG8_LAS f32x2t* T = (PG8_LAS f32x2t*)(size_t)tlds;
    const int rl0 = wr * 64 + fr, col0 = u.pn * BM + wc * 32 + 8 * fq;
    f32x4 c1v[2][2], c2v[2][2];
#pragma unroll
    for (int bj = 0; bj < 2; ++bj)
#pragma unroll
        for (int n = 0; n < 2; ++n) { c1v[bj][n] = *(const f32x4*)(c1 + col0 + bj * HALF + 4 * n); c2v[bj][n] = *(const f32x4*)(c2 + col0 + bj * HALF + 4 * n); }
    __builtin_amdgcn_sched_barrier(0);
    panel_stats_to_lds(st, u.pm, T, (wr * 4 + wc) * 64 + fq * 16 + fr);
#pragma unroll
    for (int ai = 0; ai < 2; ++ai)
#pragma unroll
        for (int m = 0; m < 4; ++m) { const f32x2t t = T[ai * HALF + m * 16 + rl0]; const float tq = -t.y * t.x;
#pragma unroll
            for (int bj = 0; bj < 2; ++bj)
#pragma unroll
                for (int n = 0; n < 2; ++n) acc[ai][bj][m][n] = acc[ai][bj][m][n] * t.y + (c1v[bj][n] * tq + c2v[bj][n]); }
}

template <int RESMODE, bool HALFACC> struct EpiZ {
    static constexpr bool PERM = true, AFTER_DRAIN = false;
    const bf16_t* res; const float* stprev; const float* gamma; const float* beta; bf16_t* Z; float* ST; unsigned xlds; static constexpr float racc = HALFACC ? 0.5f : 1.0f;
    __device__ __forceinline__ void operator()(f32x4 (&acc)[2][2][4][2], const Unit& u, int wr, int wc, int fr, int fq) const {
        asm volatile("" : "+v"(fr), "+v"(fq));
        typedef float f32x2v __attribute__((ext_vector_type(2)));
        PG8_LAS f32x2v* P = (PG8_LAS f32x2v*)(size_t)xlds;
        const int rl0 = wr * 64 + fr, col0 = u.pn * BM + wc * 32 + 8 * fq;
        PG8_LAS f32x2t* T = (PG8_LAS f32x2t*)(size_t)(xlds + 8192);
        if (RESMODE == 1) panel_stats_to_lds(stprev, u.pm, T, (wr * 4 + wc) * 64 + fq * 16 + fr);
#pragma unroll
        for (int ai = 0; ai < 2; ++ai) {
            u32x4 raw[4][2];
#pragma unroll
            for (int m = 0; m < 4; ++m) { const size_t off = (size_t)(u.pm * BM + ai * HALF + m * 16 + rl0) * 1024 + col0;
                raw[m][0] = *(const u32x4*)(res + off); raw[m][1] = *(const u32x4*)(res + off + HALF); }
            __builtin_amdgcn_sched_barrier(0);
#pragma unroll
            for (int m = 0; m < 4; ++m) { const int rl = ai * HALF + m * 16 + rl0; const size_t off = (size_t)(u.pm * BM + rl) * 1024 + col0;
                float mu = 0.f, rs = 1.f; if (RESMODE == 1) { const f32x2t t = T[rl]; mu = t.x; rs = t.y; }
                float s = 0.f, q = 0.f;
#pragma unroll
                for (int bj = 0; bj < 2; ++bj) { const u32x4 rw = raw[m][bj];
                    f32x4 r0 = unpack4((u32x2){rw.x, rw.y}), r1 = unpack4((u32x2){rw.z, rw.w});
                    if (RESMODE == 1) { const float* gp = gamma + col0 + bj * HALF; const float* bp = beta + col0 + bj * HALF;
                        r0 = (r0 - mu) * rs * *(const f32x4*)gp + *(const f32x4*)bp; r1 = (r1 - mu) * rs * *(const f32x4*)(gp + 4) + *(const f32x4*)(bp + 4); }
                    const f32x4 z0 = r0 * kAlpha + acc[ai][bj][m][0] * racc, z1 = r1 * kAlpha + acc[ai][bj][m][1] * racc;
                    *(u32x4*)(Z + off + bj * HALF) = pack8(z0, z1);
#pragma unroll
                    for (int i = 0; i < 4; ++i) { s += z0[i] + z1[i]; q += z0[i] * z0[i] + z1[i] * z1[i]; } }
                s += __shfl_xor(s, 16); s += __shfl_xor(s, 32); q += __shfl_xor(q, 16); q += __shfl_xor(q, 32);
                const float mw = s * (1.0f / 64.0f); q = fmaxf(q - s * mw, 0.f);
                if (fq == 0) P[rl * 4 + wc] = (f32x2v){mw, q}; }
            asm volatile("" ::: "memory"); }
        asm volatile("s_waitcnt lgkmcnt(0)" ::: "memory"); __builtin_amdgcn_s_barrier(); asm volatile("" ::: "memory");
        const int tid = (wr * 4 + wc) * 64 + fq * 16 + fr;
        if (tid < 256) { const f32x2v a = P[tid * 4 + 0], b = P[tid * 4 + 1], c = P[tid * 4 + 2], d = P[tid * 4 + 3];
            const float mt = ((a.x + b.x) + (c.x + d.x)) * 0.25f; const float da = a.x - mt, db = b.x - mt, dc = c.x - mt, dd = d.x - mt;
            const float m2 = ((a.y + b.y) + (c.y + d.y)) + 64.0f * ((da * da + db * db) + (dc * dc + dd * dd));
            *(f32x2v*)(ST + ((size_t)(u.pm * BM + tid) * 4 + u.pn) * 2) = (f32x2v){mt, m2}; }
        asm volatile("s_waitcnt lgkmcnt(0)" ::: "memory"); __builtin_amdgcn_s_barrier(); asm volatile("" ::: "memory");
    }
};

template <bool FOLD> struct EpiSwiGLU {
    static constexpr bool PERM = true, AFTER_DRAIN = false;
    bf16_t* H; int ldh; const float* st; const float* c1; const float* c2; unsigned tlds;
    __device__ __forceinline__ void operator()(f32x4 (&acc)[2][2][4][2], const Unit& u, int wr, int wc, int fr, int fq) const {
        asm volatile("" : "+v"(fr), "+v"(fq));
        const int row0 = u.pm * BM + wr * 64 + fr, col0 = u.pn * HALF + wc * 32 + 8 * fq;
        if (FOLD) fold_ln(acc, st, c1, c2, u, wr, wc, fr, fq, tlds);
#pragma unroll
        for (int ai = 0; ai < 2; ++ai)
#pragma unroll
            for (int m = 0; m < 4; ++m) {
                const f32x4 h0 = silu4(acc[ai][0][m][0]) * acc[ai][1][m][0], h1 = silu4(acc[ai][0][m][1]) * acc[ai][1][m][1];
                *(u32x4*)(H + (size_t)(row0 + ai * HALF + m * 16) * ldh + col0) = pack8(h0, h1);
            }
    }
};

struct EpiWin {
    static constexpr bool PERM = true, AFTER_DRAIN = false;
    bf16_t *U, *GV, *Q, *Kb, *VT, *QI, *KI; float *GVST, *WI, *outK, *outV, *outKI; const float *ropeC, *ropeS; const float *st, *c1, *c2; unsigned tlds; int pn_off;
    __device__ __forceinline__ void operator()(f32x4 (&acc)[2][2][4][2], const Unit& u, int wr, int wc, int fr, int fq) const {
        asm volatile("" : "+v"(fr), "+v"(fq));
        const int pn = u.pn + pn_off, rl0 = wr * 64 + fr, rowb = u.pm * BM + rl0, cl = wc * 32 + 8 * fq;
        const int j0 = 4 * (4 * (wc & 1) + fq);
        PG8_LAS f32x2t* T = (PG8_LAS f32x2t*)(size_t)tlds;
        const float* c1p = c1 + pn * BM + cl; const float* c2p = c2 + pn * BM + cl;
        const bool roped = pn >= 4;
        f32x4 cc1[2][2], cc2[2][2];
#pragma unroll
        for (int bj = 0; bj < 2; ++bj)
#pragma unroll
            for (int n = 0; n < 2; ++n) { cc1[bj][n] = *(const f32x4*)(c1p + bj * HALF + 4 * n); cc2[bj][n] = *(const f32x4*)(c2p + bj * HALF + 4 * n); }
        f32x4 rc = (f32x4){1.f, 1.f, 1.f, 1.f}, rsn = (f32x4){0.f, 0.f, 0.f, 0.f};
        if (roped) { const int t0 = rowb & 2047; rc = *(const f32x4*)(ropeC + t0 * 32 + j0); rsn = *(const f32x4*)(ropeS + t0 * 32 + j0); }
        __builtin_amdgcn_sched_barrier(0);
        panel_stats_to_lds(st, u.pm, T, (wr * 4 + wc) * 64 + fq * 16 + fr);
#define WIN_ROW(ai, m) const f32x2t tr_ = T[(ai) * HALF + (m) * 16 + rl0]; const float tq_ = -tr_.y * tr_.x
#define WIN_F(ai, bj, m, n) (acc[ai][bj][m][n] * tr_.y + (cc1[bj][n] * tq_ + cc2[bj][n]))
#define WIN_ROPE_NEXT(ai, m) const f32x4 c = rc, s = rsn; if ((ai) * 4 + (m) < 7) { const int gn_ = (ai) * 4 + (m) + 1; const int tn_ = (rowb + (gn_ >> 2) * HALF + (gn_ & 3) * 16) & 2047; \
            rc = *(const f32x4*)(ropeC + tn_ * 32 + j0); rsn = *(const f32x4*)(ropeS + tn_ * 32 + j0); } __builtin_amdgcn_sched_barrier(0)
        if (pn < 2) {
#pragma unroll
            for (int ai = 0; ai < 2; ++ai)
#pragma unroll
                for (int m = 0; m < 4; ++m) { WIN_ROW(ai, m); bf16_t* p = U + (size_t)(rowb + ai * HALF + m * 16) * 512 + pn * 256 + cl;
#pragma unroll
                    for (int bj = 0; bj < 2; ++bj) { const f32x4 x0 = WIN_F(ai, bj, m, 0), x1 = WIN_F(ai, bj, m, 1);
                        *(u32x4*)(p + bj * HALF) = pack8(gelu4(x0), gelu4(x1)); } }
        } else if (pn < 4) {
#pragma unroll
            for (int ai = 0; ai < 2; ++ai)
#pragma unroll
                for (int m = 0; m < 4; ++m) { WIN_ROW(ai, m); const size_t row = (size_t)(rowb + ai * HALF + m * 16); bf16_t* p = GV + row * 512 + (pn - 2) * 256 + cl;
                    f32x4 g[2][2]; float s = 0.f;
#pragma unroll
                    for (int bj = 0; bj < 2; ++bj) {
#pragma unroll
                        for (int n = 0; n < 2; ++n) { g[bj][n] = gelu4(WIN_F(ai, bj, m, n)); s += (g[bj][n][0] + g[bj][n][1]) + (g[bj][n][2] + g[bj][n][3]); }
                        *(u32x4*)(p + bj * HALF) = pack8(g[bj][0], g[bj][1]); }
                    s += __shfl_xor(s, 16); s += __shfl_xor(s, 32);
                    const float mw = s * (1.0f / 64.0f); float q = 0.f;
#pragma unroll
                    for (int bj = 0; bj < 2; ++bj)
#pragma unroll
                        for (int n = 0; n < 2; ++n)
#pragma unroll
                            for (int i = 0; i < 4; ++i) { const float d = g[bj][n][i] - mw; q += d * d; }
                    q += __shfl_xor(q, 16); q += __shfl_xor(q, 32);
                    if (fq == 0) *(f32x2t*)(GVST + ((row * 2 + (pn - 2)) * 4 + wc) * 2) = (f32x2t){mw, q}; }
        } else if (pn == 4 || pn == 5 || pn == 7) {
            bf16_t* dst = (pn == 7) ? QI : Q + (pn - 4) * 256; const int ld = (pn == 7) ? 256 : 512;
            const float qsc = (pn == 7) ? 1.0f : 0.125f * 1.4426950408889634f;
#pragma unroll
            for (int ai = 0; ai < 2; ++ai)
#pragma unroll
                for (int m = 0; m < 4; ++m) { WIN_ROW(ai, m); const int row = rowb + ai * HALF + m * 16; WIN_ROPE_NEXT(ai, m);
#pragma unroll
                    for (int bj = 0; bj < 2; ++bj) { const f32x4 x1 = WIN_F(ai, bj, m, 0), x2 = WIN_F(ai, bj, m, 1);
                        *(u32x4*)(dst + (size_t)row * ld + bj * HALF + cl) = pack8((x1 * c - x2 * s) * qsc, (x2 * c + x1 * s) * qsc); } }
        } else if (pn == 6) {
#pragma unroll
            for (int ai = 0; ai < 2; ++ai)
#pragma unroll
                for (int m = 0; m < 4; ++m) { WIN_ROW(ai, m); const int row = rowb + ai * HALF + m * 16; const int t = row & 2047; WIN_ROPE_NEXT(ai, m);
                    const f32x4 x1 = WIN_F(ai, 0, m, 0), x2 = WIN_F(ai, 0, m, 1); const f32x4 o1 = x1 * c - x2 * s, o2 = x2 * c + x1 * s;
                    *(u32x4*)(Kb + (size_t)row * 128 + cl) = pack8(o1, o2);
                    float* ok = outK + (size_t)row * 128 + (wc >> 1) * 64 + j0; *(f32x4*)ok = o1; *(f32x4*)(ok + 32) = o2;
                    const f32x4 v0 = WIN_F(ai, 1, m, 0), v1 = WIN_F(ai, 1, m, 1);
                    float* ov = outV + (size_t)row * 128 + cl; *(f32x4*)ov = v0; *(f32x4*)(ov + 4) = v1;
                    *(u32x4*)(VT + (size_t)row * 128 + cl) = pack8(v0, v1); }
        } else {
            if (wc < 2) {
#pragma unroll
                for (int ai = 0; ai < 2; ++ai)
#pragma unroll
                    for (int m = 0; m < 4; ++m) { WIN_ROW(ai, m); const int row = rowb + ai * HALF + m * 16; WIN_ROPE_NEXT(ai, m);
                        const f32x4 x1 = WIN_F(ai, 0, m, 0), x2 = WIN_F(ai, 0, m, 1); const f32x4 o1 = x1 * c - x2 * s, o2 = x2 * c + x1 * s;
                        *(u32x4*)(KI + (size_t)row * 64 + cl) = pack8(o1, o2);
                        float* ok = outKI + (size_t)row * 64 + j0; *(f32x4*)ok = o1; *(f32x4*)(ok + 32) = o2; }
            } else if (wc == 2 && fq == 0) {
#pragma unroll
                for (int ai = 0; ai < 2; ++ai)
#pragma unroll
                    for (int m = 0; m < 4; ++m) { WIN_ROW(ai, m); const int row = rowb + ai * HALF + m * 16; *(f32x4*)(WI + (size_t)row * 4) = WIN_F(ai, 0, m, 0) * 0.0625f; }
            }
        }
#undef WIN_ROPE_NEXT
        __builtin_amdgcn_s_waitcnt(0x0F70);
#undef WIN_ROW
#undef WIN_F
    }
};
}
constexpr int NWAVES = 8;
#ifndef MK_N_LAUNCHES
#define MK_N_LAUNCHES 1
#endif
constexpr int N_PHASES = 9;
constexpr int N_LAUNCHES = MK_N_LAUNCHES;

constexpr int DM = 1024, NB = 16, SEQ = 2048, MP = NB * SEQ, NS = 128, FF = 2816, INW = 2116, INWP = 2304, PAST = 8192, NPAGE = 64;
constexpr float LN_EPS = 1e-5f, kAlpha = pg8::kAlpha;
constexpr size_t OUT_Y = 0, OUT_YS = 33554432, OUT_KP = 33685504, OUT_VP = 37879808, OUT_KIP = 42074112, OUT_KS = 44171264, OUT_VS = 44187648, OUT_KIS = 44204032, OUT_AV = 44212224, OUT_TOTAL = 44277760;

constexpr size_t MiB = 1u << 20;
constexpr size_t WS_CTL = 0, CTL_ZERO_BYTES = 1 * MiB;
constexpr size_t WS_ROPEC = 1 * MiB, WS_ROPES = WS_ROPEC + 2049 * 32 * 4;
constexpr size_t WS_W1UP = 2 * MiB, WS_W1DN = 13 * MiB, WS_WIN = 19 * MiB, WS_WOUT = 24 * MiB, WS_W2UP = 26 * MiB, WS_W2DN = 37 * MiB;
constexpr size_t WS_XB = 64 * MiB;
constexpr size_t WS_H = 128 * MiB;
constexpr size_t WS_Z1 = 304 * MiB;
constexpr size_t WS_U = 368 * MiB;
constexpr size_t WS_GV = 400 * MiB;
constexpr size_t WS_GVST = 432 * MiB;
constexpr size_t WS_Q = 434 * MiB;
constexpr size_t WS_K = 466 * MiB;
constexpr size_t WS_VT = 474 * MiB;
constexpr size_t WS_QI = 482 * MiB;
constexpr size_t WS_KI = 498 * MiB;
constexpr size_t WS_WI = 502 * MiB;
constexpr size_t WS_MASK = 503 * MiB;
constexpr size_t WS_MIX = 512 * MiB;
constexpr size_t WS_Z2 = 576 * MiB;
constexpr size_t WS_SMP = 644 * MiB;
constexpr size_t SM_HS = WS_SMP, SM_Z1 = SM_HS + 128 * 2816 * 4, SM_ST1 = SM_Z1 + 128 * 1024 * 4, SM_US = SM_ST1 + 128 * 64 * 8, SM_GVS = SM_US + 128 * 512 * 4,
                 SM_QS = SM_GVS + 128 * 512 * 4, SM_QIS = SM_QS + 128 * 512 * 4, SM_WIS = SM_QIS + 128 * 256 * 4, SM_MIXS = SM_WIS + 128 * 4 * 4, SM_Z2 = SM_MIXS + 128 * 1024 * 4,
                 SM_ST2 = SM_Z2 + 128 * 1024 * 4, SM_Z3 = SM_ST2 + 128 * 64 * 8, SM_XSB = SM_Z3 + 128 * 1024 * 4, SM_MIXSB = SM_XSB + 128 * 1024 * 2, SM_Z1B = SM_MIXSB + 128 * 1024 * 2, SM_Z2B = SM_Z1B + 128 * 1024 * 2, SM_END = SM_Z2B + 128 * 1024 * 2;
constexpr size_t WS_Z3 = 304 * MiB;
constexpr size_t WS_STZ3 = 651 * MiB;
constexpr size_t WS_STZ1 = 652 * MiB, WS_STZ2 = 653 * MiB;
constexpr size_t WS_PS = 654 * MiB;
constexpr size_t PS_IN = WS_PS, PS_UP = WS_PS + 2 * 16 * 2304 * 4;
constexpr size_t WS_CV = 656 * MiB;
constexpr size_t CV_C1IN = WS_CV, CV_C2IN = CV_C1IN + 2304 * 4, CV_C1UP = CV_C2IN + 2304 * 4, CV_C2UP = CV_C1UP + 5632 * 4;
constexpr size_t WS_AWSB = 657 * MiB;
constexpr size_t WS_END = 658 * MiB;
static_assert(SM_END <= WS_END, "d_ws map");
constexpr int CW_TMO = 0, CW_CODE = 1;
constexpr int CW_BAR = 4096;
constexpr int CW_QUEUE = 64;

constexpr int RING_OFF = 0, RING_BYTES = 147968;
constexpr int XLDS_OFF = 131072;
constexpr int LDSCTL_OFF = RING_BYTES, MISC_OFF = LDSCTL_OFF + 320;
constexpr int LDS_BYTES = 163840;
static_assert(MISC_OFF + 128 <= LDS_BYTES, "LDS map");
#define GAS __attribute__((address_space(1)))
#define LAS __attribute__((address_space(3)))
typedef unsigned short bf16;
typedef unsigned v4u __attribute__((ext_vector_type(4)));
typedef float f32x4 __attribute__((ext_vector_type(4)));
typedef short bf16x8 __attribute__((ext_vector_type(8)));
typedef GAS unsigned gu32;
typedef GAS unsigned long long gu64;
#define RLX_AGENT __ATOMIC_RELAXED, __HIP_MEMORY_SCOPE_AGENT
#define LDS_WAIT() asm volatile("s_waitcnt lgkmcnt(0)" ::: "memory")
#define VM_WAIT() asm volatile("s_waitcnt vmcnt(0)" ::: "memory")
__device__ __forceinline__ unsigned long long rt() { return __builtin_amdgcn_s_memrealtime(); }
__device__ __forceinline__ unsigned f2bf(float f) { unsigned u = __builtin_bit_cast(unsigned, f); return (u + 0x7fffu + ((u >> 16) & 1u)) >> 16; }
__device__ __forceinline__ unsigned pk2(float lo, float hi) { return f2bf(lo) | (f2bf(hi) << 16); }

#define XB_TMO      128
#define XB_XCNT(j)  (256  + 64 * (j))
#define XB_XSUB(j)  (1280 + 64 * (j))
#define XB_XGEN(j)  (2304 + 64 * (j))
#define XB_TOP      3328
#define XB_TOPGEN   3392
#define XCD_BAR_WORDS 3456
#define XB_SPIN_CAP (1u << 18)

__device__ __forceinline__ unsigned xb_ld(unsigned* p)              { return __hip_atomic_load(p, __ATOMIC_RELAXED, __HIP_MEMORY_SCOPE_AGENT); }
__device__ __forceinline__ unsigned xb_add(unsigned* p, unsigned v) { return __hip_atomic_fetch_add(p, v, __ATOMIC_RELAXED, __HIP_MEMORY_SCOPE_AGENT); }
__device__ __forceinline__ unsigned xb_xcc_id() { return (unsigned)__builtin_amdgcn_s_getreg((3 << 11) | 20) & 0xFu; }
#define XB_SPIN(cond, bar) do { unsigned _sp = 0; while (cond) { __builtin_amdgcn_s_sleep(1); \
    if ((++_sp & 255u) == 0u) { if (xb_ld(&(bar)[XB_TMO])) break; if (_sp > XB_SPIN_CAP) { atomicAdd(&(bar)[XB_TMO], 1u); break; } } } } while (0)

struct XcdBarrier {
    unsigned* bar; unsigned x;
    volatile LAS unsigned* st;
};

__device__ __forceinline__ XcdBarrier xcd_barrier_post(unsigned* bar, volatile LAS unsigned* st) {
    XcdBarrier b; b.bar = bar; b.x = xb_xcc_id(); b.st = st;
    if (threadIdx.x == 0) (void)xb_add(&bar[XB_XCNT(b.x)], 1u);
    return b;
}
__device__ __forceinline__ void xcd_barrier_complete(unsigned* bar, unsigned x, unsigned& nloc, unsigned& nx) {
    const unsigned G = gridDim.x * gridDim.y * gridDim.z;
    unsigned sum, cnt, mine, sp = 0u;
    for (;;) {
        sum = 0u; cnt = 0u; mine = 0u;
#pragma unroll
        for (unsigned j = 0; j < 16; ++j) { const unsigned c = xb_ld(&bar[XB_XCNT(j)]); sum += c; cnt += (c > 0u) ? 1u : 0u; mine = (j == x) ? c : mine; }
        if (sum == G) break;
        __builtin_amdgcn_s_sleep(1);
        if ((++sp & 255u) == 0u) { if (xb_ld(&bar[XB_TMO])) break; if (sp > XB_SPIN_CAP) { atomicAdd(&bar[XB_TMO], 1u); break; } }
    }
    nloc = mine > 0u ? mine : 1u; nx = cnt > 0u ? cnt : 1u;
}

__device__ __forceinline__ void xcd_barrier(const XcdBarrier& b) {
    asm volatile("s_waitcnt vmcnt(0)" ::: "memory");
    __syncthreads();
    if (threadIdx.x == 0) {
        unsigned* bar = b.bar;
        __builtin_amdgcn_s_waitcnt(0);
        unsigned nloc = b.st[0], nx = b.st[1];
        if (nloc == 0u) { xcd_barrier_complete(bar, b.x, nloc, nx); b.st[0] = nloc; b.st[1] = nx; }
        const unsigned old = xb_add(&bar[XB_XSUB(b.x)], 1u);
        const unsigned gen = old / nloc;
        if (old + 1u == (gen + 1u) * nloc) {
            __builtin_amdgcn_fence(__ATOMIC_RELEASE, "agent");
            asm volatile("s_waitcnt vmcnt(0)" ::: "memory");
            const unsigned og = xb_add(&bar[XB_TOP], 1u);
            const unsigned tg = og / nx;
            if (og + 1u == (tg + 1u) * nx) xb_add(&bar[XB_TOPGEN], 1u);
            else XB_SPIN(xb_ld(&bar[XB_TOPGEN]) == tg, bar);
            __builtin_amdgcn_fence(__ATOMIC_ACQUIRE, "agent");
            xb_add(&bar[XB_XGEN(b.x)], 1u);
            asm volatile("s_waitcnt vmcnt(0)" ::: "memory");
        } else {
            XB_SPIN(xb_ld(&bar[XB_XGEN(b.x)]) == gen, bar);
            __builtin_amdgcn_fence(__ATOMIC_ACQUIRE, "agent");
            asm volatile("s_waitcnt vmcnt(0)" ::: "memory");
        }
    }
    __syncthreads();
}
typedef float f32x2 __attribute__((ext_vector_type(2)));
typedef unsigned u32x2 __attribute__((ext_vector_type(2)));
typedef float f32x16 __attribute__((ext_vector_type(16)));
struct Frame {
    LAS unsigned char* lds;
    volatile LAS unsigned* MISC;
    gu32* ctl;
    int tid, lane, wave, vcu, G;
    float* out; unsigned char* ws;
};
struct Args { const void* in[22]; float* out; unsigned char* ws; int ph_lo, ph_hi; };
#define IN_F(k) ((const float*)A.in[k])
__device__ __forceinline__ const float* in_lds(const Frame& F, int k) {
    const volatile LAS unsigned* t = (const volatile LAS unsigned*)(F.lds + LDSCTL_OFF);
    const unsigned lo = (unsigned)__builtin_amdgcn_readfirstlane((int)t[2 * k]), hi = (unsigned)__builtin_amdgcn_readfirstlane((int)t[2 * k + 1]);
    return (const float*)(const GAS float*)(((unsigned long long)hi << 32) | lo);
}
#define IN_L(k) in_lds(F, k)
__device__ __forceinline__ void launder(Frame& F) { unsigned long long w = (unsigned long long)F.ws, o = (unsigned long long)F.out; int t = F.tid, l = F.lane, wv = F.wave; asm volatile("" : "+s"(w), "+s"(o), "+v"(t), "+v"(l), "+s"(wv));
    F.ws = (unsigned char*)(GAS unsigned char*)w; F.out = (float*)(GAS float*)o; F.tid = t; F.lane = l; F.wave = wv; }
enum { I_XP = 0, I_XS, I_CK, I_CV, I_CKI, I_PT, I_LN1G, I_LN1B, I_W1UP, I_W1DN, I_LN2G, I_LN2B, I_WIN, I_ALNG, I_ALNB, I_AWS, I_ABS, I_WOUT, I_LN3G, I_LN3B, I_W2UP, I_W2DN };

__device__ __forceinline__ float wave_sum(float v) {
#pragma unroll
    for (int o = 1; o < 64; o <<= 1) v += __shfl_xor(v, o);
    return v;
}
__device__ __forceinline__ float wave_max(float v) {
#pragma unroll
    for (int o = 1; o < 64; o <<= 1) v = fmaxf(v, __shfl_xor(v, o));
    return v;
}
__device__ __forceinline__ f32x4 mfma16(const bf16x8 a, const bf16x8 b, const f32x4 c) { return __builtin_amdgcn_mfma_f32_16x16x32_bf16(a, b, c, 0, 0, 0); }
__device__ __forceinline__ f32x16 mfma32(const bf16x8 a, const bf16x8 b, const f32x16 c) { return __builtin_amdgcn_mfma_f32_32x32x16_bf16(a, b, c, 0, 0, 0); }
__device__ __forceinline__ bf16x8 as_bf16x8(const v4u w) { return __builtin_bit_cast(bf16x8, w); }

template <int MODE> __device__ __forceinline__ int dest_row(int n) {
    if (MODE == 1) { const int half = n >= FF ? 1 : 0, j = n - half * FF; return 256 * (j >> 7) + 128 * half + (j & 127); }
    if (MODE == 2) { const bool rp = (n >= 1024 && n < 1664) || (n >= 1792 && n < 2112);
        if (rp) { const int base = n & ~63, cc = n & 63; return base + 8 * ((cc & 31) >> 2) + 4 * (cc >> 5) + (cc & 3); }
        return n; }
    return n;
}
template <int MODE, bool FOLD> __device__ __forceinline__ void p0_item(const float* W, int K, int N, int Npad, bf16* WT, LAS float* scr, int item, int lane, const float* gamma, const float* beta, float* ps1, float* ps2) {
    const int nblk = Npad / 32, kb = item / nblk, nb = item % nblk, k0 = 64 * kb, n0 = 32 * nb;
    const int nsrc = n0 + (lane & 31); const bool ok = nsrc < N;
    { float wv[32];
#pragma unroll
      for (int i = 0; i < 32; ++i) { const int kk = 2 * i + (lane >> 5); wv[i] = ok ? __builtin_nontemporal_load(W + (size_t)(k0 + kk) * N + nsrc) : 0.f; }
      __builtin_amdgcn_sched_barrier(0);
#pragma unroll
      for (int i = 0; i < 32; ++i) { const int kk = 2 * i + (lane >> 5); scr[kk * 33 + (lane & 31)] = wv[i]; } }
    LDS_WAIT(); asm volatile("" ::: "memory");
    const int c = lane & 7;
    f32x4 g0 = (f32x4){1.f, 1.f, 1.f, 1.f}, g1 = g0, b0 = (f32x4){0.f, 0.f, 0.f, 0.f}, b1 = b0;
    if (FOLD) { g0 = *(const f32x4*)(gamma + k0 + 8 * c); g1 = *(const f32x4*)(gamma + k0 + 8 * c + 4); b0 = *(const f32x4*)(beta + k0 + 8 * c); b1 = *(const f32x4*)(beta + k0 + 8 * c + 4); }
#pragma unroll
    for (int j = 0; j < 4; ++j) { const int n = (lane >> 3) + 8 * j; const LAS float* s = scr + (8 * c) * 33 + n;
        const float w0 = s[0 * 33], w1 = s[1 * 33], w2 = s[2 * 33], w3 = s[3 * 33], w4 = s[4 * 33], w5 = s[5 * 33], w6 = s[6 * 33], w7 = s[7 * 33];
        v4u o; o.x = pk2(w0 * g0[0], w1 * g0[1]); o.y = pk2(w2 * g0[2], w3 * g0[3]); o.z = pk2(w4 * g1[0], w5 * g1[1]); o.w = pk2(w6 * g1[2], w7 * g1[3]);
        const int dr = dest_row<MODE>(n0 + n);
        *(GAS v4u*)(WT + (size_t)dr * K + k0 + 8 * c) = o;
        if (FOLD) {
            float s1 = ((__uint_as_float(o.x << 16) + __uint_as_float(o.x & 0xffff0000u)) + (__uint_as_float(o.y << 16) + __uint_as_float(o.y & 0xffff0000u)))
                     + ((__uint_as_float(o.z << 16) + __uint_as_float(o.z & 0xffff0000u)) + (__uint_as_float(o.w << 16) + __uint_as_float(o.w & 0xffff0000u)));
            float s2 = ((w0 * b0[0] + w1 * b0[1]) + (w2 * b0[2] + w3 * b0[3])) + ((w4 * b1[0] + w5 * b1[1]) + (w6 * b1[2] + w7 * b1[3]));
            s1 += __shfl_xor(s1, 1); s1 += __shfl_xor(s1, 2); s1 += __shfl_xor(s1, 4); s2 += __shfl_xor(s2, 1); s2 += __shfl_xor(s2, 2); s2 += __shfl_xor(s2, 4);
            if (c == 0) { ps1[(size_t)kb * Npad + dr] = s1; ps2[(size_t)kb * Npad + dr] = s2; }
        } }
    LDS_WAIT(); asm volatile("" ::: "memory");
}
__device__ const float ROPE_INV[32] = {
    1.0f, 0.7498942093324559f, 0.5623413251903491f, 0.4216965034285822f, 0.31622776601683794f, 0.23713737056616552f, 0.1778279410038923f, 0.1333521432163324f,
    0.1f, 0.07498942093324559f, 0.05623413251903491f, 0.04216965034285822f, 0.03162277660168379f, 0.023713737056616554f, 0.01778279410038923f, 0.01333521432163324f,
    0.01f, 0.007498942093324558f, 0.005623413251903491f, 0.004216965034285822f, 0.0031622776601683794f, 0.0023713737056616554f, 0.0017782794100389228f, 0.001333521432163324f,
    0.001f, 0.0007498942093324559f, 0.0005623413251903491f, 0.00042169650342858224f, 0.00031622776601683794f, 0.00023713737056616554f, 0.00017782794100389227f, 0.0001333521432163324f };
__device__ __forceinline__ void p0_prologue(Frame& F, const Args& A) {
    LAS float* scr = (LAS float*)(F.lds + RING_OFF + F.wave * 16384);
    const int gw = F.vcu * NWAVES + F.wave, NGW = F.G * NWAVES;
    unsigned char* ws = F.ws;
    constexpr int I_UP = (DM / 64) * (2 * FF / 32), I_DN = (FF / 64) * (DM / 32), I_IN = (DM / 64) * (INWP / 32);
    constexpr int NITEMS = I_UP + I_DN + I_IN;
    for (int it = gw; it < NITEMS; it += NGW) {
        int r = it;
        if (r < I_UP) { p0_item<1, false>(IN_F(I_W1UP), DM, 2 * FF, 2 * FF, (bf16*)(ws + WS_W1UP), scr, r, F.lane, nullptr, nullptr, nullptr, nullptr); continue; } r -= I_UP;
        if (r < I_DN) { p0_item<0, false>(IN_F(I_W1DN), FF, DM, DM, (bf16*)(ws + WS_W1DN), scr, r, F.lane, nullptr, nullptr, nullptr, nullptr); continue; } r -= I_DN;
        p0_item<2, true>(IN_F(I_WIN), DM, INW, INWP, (bf16*)(ws + WS_WIN), scr, r, F.lane, IN_F(I_LN1G), IN_F(I_LN1B), (float*)(ws + PS_IN), (float*)(ws + PS_IN) + 16 * INWP);
    }
    { const size_t gt = (size_t)F.vcu * (NWAVES * 64) + F.tid, NT = (size_t)F.G * NWAVES * 64; const float* x = IN_F(I_XP); bf16* xb = (bf16*)(ws + WS_XB);
      static_assert(((size_t)MP * DM / 8) % ((size_t)256 * NWAVES * 64 * 8) == 0, "x conversion: whole batches of 8 per thread on a 256-workgroup grid");
      for (size_t e0 = gt; e0 < (size_t)MP * DM / 8; e0 += 8 * NT) {
          f32x4 a[8], b[8];
#pragma unroll
          for (int i = 0; i < 8; ++i) { const size_t e = e0 + (size_t)i * NT; if (e < (size_t)MP * DM / 8) { a[i] = __builtin_nontemporal_load((const f32x4*)(x + e * 8)); b[i] = __builtin_nontemporal_load((const f32x4*)(x + e * 8 + 4)); } }
          __builtin_amdgcn_sched_barrier(0);
#pragma unroll
          for (int i = 0; i < 8; ++i) { const size_t e = e0 + (size_t)i * NT; if (e < (size_t)MP * DM / 8) {
              v4u o; o.x = pk2(a[i][0], a[i][1]); o.y = pk2(a[i][2], a[i][3]); o.z = pk2(b[i][0], b[i][1]); o.w = pk2(b[i][2], b[i][3]); *(GAS v4u*)(xb + e * 8) = o; } } } }
    { const int gt = F.vcu * (NWAVES * 64) + F.tid; const float* x = IN_F(I_XS); bf16* xb = (bf16*)(ws + SM_XSB);
      if (gt < NS * DM / 8) { const f32x4 a = *(const GAS f32x4*)(x + gt * 8), b = *(const GAS f32x4*)(x + gt * 8 + 4);
          v4u o; o.x = pk2(a[0], a[1]); o.y = pk2(a[2], a[3]); o.z = pk2(b[0], b[1]); o.w = pk2(b[2], b[3]); *(GAS v4u*)(xb + gt * 8) = o; } }
    { const int gt = F.vcu * (NWAVES * 64) + F.tid; if (gt < 4 * 128 * 128) { const int t = (gt >> 7) & 127, s = gt & 127; const float v = IN_F(I_AWS)[gt];
          ((bf16*)(ws + WS_AWSB))[gt] = (bf16)f2bf((s > t) ? 0.f : v); } }
    { const int gt = F.vcu * (NWAVES * 64) + F.tid, NT = F.G * NWAVES * 64; float* rc = (float*)(ws + WS_ROPEC); float* rs = (float*)(ws + WS_ROPES);
      for (int e = gt; e < 2049 * 32; e += NT) { const int t = e >> 5, j = e & 31; const float pos = (t == 2048) ? 8192.f : (float)t; const float ang = pos * ROPE_INV[j];
          double rev = (double)ang * 0.15915494309189535; rev -= __builtin_floor(rev); const float fr = (float)rev;
          rc[e] = __builtin_amdgcn_cosf(fr); rs[e] = __builtin_amdgcn_sinf(fr); } }
}

__device__ __forceinline__ void p0_wout(Frame& F, const Args& A, int rank, int nrank) {
    launder(F); unsigned char* ws = F.ws; LAS float* scr = (LAS float*)(F.lds + RING_OFF + F.wave * 16384);
    constexpr int I_OUT = (DM / 64) * (DM / 32);
    for (int it = rank * NWAVES + F.wave; it < I_OUT; it += nrank * NWAVES) p0_item<0, false>(IN_L(I_WOUT), DM, DM, DM, (bf16*)(ws + WS_WOUT), scr, it, F.lane, nullptr, nullptr, nullptr, nullptr);
}
constexpr int LATE_ITEMS = (DM / 64) * (2 * FF / 32) + (FF / 64) * (DM / 32), LATE_UNITS = LATE_ITEMS / NWAVES;
static_assert(LATE_ITEMS % NWAVES == 0, "late weight units");
__device__ __forceinline__ void late_weight_unit(Frame& F, const Args& A, int unit) {
    launder(F); unsigned char* ws = F.ws; LAS float* scr = (LAS float*)(F.lds + RING_OFF + F.wave * 16384);
    constexpr int I_UP = (DM / 64) * (2 * FF / 32);
    const int r = unit * NWAVES + F.wave;
    if (r < I_UP) p0_item<1, true>(IN_L(I_W2UP), DM, 2 * FF, 2 * FF, (bf16*)(ws + WS_W2UP), scr, r, F.lane, IN_L(I_LN2G), IN_L(I_LN2B), (float*)(ws + PS_UP), (float*)(ws + PS_UP) + 16 * 2 * FF);
    else p0_item<0, false>(IN_L(I_W2DN), FF, DM, DM, (bf16*)(ws + WS_W2DN), scr, r - I_UP, F.lane, nullptr, nullptr, nullptr, nullptr);
    __syncthreads();
}
__device__ __forceinline__ void finalize_cvec(Frame& F, int sel) {
    unsigned char* ws = F.ws; const int gt = F.vcu * (NWAVES * 64) + F.tid + (sel ? 2 * INWP : 0);
    if (sel == 0 && gt >= 2 * INWP) return;
    if (gt < 2 * INWP) { const int which = gt / INWP, n = gt % INWP; const float* p = (const float*)(ws + PS_IN) + (size_t)which * 16 * INWP + n; float s = 0.f;
#pragma unroll
        for (int kb = 0; kb < 16; ++kb) s += p[(size_t)kb * INWP];
        ((float*)(ws + (which ? CV_C2IN : CV_C1IN)))[n] = s; }
    else if (gt < 2 * INWP + 4 * FF) { const int g2 = gt - 2 * INWP, which = g2 / (2 * FF), n = g2 % (2 * FF); const float* p = (const float*)(ws + PS_UP) + (size_t)which * 16 * 2 * FF + n; float s = 0.f;
#pragma unroll
        for (int kb = 0; kb < 16; ++kb) s += p[(size_t)kb * 2 * FF];
        ((float*)(ws + (which ? CV_C2UP : CV_C1UP)))[n] = s; }
}

constexpr int TH_RED = 0, TH_STAT = 131072;
__device__ __forceinline__ void thin_rowstats(const float* stat, int row, int fq, float& mean, float& rstd) {
    float s = 0.f, q = 0.f; const f32x4* p = (const f32x4*)((const f32x2*)stat + row * 64 + fq * 16);
    f32x4 v8[8];
#pragma unroll
    for (int i = 0; i < 8; ++i) v8[i] = p[i];
    __builtin_amdgcn_sched_barrier(0);
#pragma unroll
    for (int i = 0; i < 8; ++i) { s += v8[i][0] + v8[i][2]; q += v8[i][1] + v8[i][3]; }
    s += __shfl_xor(s, 16); s += __shfl_xor(s, 32); q += __shfl_xor(q, 16); q += __shfl_xor(q, 32);
    mean = s * (1.f / 1024.f); const float var = fmaxf(q * (1.f / 1024.f) - mean * mean, 0.f); rstd = 1.0f / sqrtf(var + LN_EPS);
}
__device__ __forceinline__ void thin_putstat(float* stat, int row, int unit, int fq, const f32x4 z) {
    float s = (z[0] + z[1]) + (z[2] + z[3]), q = (z[0] * z[0] + z[1] * z[1]) + (z[2] * z[2] + z[3] * z[3]);
    s += __shfl_xor(s, 16); s += __shfl_xor(s, 32); q += __shfl_xor(q, 16); q += __shfl_xor(q, 32);
    if (fq == 0) ((f32x2*)stat)[row * 64 + unit] = (f32x2){s, q};
}
template <int K, int NBR> __device__ __forceinline__ void thin_gemm(Frame& F, f32x4 (&out)[NBR], const bf16* Asrc, const bf16* const (&brow)[NBR]) {
    const int lane = F.lane, fr = lane & 15, fq = lane >> 4, w = F.wave;
    constexpr int KS = K / 8; static_assert(KS % 32 == 0, "K slice");
    f32x4 acc[8][NBR];
#pragma unroll
    for (int rt = 0; rt < 8; ++rt)
#pragma unroll
        for (int nb = 0; nb < NBR; ++nb) acc[rt][nb] = (f32x4){0.f, 0.f, 0.f, 0.f};
    constexpr int NSTEP = KS / 32, BATCH = (K == DM) ? 2 : 4;
#pragma unroll 1
    for (int s0 = 0; s0 < NSTEP; s0 += BATCH) {
        bf16x8 bf[BATCH][NBR], af[BATCH][8];
#pragma unroll
        for (int bi = 0; bi < BATCH; ++bi) if (s0 + bi < NSTEP) { const int k0 = w * KS + 32 * (s0 + bi) + 8 * fq;
#pragma unroll
            for (int nb = 0; nb < NBR; ++nb) bf[bi][nb] = *(const bf16x8*)(brow[nb] + k0);
#pragma unroll
            for (int rt = 0; rt < 8; ++rt) af[bi][rt] = *(const bf16x8*)(Asrc + (size_t)(16 * rt + fr) * K + k0); }
        __builtin_amdgcn_sched_barrier(0);
#pragma unroll
        for (int bi = 0; bi < BATCH; ++bi) if (s0 + bi < NSTEP) {
#pragma unroll
            for (int rt = 0; rt < 8; ++rt)
#pragma unroll
                for (int nb = 0; nb < NBR; ++nb) acc[rt][nb] = mfma16(bf[bi][nb], af[bi][rt], acc[rt][nb]); }
        __builtin_amdgcn_sched_barrier(0);
    }
    LAS f32x4* red = (LAS f32x4*)(F.lds + RING_OFF + TH_RED);
#pragma unroll
    for (int rt = 0; rt < 8; ++rt)
#pragma unroll
        for (int nb = 0; nb < NBR; ++nb) red[((nb * 8 + w) * 128 + 16 * rt + fr) * 4 + fq] = acc[rt][nb];
    __syncthreads();
#pragma unroll
    for (int nb = 0; nb < NBR; ++nb) { f32x4 s = red[((nb * 8 + 0) * 128 + 16 * w + fr) * 4 + fq];
#pragma unroll
        for (int ws = 1; ws < 8; ++ws) s = s + red[((nb * 8 + ws) * 128 + 16 * w + fr) * 4 + fq];
        out[nb] = s; }
    __syncthreads();
}
template <int STAGE> __device__ __forceinline__ void thin_stage(Frame& F, const Args& A, int unit0, int ustride) {
    launder(F); unsigned char* ws = F.ws; const int lane = F.lane, fr = lane & 15, fq = lane >> 4, w = F.wave; const int row = 16 * w + fr;
    constexpr int NU = (STAGE == 1 || STAGE == 7) ? FF / 16 : (STAGE == 3) ? (INW + 15) / 16 : DM / 16;
    bf16* HSB = (bf16*)(ws + SM_HS); float* Z1 = (float*)(ws + SM_Z1); float* ST1 = (float*)(ws + SM_ST1); float* Z2 = (float*)(ws + SM_Z2); float* ST2 = (float*)(ws + SM_ST2); float* Z3 = (float*)(ws + SM_Z3);
    if (unit0 < 0 || unit0 >= NU) return;
    float mean = 0.f, rstd = 1.f, mean1 = 0.f, rstd1 = 1.f;
    if (STAGE == 3 || STAGE == 6) thin_rowstats(ST1, row, fq, mean1, rstd1);
    if (STAGE == 7 || STAGE == 8) thin_rowstats(ST2, row, fq, mean, rstd);
    for (int unit = unit0; unit < NU; unit += ustride) {
        const int c0 = 16 * unit + 4 * fq;
        if (STAGE == 1 || STAGE == 7) {
            const bf16* Bt = (const bf16*)(ws + (STAGE == 1 ? WS_W1UP : WS_W2UP));
            const int rg = 256 * (unit >> 3) + 16 * (unit & 7) + fr;
            const bf16* const brow[2] = {Bt + (size_t)rg * DM, Bt + (size_t)(rg + 128) * DM};
            f32x4 acc[2]; f32x4 c1g = (f32x4){0.f, 0.f, 0.f, 0.f}, c1u = c1g, c2g = c1g, c2u = c1g;
            if (STAGE == 7) { const float* c1 = (const float*)(ws + CV_C1UP) + 256 * (unit >> 3) + 16 * (unit & 7) + 4 * fq; const float* c2 = (const float*)(ws + CV_C2UP) + 256 * (unit >> 3) + 16 * (unit & 7) + 4 * fq;
                c1g = *(const f32x4*)c1; c1u = *(const f32x4*)(c1 + 128); c2g = *(const f32x4*)c2; c2u = *(const f32x4*)(c2 + 128); }
            thin_gemm<DM, 2>(F, acc, (const bf16*)(ws + (STAGE == 1 ? SM_XSB : SM_Z2B)), brow);
            if (STAGE == 7) { const float rm = -rstd * mean;
                acc[0] = acc[0] * rstd + (c1g * rm + c2g); acc[1] = acc[1] * rstd + (c1u * rm + c2u); }
            f32x4 h;
#pragma unroll
            for (int i = 0; i < 4; ++i) h[i] = pg8::silu_f(acc[0][i]) * acc[1][i];
            u32x2 o; o.x = pk2(h[0], h[1]); o.y = pk2(h[2], h[3]); *(u32x2*)(HSB + (size_t)row * FF + c0) = o;
        } else if (STAGE == 2 || STAGE == 8) {
            const bf16* Bt = (const bf16*)(ws + (STAGE == 2 ? WS_W1DN : WS_W2DN));
            const bf16* const brow[1] = {Bt + (size_t)(16 * unit + fr) * FF};
            f32x4 acc[1];
            thin_gemm<FF, 1>(F, acc, HSB, brow);
            f32x4 res = *(const f32x4*)((STAGE == 2 ? IN_L(I_XS) : (const float*)Z2) + (size_t)row * DM + c0);
            if (STAGE == 8) res = (res - mean) * rstd * *(const f32x4*)(IN_L(I_LN2G) + c0) + *(const f32x4*)(IN_L(I_LN2B) + c0);
            const f32x4 z = res * kAlpha + acc[0] * 0.5f;
            *(f32x4*)((STAGE == 2 ? Z1 : Z3) + (size_t)row * DM + c0) = z;
            if (STAGE == 2) { thin_putstat(ST1, row, unit, fq, z); u32x2 o; o.x = pk2(z[0], z[1]); o.y = pk2(z[2], z[3]); *(u32x2*)((bf16*)(ws + SM_Z1B) + (size_t)row * DM + c0) = o; }
        } else if (STAGE == 6) {
            const bf16* Bt = (const bf16*)(ws + WS_WOUT);
            const bf16* const brow[1] = {Bt + (size_t)(16 * unit + fr) * DM};
            f32x4 acc[1];
            const f32x4 z1 = *(const f32x4*)(Z1 + (size_t)row * DM + c0);
            thin_gemm<DM, 1>(F, acc, (const bf16*)(ws + SM_MIXSB), brow);
            const f32x4 x1 = (z1 - mean1) * rstd1 * *(const f32x4*)(IN_L(I_LN1G) + c0) + *(const f32x4*)(IN_L(I_LN1B) + c0);
            const f32x4 z = x1 * kAlpha + acc[0];
            *(f32x4*)(Z2 + (size_t)row * DM + c0) = z;
            thin_putstat(ST2, row, unit, fq, z); { u32x2 o; o.x = pk2(z[0], z[1]); o.y = pk2(z[2], z[3]); *(u32x2*)((bf16*)(ws + SM_Z2B) + (size_t)row * DM + c0) = o; }
        } else {
            const bf16* Bt = (const bf16*)(ws + WS_WIN);
            const bf16* const brow[1] = {Bt + (size_t)(16 * unit + fr) * DM};
            f32x4 acc[1];
            const f32x4 c1v = *(const f32x4*)((const float*)(ws + CV_C1IN) + c0), c2v = *(const f32x4*)((const float*)(ws + CV_C2IN) + c0);
            thin_gemm<DM, 1>(F, acc, (const bf16*)(ws + SM_Z1B), brow);
            const f32x4 v = acc[0] * rstd1 + (c1v * (-rstd1 * mean1) + c2v);
            const bool roped = (c0 >= 1024 && c0 < 1664) || (c0 >= 1792 && c0 < 2112);
            f32x4 pr;
#pragma unroll
            for (int i = 0; i < 4; ++i) pr[i] = __shfl_xor(v[i], 16);
            if (c0 < 512) { f32x4 o;
#pragma unroll
                for (int i = 0; i < 4; ++i) o[i] = pg8::gelu_f(v[i]);
                *(f32x4*)((float*)(ws + SM_US) + (size_t)row * 512 + c0) = o;
            } else if (c0 < 1024) { f32x4 o;
#pragma unroll
                for (int i = 0; i < 4; ++i) o[i] = pg8::gelu_f(v[i]);
                *(f32x4*)((float*)(ws + SM_GVS) + (size_t)row * 512 + (c0 - 512)) = o;
            } else if (roped) {
                const int base = c0 & ~63, p = c0 & 63, g = p >> 3, n = (p >> 2) & 1;
                const f32x4 c = *(const f32x4*)((const float*)(ws + WS_ROPEC) + 2048 * 32 + 4 * g), s = *(const f32x4*)((const float*)(ws + WS_ROPES) + 2048 * 32 + 4 * g);
                const f32x4 o = n ? (v * c + pr * s) : (v * c - pr * s);
                const int oc = base + 32 * n + 4 * g;
                float* dst;
                if (oc < 1536) dst = (float*)(ws + SM_QS) + (size_t)row * 512 + (oc - 1024);
                else if (oc < 1664) dst = F.out + OUT_KS + (size_t)row * 128 + (oc - 1536);
                else if (oc < 2048) dst = (float*)(ws + SM_QIS) + (size_t)row * 256 + (oc - 1792);
                else dst = F.out + OUT_KIS + (size_t)row * 64 + (oc - 2048);
                *(f32x4*)dst = o;
            } else if (c0 < 1792) { *(f32x4*)(F.out + OUT_VS + (size_t)row * 128 + (c0 - 1664)) = v;
            } else if (c0 == 2112) { *(f32x4*)((float*)(ws + SM_WIS) + (size_t)row * 4) = v * 0.0625f; }
        }
    }
}
__device__ __forceinline__ void thin_final_ln(Frame& F, const Args& A) {
    const int gw = (F.G - 1 - F.vcu) * NWAVES + F.wave; if (gw >= NS) return;
    const float* z = (const float*)(F.ws + SM_Z3) + (size_t)gw * DM; const GAS f32x4* zr = (const GAS f32x4*)z + F.lane;
    f32x4 v[4]; float s = 0.f;
#pragma unroll
    for (int j = 0; j < 4; ++j) { v[j] = zr[64 * j]; s += (v[j].x + v[j].y) + (v[j].z + v[j].w); }
    const float mean = wave_sum(s) * (1.f / DM); float s2 = 0.f;
#pragma unroll
    for (int j = 0; j < 4; ++j) { v[j] = v[j] - mean; s2 += (v[j].x * v[j].x + v[j].y * v[j].y) + (v[j].z * v[j].z + v[j].w * v[j].w); }
    const float rstd = 1.f / sqrtf(wave_sum(s2) * (1.f / DM) + LN_EPS);
    const f32x4* g = (const f32x4*)IN_L(I_LN3G) + F.lane; const f32x4* b = (const f32x4*)IN_L(I_LN3B) + F.lane; f32x4* o = (f32x4*)(F.out + OUT_YS + (size_t)gw * DM) + F.lane;
#pragma unroll
    for (int j = 0; j < 4; ++j) o[64 * j] = v[j] * rstd * g[64 * j] + b[64 * j];
}

__device__ __forceinline__ void final_ln_rows(Frame& F, const Args& A) {
    launder(F); unsigned char* ws = F.ws; const int lane = F.lane;
    const int gw = F.vcu * NWAVES + F.wave, NGW = F.G * NWAVES;
    const float* g3 = IN_L(I_LN3G); const float* b3 = IN_L(I_LN3B);
    f32x4 gv[4], bv[4];
#pragma unroll
    for (int j = 0; j < 4; ++j) { gv[j] = *(const f32x4*)(g3 + 256 * j + 4 * lane); bv[j] = *(const f32x4*)(b3 + 256 * j + 4 * lane); }
    const bf16* Z = (const bf16*)(ws + WS_Z3); const float* ST = (const float*)(ws + WS_STZ3);
#pragma unroll 1
    for (int row0 = gw; row0 < MP; row0 += 4 * NGW) {
        u32x2 raw[4][4]; f32x4 sa[4], sb[4];
#pragma unroll
        for (int r = 0; r < 4; ++r) { const size_t row = (size_t)row0 + (size_t)r * NGW; if (row < (size_t)MP) { sa[r] = *(const f32x4*)(ST + row * 8); sb[r] = *(const f32x4*)(ST + row * 8 + 4);
#pragma unroll
            for (int j = 0; j < 4; ++j) raw[r][j] = __builtin_nontemporal_load((const u32x2*)(Z + row * DM + 256 * j + 4 * lane)); } }
        __builtin_amdgcn_sched_barrier(0);
#pragma unroll
        for (int r = 0; r < 4; ++r) { const size_t row = (size_t)row0 + (size_t)r * NGW; if (row < (size_t)MP) { float mu, rs; pg8::stats_from(sa[r], sb[r], mu, rs);
            float* o = F.out + OUT_Y + row * DM + 4 * lane;
#pragma unroll
            for (int j = 0; j < 4; ++j) __builtin_nontemporal_store((pg8::unpack4(raw[r][j]) - mu) * rs * gv[j] + bv[j], (f32x4*)(o + 256 * j)); } }
    }
}
constexpr int GM_LD = 136;
__device__ __forceinline__ void gmlp_unit(Frame& F, const Args& A, int b, int c, int g) {
    launder(F); unsigned char* ws = F.ws; const int tid = F.tid, lane = F.lane, fr = lane & 15, fq = lane >> 4, w = F.wave;
    LAS bf16* wsA = (LAS bf16*)(F.lds + RING_OFF); LAS bf16* vnT = wsA + 128 * GM_LD;
    const int m0 = b * SEQ + 128 * c;
    const int s_ = tid >> 2, dq_ = tid & 3; const size_t row_ = (size_t)(m0 + s_);
    const f32x4* st = (const f32x4*)((const float*)(ws + WS_GVST) + row_ * 16);
    const bf16* gv = (const bf16*)(ws + WS_GV) + row_ * 512 + 128 * g + 32 * dq_;
    f32x4 stv[4]; v4u raw4[4];
    {
        const int t = tid >> 2, sb = 32 * (tid & 3); const bf16* src = (const bf16*)(ws + WS_AWSB) + ((size_t)(g * 128 + t) * 128 + sb);
        v4u wv4[4];
#pragma unroll
        for (int i = 0; i < 4; ++i) wv4[i] = *(const v4u*)(src + 8 * i);
#pragma unroll
        for (int i = 0; i < 4; ++i) { stv[i] = st[i]; raw4[i] = *(const v4u*)(gv + 8 * i); }
        __builtin_amdgcn_sched_barrier(0);
#pragma unroll
        for (int i = 0; i < 4; ++i) *(LAS v4u*)(wsA + t * GM_LD + sb + 8 * i) = wv4[i];
    }
    {
        const int s = s_, dq = dq_;
        const f32x4 p0 = stv[0], p1 = stv[1], p2 = stv[2], p3 = stv[3];
        const float mean = ((p0[0] + p0[2]) + (p1[0] + p1[2]) + (p2[0] + p2[2]) + (p3[0] + p3[2])) * 0.125f;
        float m2 = (p0[1] + p0[3]) + (p1[1] + p1[3]) + (p2[1] + p2[3]) + (p3[1] + p3[3]);
        { const float d0 = p0[0] - mean, d1 = p0[2] - mean, d2 = p1[0] - mean, d3 = p1[2] - mean, d4 = p2[0] - mean, d5 = p2[2] - mean, d6 = p3[0] - mean, d7 = p3[2] - mean;
          m2 += 64.f * ((d0 * d0 + d1 * d1) + (d2 * d2 + d3 * d3) + (d4 * d4 + d5 * d5) + (d6 * d6 + d7 * d7)); }
        const float rstd = 1.0f / sqrtf(m2 * (1.f / 512.f) + LN_EPS);
        const float* lg = IN_L(I_ALNG) + 128 * g + 32 * dq; const float* lb = IN_L(I_ALNB) + 128 * g + 32 * dq;
#pragma unroll
        for (int i = 0; i < 4; ++i) { const v4u raw = raw4[i];
            const f32x4 x0 = pg8::unpack4((u32x2){raw.x, raw.y}), x1 = pg8::unpack4((u32x2){raw.z, raw.w});
            const f32x4 g0 = *(const f32x4*)(lg + 8 * i), g1 = *(const f32x4*)(lg + 8 * i + 4), b0 = *(const f32x4*)(lb + 8 * i), b1 = *(const f32x4*)(lb + 8 * i + 4);
            const f32x4 y0 = (x0 - mean) * rstd * g0 + b0, y1 = (x1 - mean) * rstd * g1 + b1;
            const int d = 32 * dq + 8 * i;
#pragma unroll
            for (int e = 0; e < 4; ++e) { vnT[(d + e) * GM_LD + s] = (bf16)f2bf(y0[e]); vnT[(d + 4 + e) * GM_LD + s] = (bf16)f2bf(y1[e]); } }
    }
    __syncthreads();
    {
        f32x4 acc[8];
#pragma unroll
        for (int dt = 0; dt < 8; ++dt) acc[dt] = (f32x4){0.f, 0.f, 0.f, 0.f};
        const int t = 16 * w + fr; const size_t row = (size_t)(m0 + t); const float bias = IN_L(I_ABS)[g * 128 + t];
        const bf16* up = (const bf16*)(ws + WS_U) + row * 512 + 128 * g + 4 * fq; bf16* op = (bf16*)(ws + WS_MIX) + row * 1024 + 128 * g + 4 * fq;
        u32x2 u8[8];
#pragma unroll
        for (int dt = 0; dt < 8; ++dt) u8[dt] = *(const u32x2*)(up + 16 * dt);
        __builtin_amdgcn_sched_barrier(0);
        const int nsteps = (w + 2) >> 1;
        for (int st = 0; st < nsteps; ++st) { const int s0 = 32 * st + 8 * fq;
            const bf16x8 bfr = *(const LAS bf16x8*)(wsA + (16 * w + fr) * GM_LD + s0);
#pragma unroll
            for (int dt = 0; dt < 8; ++dt) { const bf16x8 afr = *(const LAS bf16x8*)(vnT + (16 * dt + fr) * GM_LD + s0); acc[dt] = mfma16(afr, bfr, acc[dt]); } }
        __builtin_amdgcn_sched_barrier(0);
#pragma unroll
        for (int dt = 0; dt < 8; ++dt) { const f32x4 uu = pg8::unpack4(u8[dt]); const f32x4 o = uu * (acc[dt] + bias);
            u32x2 wv; wv.x = pk2(o[0], o[1]); wv.y = pk2(o[2], o[3]); *(u32x2*)(op + 16 * dt) = wv; }
    }
    __syncthreads();
}

__device__ __forceinline__ unsigned ord_f32(float x) { unsigned u = __float_as_uint(x); if (u == 0x80000000u) u = 0u; return (u & 0x80000000u) ? ~u : (u | 0x80000000u); }
__device__ __forceinline__ unsigned ord_f32_nz(float x) { const unsigned u = __float_as_uint(x); return u ^ ((unsigned)((int)u >> 31) | 0x80000000u); }
constexpr int SC_LD = 2052;
constexpr int TA_SC = 0, TA_MASK = 16 * SC_LD * 4, TA_END = TA_MASK + 64 * 64 * 4;
static_assert(TA_END <= RING_BYTES, "topk/attention LDS");
__device__ __forceinline__ void cnt_ge(unsigned& c, unsigned x, unsigned T) {
    asm volatile("v_cmp_le_u32_e32 vcc, %2, %1\n\ts_nop 1\n\tv_addc_co_u32_e32 %0, vcc, 0, %0, vcc" : "+v"(c) : "v"(x), "s"(T) : "vcc");
}
__device__ __forceinline__ unsigned wave_sum_u32(unsigned v) {
    v += (unsigned)__builtin_amdgcn_update_dpp(0, (int)v, 0xB1, 0xF, 0xF, true);
    v += (unsigned)__builtin_amdgcn_update_dpp(0, (int)v, 0x4E, 0xF, 0xF, true);
    v += (unsigned)__builtin_amdgcn_update_dpp(0, (int)v, 0x141, 0xF, 0xF, true);
    v += (unsigned)__builtin_amdgcn_update_dpp(0, (int)v, 0x140, 0xF, 0xF, true);
    return (unsigned)__builtin_amdgcn_readlane((int)v, 0) + (unsigned)__builtin_amdgcn_readlane((int)v, 16) + (unsigned)__builtin_amdgcn_readlane((int)v, 32) + (unsigned)__builtin_amdgcn_readlane((int)v, 48);
}
__device__ __forceinline__ void transpose32(unsigned (&a)[32]) {
#define T32_STAGE(J, M) _Pragma("unroll") for (int k = 0; k < 32; ++k) if (!(k & (J))) { const unsigned lo = a[k], hi = a[k + (J)]; a[k] = (lo & (M)) | ((hi << (J)) & ~(M)); a[k + (J)] = ((lo >> (J)) & (M)) | (hi & ~(M)); }
    T32_STAGE(16, 0x0000FFFFu) T32_STAGE(8, 0x00FF00FFu) T32_STAGE(4, 0x0F0F0F0Fu) T32_STAGE(2, 0x33333333u) T32_STAGE(1, 0x55555555u)
#undef T32_STAGE
}
template <int J> __device__ __forceinline__ void ties_by_index(unsigned cand, int need, int base, unsigned& sel) {
    if constexpr (J < 32) { const bool tb = ((cand >> J) & 1u) != 0u; const unsigned long long tie = __ballot(tb);
        const int rank = base + (int)__builtin_amdgcn_mbcnt_hi((unsigned)(tie >> 32), __builtin_amdgcn_mbcnt_lo((unsigned)tie, 0u));
        sel |= ((unsigned)tb & (unsigned)(rank < need)) << J;
        ties_by_index<J + 1>(cand, need, base + __builtin_popcountll(tie), sel); }
}
__device__ __forceinline__ void select_rows(const LAS float* sc, LAS unsigned* mask16, int qbase, int w, int lane) {
    const int ra = 2 * w, rb = 2 * w + 1, qa = qbase + ra, qb = qbase + rb;
    unsigned PA[32], PB[32];
#pragma unroll
    for (int i = 0; i < 32; ++i) { const int k = 64 * i + lane; PA[i] = __float_as_uint(sc[ra * SC_LD + k]); PB[i] = __float_as_uint(sc[rb * SC_LD + k]); }
    __builtin_amdgcn_sched_barrier(0);
#pragma unroll
    for (int i = 0; i < 32; ++i) { const int k = 64 * i + lane; PA[i] = (k <= qa) ? ord_f32_nz(__uint_as_float(PA[i])) : 0u; PB[i] = (k <= qb) ? ord_f32_nz(__uint_as_float(PB[i])) : 0u; }
    transpose32(PA); transpose32(PB);
    unsigned candA = ~0u, candB = ~0u, selA = 0u, selB = 0u; int abA = 0, abB = 0;
#pragma unroll
    for (int b = 31; b >= 0; --b) {
        const unsigned tA = candA & PA[b], tB = candB & PB[b];
        const unsigned tot = wave_sum_u32((unsigned)__builtin_popcount(tA) | ((unsigned)__builtin_popcount(tB) << 16));
        { const int nA = abA + (int)(tot & 0xffffu); const bool take = nA >= 256, ex = nA == 256;
          selA |= (take && !ex) ? 0u : tA; candA = take ? (ex ? 0u : tA) : (candA & ~PA[b]); abA = take ? (ex ? 256 : abA) : nA; }
        { const int nB = abB + (int)(tot >> 16); const bool take = nB >= 256, ex = nB == 256;
          selB |= (take && !ex) ? 0u : tB; candB = take ? (ex ? 0u : tB) : (candB & ~PB[b]); abB = take ? (ex ? 256 : abB) : nB; }
        if (abA == 256 && abB == 256) break;
    }
    {
        const unsigned tot = wave_sum_u32((unsigned)__builtin_popcount(candA) | ((unsigned)__builtin_popcount(candB) << 16));
        const int needA = 256 - abA, needB = 256 - abB;
        if ((int)(tot & 0xffffu) == needA) selA |= candA; else ties_by_index<0>(candA, needA, 0, selA);
        if ((int)(tot >> 16) == needB) selB |= candB; else ties_by_index<0>(candB, needB, 0, selB);
    }
    mask16[ra * 64 + lane] = selA; mask16[rb * 64 + lane] = selB;
}
__device__ __forceinline__ void topk_load_k(Frame& F, int b, int ntile_max, bf16x8 (&k0)[8], bf16x8 (&k1)[8]) {
    launder(F); const int lane = F.lane, fr = lane & 15, fq = lane >> 4, w = F.wave;
    const bf16* kib = (const bf16*)(F.ws + WS_KI) + ((size_t)b * SEQ + fr) * 64 + 8 * fq;
#pragma unroll
    for (int i = 0; i < 8; ++i) { const int kt = w + NWAVES * i; k0[i] = bf16x8{}; k1[i] = bf16x8{}; if (kt < ntile_max) { const bf16* kp = kib + (size_t)kt * 16 * 64; k0[i] = *(const bf16x8*)kp; k1[i] = *(const bf16x8*)(kp + 32); } }
    __builtin_amdgcn_sched_barrier(0);
}
__device__ __forceinline__ void topk16(Frame& F, int b, int q0, LAS unsigned* mask16, const bf16x8 (&kh0)[8], const bf16x8 (&kh1)[8]) {
    launder(F); unsigned char* ws = F.ws; const int lane = F.lane, fr = lane & 15, fq = lane >> 4, w = F.wave;
    const size_t rowq = (size_t)b * SEQ + q0;
    if (q0 < 256) {
#pragma unroll
        for (int rr = 0; rr < 2; ++rr) { const int r = 2 * w + rr, q = q0 + r; const int d = q - lane;
            mask16[r * 64 + lane] = (d < 0) ? 0u : ((2u << (d >> 6)) - 1u); }
        return;
    }
    LAS float* sc = (LAS float*)(F.lds + RING_OFF + TA_SC);
    {
        const bf16* qip = (const bf16*)(ws + WS_QI) + (rowq + fr) * 256 + 8 * fq;
        bf16x8 qf[4][2];
#pragma unroll
        for (int h = 0; h < 4; ++h) { qf[h][0] = *(const bf16x8*)(qip + 64 * h); qf[h][1] = *(const bf16x8*)(qip + 64 * h + 32); }
        const f32x4 wq = *(const f32x4*)((const float*)(ws + WS_WI) + (rowq + fr) * 4);
        const int ntile = (q0 >> 4) + 1;
        const bf16* kib = (const bf16*)(ws + WS_KI) + ((size_t)b * SEQ + fr) * 64 + 8 * fq;
        bf16x8 k0[8], k1[8];
#pragma unroll
        for (int i = 0; i < 8; ++i) { const int kt = w + 64 + NWAVES * i; if (kt < ntile) { const bf16* kp = kib + (size_t)kt * 16 * 64; k0[i] = *(const bf16x8*)kp; k1[i] = *(const bf16x8*)(kp + 32); } }
        __builtin_amdgcn_sched_barrier(0);
#define TOPK_TILE(KA, KB, kt) { f32x4 s = (f32x4){0.f, 0.f, 0.f, 0.f}; \
            _Pragma("unroll") for (int h = 0; h < 4; ++h) { f32x4 d = mfma16(KA, qf[h][0], (f32x4){0.f, 0.f, 0.f, 0.f}); d = mfma16(KB, qf[h][1], d); \
                _Pragma("unroll") for (int e = 0; e < 4; ++e) s[e] = __builtin_fmaf(wq[h], fmaxf(d[e], 0.f), s[e]); } \
            *(LAS f32x4*)(sc + fr * SC_LD + 16 * (kt) + 4 * fq) = s; }
#pragma unroll
        for (int i = 0; i < 8; ++i) { const int kt = w + NWAVES * i; if (kt < ntile) TOPK_TILE(kh0[i], kh1[i], kt) }
        __builtin_amdgcn_sched_barrier(0);
#pragma unroll
        for (int i = 0; i < 8; ++i) { const int kt = w + 64 + NWAVES * i; if (kt < ntile) TOPK_TILE(k0[i], k1[i], kt) }
#undef TOPK_TILE
    }
    __syncthreads();
    select_rows(sc, mask16, q0, w, lane);
    __syncthreads();
}

typedef float f32x8 __attribute__((ext_vector_type(8)));
constexpr int AT_SLOTB = 8192, AT_LK = 0, AT_LV = 3 * AT_SLOTB, AT_MT = 6 * AT_SLOTB, AT_QS = AT_MT + 32 * 128 * 4, AT_END = AT_QS + 8 * 4096;
static_assert(AT_END <= TA_MASK, "attention rings + tile-major mask overlay the score image");
__device__ __forceinline__ void at_glds16(const void* g, unsigned lds_dst) { unsigned keep;
    asm volatile("s_mov_b32 %0, m0\n\ts_mov_b32 m0, %2\n\ts_nop 0\n\tglobal_load_lds_dwordx4 %1, off\n\ts_mov_b32 m0, %0" : "=&s"(keep) : "v"(g), "s"(lds_dst) : "memory"); }
typedef short at_v4i16 __attribute__((ext_vector_type(4)));
__device__ __forceinline__ u32x2 at_vtr(const LAS char* p) { return __builtin_bit_cast(u32x2, __builtin_amdgcn_ds_read_tr16_b64_v4i16((LAS at_v4i16*)p)); }
__device__ __forceinline__ void at_kload2(bf16x8* kf, const LAS char* kp, int j) { kf[2 * j] = *(const LAS bf16x8*)(kp + j * 2048); kf[2 * j + 1] = *(const LAS bf16x8*)(kp + j * 2048 + 512); }
#define AT_MX3(a, b, c) __builtin_fmaxf(__builtin_fmaxf((a), (b)), (c))
__device__ __forceinline__ float at_rowmax(const f32x16& p0, const f32x16& p1) {
    float a = AT_MX3(p0[0], p0[1], p1[0]), b = AT_MX3(p0[2], p0[3], p1[1]); a = AT_MX3(a, p1[2], p1[3]);
#pragma unroll
    for (int r = 4; r < 16; r += 4) { a = AT_MX3(a, p0[r], p0[r + 1]); b = AT_MX3(b, p0[r + 2], p0[r + 3]); a = AT_MX3(a, p1[r], p1[r + 1]); b = AT_MX3(b, p1[r + 2], p1[r + 3]); }
    const float m = __builtin_fmaxf(a, b); auto rr = __builtin_amdgcn_permlane32_swap(__float_as_uint(m), __float_as_uint(m), false, false);
    return __builtin_fmaxf(__uint_as_float(rr[0]), __uint_as_float(rr[1])); }
__device__ __forceinline__ void mask_to_tiles(Frame& F, const LAS unsigned* mask64) {
    const int tid = F.tid;
    if (tid < 128) { const int row = tid >> 1, hf = tid & 1;
        const LAS v4u* mp = (const LAS v4u*)(mask64 + row * 64 + 4 * hf);
        unsigned a[32];
#pragma unroll
        for (int kh = 0; kh < 2; ++kh)
#pragma unroll
            for (int i4 = 0; i4 < 4; ++i4) { const v4u v = mp[8 * kh + 2 * i4]; a[8 * kh + 2 * i4] = v.x; a[8 * kh + 2 * i4 + 16] = v.y; a[8 * kh + 2 * i4 + 1] = v.z; a[8 * kh + 2 * i4 + 17] = v.w; }
        transpose32(a);
        LAS unsigned* mt = (LAS unsigned*)(F.lds + RING_OFF + AT_MT) + tid;
#pragma unroll
        for (int t = 0; t < 32; ++t) mt[t * 128] = a[t]; }
}
#define AT_SBAR() __builtin_amdgcn_sched_barrier(0)
#define AT_PIN(x) asm volatile("" : "+v"(x))
#define AT_WAIT_BAR(N) asm volatile("s_waitcnt vmcnt(" #N ") lgkmcnt(0)\n\ts_barrier" ::: "memory")
#define AT_MEXP(v, pos, W) __uint_as_float(__float_as_uint(__builtin_amdgcn_exp2f(v)) & (unsigned)__builtin_amdgcn_sbfe((int)(W), (pos), 1))
#define AT_PMASK(j, W) ({ unsigned m_; if ((j) == 15) asm("v_pk_ashrrev_i16 %0, 15, %1 op_sel_hi:[0,1]" : "=v"(m_) : "v"(W)); \
    else asm("v_pk_lshlrev_b16 %0, %2, %1 op_sel_hi:[0,1]\n\tv_pk_ashrrev_i16 %0, 15, %0 op_sel_hi:[0,1]" : "=v"(m_) : "v"(W), "n"(15 - (j))); m_; })
#ifdef PROBE_DUPMASK
#define AT_MEXPC(v, pos, W) ({ unsigned m_, m2_; asm("v_bfe_i32 %0, %1, %2, 1" : "=v"(m_) : "v"(W), "n"(pos)); unsigned r_ = __float_as_uint(__builtin_amdgcn_exp2f(v)) & m_; asm volatile("v_bfe_i32 %0, %2, %3, 1\n\tv_and_b32 %1, %1, %0" : "=&v"(m2_), "+v"(r_) : "v"(W), "n"(pos)); __uint_as_float(r_); })
#else
#define AT_MEXPC(v, pos, W) ({ unsigned m_; asm("v_bfe_i32 %0, %1, %2, 1" : "=v"(m_) : "v"(W), "n"(pos)); __uint_as_float(__float_as_uint(__builtin_amdgcn_exp2f(v)) & m_); })
#endif
__device__ __forceinline__ void attn_unit(Frame& F, int b, int qt, int g) {
    launder(F); unsigned char* ws = F.ws; const int lane = F.lane, r32 = lane & 31, hi = lane >> 5; const int wid = __builtin_amdgcn_readfirstlane(F.wave);
    const int hh = wid & 3, qs = wid >> 2, head = 4 * g + hh, q0 = 64 * qt + 32 * qs; const size_t qrow = (size_t)b * SEQ + q0 + r32;
    const int NT = qt + 1;
    const LAS char* shm = (const LAS char*)(F.lds + RING_OFF); const unsigned lds0 = (unsigned)(size_t)shm;
    const bf16* ksrc = (const bf16*)(ws + WS_K) + ((size_t)b * SEQ + lane) * 128 + 64 * g + 8 * wid;
    const bf16* vsrc = (const bf16*)(ws + WS_VT) + ((size_t)b * SEQ + 16 * (wid & 3) + (lane >> 2)) * 128 + 64 * g + (wid >> 2) * 32 + (lane & 3) * 8;
    const unsigned kdst = lds0 + AT_LK + wid * 1024, vdst = lds0 + AT_LV + wid * 1024;
#define DMA_K(t, slot) at_glds16(ksrc + (size_t)min((int)(t), NT - 1) * (64 * 128), (unsigned)__builtin_amdgcn_readfirstlane((int)(kdst + (slot))))
#define DMA_V(t, slot) at_glds16(vsrc + (size_t)min((int)(t), NT - 1) * (64 * 128), (unsigned)__builtin_amdgcn_readfirstlane((int)(vdst + (slot))))
    const LAS char* kp0 = shm + AT_LK + hi * 1024 + r32 * 16;
    const LAS char* vp0 = shm + AT_LV + ((lane >> 4) & 1) * 32 + (lane & 3) * 8 + (4 * hi + ((lane & 15) >> 2)) * 64;
    const LAS unsigned* mT = (const LAS unsigned*)(shm + AT_MT) + 2 * (32 * qs + r32) + hi;
    DMA_K(0, 0); DMA_V(0, 0); DMA_K(1, AT_SLOTB);
    bf16x8 qr[4];
    const LAS char* qsp = shm + AT_QS + wid * 4096 + lane * 16;
    { const bf16* qp = (const bf16*)(ws + WS_Q) + qrow * 512 + 64 * head + 8 * hi;
#pragma unroll
      for (int ks = 0; ks < 4; ++ks) qr[ks] = *(const bf16x8*)(qp + 16 * ks);
#pragma unroll
      for (int ks = 0; ks < 4; ++ks) *(LAS bf16x8*)(shm + AT_QS + wid * 4096 + lane * 16 + ks * 1024) = qr[ks]; }
#define QRD(i) do { qv[i] = *(const LAS bf16x8*)(qsp + ((i) & 3) * 1024); } while (0)
    float mhat = 0.f, fsc = 1.f; f32x16 o[2]; o[0] = f32x16{}; o[1] = f32x16{}; f32x16 negm = f32x16{}; AT_PIN(negm);
    f32x16 lacc = f32x16{};
    v4u onesw = (v4u){0x3F803F80u, 0x3F803F80u, 0x3F803F80u, 0x3F803F80u}; AT_PIN(onesw);
    bool resc = false;
    f32x16 pA0, pA1, pB0, pB1; bf16x8 kf[8]; u32x2 vlo[8], vhi[8]; v4u pw0, pw1, pw2, pw3;
    int sl_prev = 0, sl_cur = 0, sl_next = AT_SLOTB;
#define ROT() do { sl_prev = sl_cur; sl_cur = sl_next; sl_next = (sl_next == 2 * AT_SLOTB) ? 0 : sl_next + AT_SLOTB; } while (0)
#define RESC() do { if (resc) { o[0] = o[0] * fsc; o[1] = o[1] * fsc; lacc = lacc * fsc; } } while (0)
    DMA_K(2, 2 * AT_SLOTB);
    AT_WAIT_BAR(3);
#pragma unroll
    for (int d0 = 0; d0 < 4; ++d0) at_kload2(kf, kp0, d0);
    pA0 = mfma32(kf[0], qr[0], negm); pA1 = mfma32(kf[1], qr[0], negm); pA0 = mfma32(kf[2], qr[1], pA0); pA1 = mfma32(kf[3], qr[1], pA1);
    pA0 = mfma32(kf[4], qr[2], pA0); pA1 = mfma32(kf[5], qr[2], pA1); pA0 = mfma32(kf[6], qr[3], pA0); pA1 = mfma32(kf[7], qr[3], pA1);
    { const float rm = at_rowmax(pA0, pA1); mhat = rm;
#pragma unroll
      for (int r = 0; r < 16; ++r) negm[r] = -mhat;
      AT_PIN(negm);
#pragma unroll
      for (int r = 0; r < 16; ++r) { pA0[r] = __builtin_amdgcn_exp2f(pA0[r] - rm); pA1[r] = pA1[r] - rm; } }
    AT_WAIT_BAR(0);
    DMA_K(3, 0); DMA_V(1, AT_SLOTB); ROT();
#pragma unroll
    for (int d0 = 0; d0 < 4; ++d0) at_kload2(kf, kp0 + sl_cur, d0);
    AT_WAIT_BAR(2);
#define PKW(P, i) pg8::cvt_pk_bf16(P[i], P[(i) + 1])
#define PKM(P, i, J0) (PKW(P, i) & AT_PMASK((J0) + (i) / 2, mwp))
#define PAF(k) as_bf16x8(pw##k)
#define VFR(i) as_bf16x8((v4u){vlo[i].x, vlo[i].y, vhi[i].x, vhi[i].y})
#define VRD(i) do { vlo[i] = at_vtr(vp_ + (((i) >> 2) * 4096 + ((i) & 3) * 1024)); vhi[i] = at_vtr(vp_ + (((i) >> 2) * 4096 + ((i) & 3) * 1024 + 512)); } while (0)
#define KRD(d0) do { at_kload2(kf, kp0 + sl_next, d0); AT_SBAR(); } while (0)
#define GAPA(MF, W0, W1, PW) do { MF; W0; W1; AT_PIN(PW); AT_SBAR(); } while (0)
#define MX1(X, i) X[i] = __builtin_amdgcn_exp2f(X[i])
#define GAPAX(MF, W0, W1, PW, X, EXPS) do { MF; W0; W1; AT_PIN(PW); EXPS; AT_PIN(X); AT_SBAR(); } while (0)
#define LSUM(k) do { lacc = mfma32(as_bf16x8(onesw), PAF(k), lacc); AT_SBAR(); } while (0)
#define GAPB(MF, X, i) do { MF; X[i] = __builtin_amdgcn_exp2f(X[i]); X[(i) + 1] = __builtin_amdgcn_exp2f(X[(i) + 1]); AT_PIN(X); AT_SBAR(); } while (0)
#define STEP(C0, C1, P0, P1, t) do { AT_SBAR(); \
    const LAS char* vp_ = vp0 + sl_prev; const unsigned mwp = mT[((t) - 1) * 128]; \
    bf16x8 qv[8]; QRD(0); QRD(1); AT_SBAR(); \
    QRD(2); AT_SBAR(); GAPAX(C0 = mfma32(kf[0], qv[0], negm), pw0[0] = PKM(P0, 0, 0),  pw0[1] = PKM(P0, 2, 0),  pw0, P1, MX1(P1, 0); MX1(P1, 1); MX1(P1, 2)); \
    QRD(3); AT_SBAR(); GAPAX(C0 = mfma32(kf[2], qv[1], C0),   pw0[2] = PKM(P0, 4, 0),  pw0[3] = PKM(P0, 6, 0),  pw0, P1, MX1(P1, 3); MX1(P1, 4); MX1(P1, 5)); \
    QRD(4); AT_SBAR(); GAPAX(C0 = mfma32(kf[4], qv[2], C0),   pw1[0] = PKM(P0, 8, 0),  pw1[1] = PKM(P0, 10, 0), pw1, P1, MX1(P1, 6); MX1(P1, 7)); LSUM(0); \
    QRD(5); AT_SBAR(); GAPAX(C0 = mfma32(kf[6], qv[3], C0),   pw1[2] = PKM(P0, 12, 0), pw1[3] = PKM(P0, 14, 0), pw1, P1, MX1(P1, 8); MX1(P1, 9)); \
    QRD(6); AT_SBAR(); GAPAX(C1 = mfma32(kf[1], qv[4], negm), pw2[0] = PKM(P1, 0, 8),  pw2[1] = PKM(P1, 2, 8),  pw2, P1, MX1(P1, 10); MX1(P1, 11)); LSUM(1); \
    QRD(7); AT_SBAR(); GAPAX(C1 = mfma32(kf[3], qv[5], C1),   pw2[2] = PKM(P1, 4, 8),  pw2[3] = PKM(P1, 6, 8),  pw2, P1, MX1(P1, 12); MX1(P1, 13)); \
    GAPAX(C1 = mfma32(kf[5], qv[6], C1),   pw3[0] = PKM(P1, 8, 8),  pw3[1] = PKM(P1, 10, 8), pw3, P1, MX1(P1, 14); MX1(P1, 15)); LSUM(2); \
    GAPA(C1 = mfma32(kf[7], qv[7], C1),    pw3[2] = PKM(P1, 12, 8), pw3[3] = PKM(P1, 14, 8), pw3); LSUM(3); \
    DMA_K((t) + 3, sl_cur); DMA_V((t) + 1, sl_next);                                                       \
    VRD(0); VRD(4); AT_SBAR();                                                                             \
    { const float rm = at_rowmax(C0, C1); resc = false;                                                    \
      if (__builtin_expect(__any(rm > 8.f), 0)) { const float dl = __builtin_fmaxf(rm, 0.f); mhat += dl;    \
          _Pragma("unroll") for (int r = 0; r < 16; ++r) { C0[r] -= dl; C1[r] -= dl; } \
          _Pragma("unroll") for (int r = 0; r < 16; ++r) negm[r] = -mhat; \
          AT_PIN(negm); fsc = __builtin_amdgcn_exp2f(-dl); resc = true; } } \
    AT_SBAR(); \
    VRD(1); AT_SBAR(); GAPB(o[0] = mfma32(VFR(0), PAF(0), o[0]), C0, 0); \
    VRD(5); AT_SBAR(); GAPB(o[1] = mfma32(VFR(4), PAF(0), o[1]), C0, 2); \
    KRD(0); VRD(2); AT_SBAR(); GAPB(o[0] = mfma32(VFR(1), PAF(1), o[0]), C0, 4); \
    KRD(1); VRD(6); AT_SBAR(); GAPB(o[1] = mfma32(VFR(5), PAF(1), o[1]), C0, 6); \
    KRD(2); VRD(3); AT_SBAR(); GAPB(o[0] = mfma32(VFR(2), PAF(2), o[0]), C0, 8); \
    KRD(3); VRD(7); AT_SBAR(); GAPB(o[1] = mfma32(VFR(6), PAF(2), o[1]), C0, 10); \
    GAPB(o[0] = mfma32(VFR(3), PAF(3), o[0]), C0, 12);              GAPB(o[1] = mfma32(VFR(7), PAF(3), o[1]), C0, 14); \
    } while (0)
    int t = 1;
    for (; t + 1 < NT; t += 2) {
        STEP(pB0, pB1, pA0, pA1, t);     AT_WAIT_BAR(2); RESC(); ROT();
        STEP(pA0, pA1, pB0, pB1, t + 1); AT_WAIT_BAR(2); RESC(); ROT();
    }
    if (t < NT) { STEP(pB0, pB1, pA0, pA1, t); AT_WAIT_BAR(2); RESC(); ROT(); pA0 = pB0; pA1 = pB1; }
    {
#pragma unroll
      for (int r = 0; r < 16; ++r) pA1[r] = __builtin_amdgcn_exp2f(pA1[r]);
      const unsigned mwp = mT[(NT - 1) * 128];
      pw0 = (v4u){PKM(pA0, 0, 0), PKM(pA0, 2, 0), PKM(pA0, 4, 0), PKM(pA0, 6, 0)}; pw1 = (v4u){PKM(pA0, 8, 0), PKM(pA0, 10, 0), PKM(pA0, 12, 0), PKM(pA0, 14, 0)};
      pw2 = (v4u){PKM(pA1, 0, 8), PKM(pA1, 2, 8), PKM(pA1, 4, 8), PKM(pA1, 6, 8)}; pw3 = (v4u){PKM(pA1, 8, 8), PKM(pA1, 10, 8), PKM(pA1, 12, 8), PKM(pA1, 14, 8)};
      const LAS char* vp_ = vp0 + sl_prev;
#pragma unroll
      for (int i = 0; i < 8; ++i) VRD(i);
      o[0] = mfma32(VFR(0), PAF(0), o[0]); o[1] = mfma32(VFR(4), PAF(0), o[1]); o[0] = mfma32(VFR(1), PAF(1), o[0]); o[1] = mfma32(VFR(5), PAF(1), o[1]);
      o[0] = mfma32(VFR(2), PAF(2), o[0]); o[1] = mfma32(VFR(6), PAF(2), o[1]); o[0] = mfma32(VFR(3), PAF(3), o[0]); o[1] = mfma32(VFR(7), PAF(3), o[1]);
      lacc = mfma32(as_bf16x8(onesw), PAF(0), lacc); lacc = mfma32(as_bf16x8(onesw), PAF(1), lacc); lacc = mfma32(as_bf16x8(onesw), PAF(2), lacc); lacc = mfma32(as_bf16x8(onesw), PAF(3), lacc); }
    const float l_reg = lacc[0];
    asm volatile("s_waitcnt vmcnt(0)" ::: "memory");
    {
        const float linv = 1.0f / l_reg; bf16* op = (bf16*)(ws + WS_MIX) + qrow * 1024 + 512 + 64 * head + 8 * hi;
#pragma unroll
        for (int k = 0; k < 8; k += 2) {
            const int dba = k >> 2, ia = k & 3, ib = ia + 1;
            unsigned ax = pg8::cvt_pk_bf16(o[dba][4 * ia] * linv, o[dba][4 * ia + 1] * linv), ay = pg8::cvt_pk_bf16(o[dba][4 * ia + 2] * linv, o[dba][4 * ia + 3] * linv);
            unsigned bx = pg8::cvt_pk_bf16(o[dba][4 * ib] * linv, o[dba][4 * ib + 1] * linv), by = pg8::cvt_pk_bf16(o[dba][4 * ib + 2] * linv, o[dba][4 * ib + 3] * linv);
            { auto r = __builtin_amdgcn_permlane32_swap(ax, bx, false, false); ax = r[0]; bx = r[1]; }
            { auto r = __builtin_amdgcn_permlane32_swap(ay, by, false, false); ay = r[0]; by = r[1]; }
            *(v4u*)(op + 8 * k) = (v4u){ax, ay, bx, by}; }
    }
    asm volatile("s_waitcnt lgkmcnt(0)\n\ts_barrier" ::: "memory");
#undef DMA_K
#undef DMA_V
#undef ROT
#undef RESC
#undef PKW
#undef PKM
#undef PAF
#undef VFR
#undef VRD
#undef KRD
#undef GAPA
#undef GAPAX
#undef MX1
#undef QRD
#undef LSUM
#undef GAPB
#undef STEP
}
__device__ __forceinline__ void topk_attn_unit(Frame& F, int b, int qt) {
    LAS unsigned* mask64 = (LAS unsigned*)(F.lds + RING_OFF + TA_MASK);
    bf16x8 kh0[8], kh1[8];
    topk_load_k(F, b, (qt < 4) ? 0 : 4 * qt + 4, kh0, kh1);
#pragma unroll 1
    for (int sub = 0; sub < 4; ++sub) topk16(F, b, 64 * qt + 16 * sub, mask64 + sub * 16 * 64, kh0, kh1);
    __syncthreads();
    mask_to_tiles(F, mask64);
    __syncthreads();
#pragma unroll 1
#ifdef PROBE_ATT2
    for (int g = 0; g < 4; ++g) attn_unit(F, b, qt, g & 1);
#else
    for (int g = 0; g < 2; ++g) attn_unit(F, b, qt, g);
#endif
}

__device__ __forceinline__ float dpp_sum16(float v) {
    v += __builtin_bit_cast(float, __builtin_amdgcn_update_dpp(0, __builtin_bit_cast(int, v), 0xB1, 0xF, 0xF, true));
    v += __builtin_bit_cast(float, __builtin_amdgcn_update_dpp(0, __builtin_bit_cast(int, v), 0x4E, 0xF, 0xF, true));
    v += __builtin_bit_cast(float, __builtin_amdgcn_update_dpp(0, __builtin_bit_cast(int, v), 0x141, 0xF, 0xF, true));
    v += __builtin_bit_cast(float, __builtin_amdgcn_update_dpp(0, __builtin_bit_cast(int, v), 0x140, 0xF, 0xF, true));
    return v;
}
__device__ __forceinline__ float dot4(const f32x4 a, const f32x4 b) { return __builtin_fmaf(a[3], b[3], __builtin_fmaf(a[2], b[2], __builtin_fmaf(a[1], b[1], a[0] * b[0]))); }
constexpr int SU_SC = 0, SU_QI = 8208 * 4, SU_WI = SU_QI + 256 * 4, SU_Q = SU_WI + 16, SU_SEL = SU_Q + 512 * 4, SU_P = SU_SEL + 256 * 4, SU_CNT = SU_P + 8 * 256 * 4, SU_CW = SU_CNT + 64 * 4, SU_RED = SU_CW + 2 * 17 * 8 * 4, SU_END = SU_RED + 64 * 4;
static_assert(SU_END <= RING_BYTES, "sample-unit LDS");
__device__ __forceinline__ void sample_unit(Frame& F, const Args& A, int b) {
    launder(F); unsigned char* ws = F.ws; const int tid = F.tid, lane = F.lane, w = F.wave;
    LAS float* sc = (LAS float*)(F.lds + RING_OFF + SU_SC); LAS float* qi_s = (LAS float*)(F.lds + RING_OFF + SU_QI); LAS float* wi_s = (LAS float*)(F.lds + RING_OFF + SU_WI);
    LAS float* q_s = (LAS float*)(F.lds + RING_OFF + SU_Q); LAS int* sel = (LAS int*)(F.lds + RING_OFF + SU_SEL); LAS float* p_s = (LAS float*)(F.lds + RING_OFF + SU_P);
    LAS unsigned* cnts = (LAS unsigned*)(F.lds + RING_OFF + SU_CNT); LAS unsigned* cw = (LAS unsigned*)(F.lds + RING_OFF + SU_CW); LAS float* red = (LAS float*)(F.lds + RING_OFF + SU_RED);
    const int* pt = (const int*)IN_L(I_PT) + b * NPAGE;
    if (tid < 256) qi_s[tid] = ((const float*)(ws + SM_QIS))[b * 256 + tid];
    if (tid < 4) wi_s[tid] = ((const float*)(ws + SM_WIS))[b * 4 + tid];
    q_s[tid] = ((const float*)(ws + SM_QS))[b * 512 + tid];
    {
        const float gv = ((const float*)(ws + SM_GVS))[b * 512 + tid];
        const float s1 = wave_sum(gv); if (lane == 0) red[w] = s1;
        __syncthreads();
        float mean = 0.f;
#pragma unroll
        for (int i = 0; i < 8; ++i) mean += red[i];
        mean *= (1.f / 512.f);
        const float d = gv - mean; const float s2 = wave_sum(d * d); if (lane == 0) red[8 + w] = s2;
        __syncthreads();
        float var = 0.f;
#pragma unroll
        for (int i = 0; i < 8; ++i) var += red[8 + i];
        const float rstd = 1.0f / sqrtf(var * (1.f / 512.f) + LN_EPS);
        const float av = d * rstd * IN_L(I_ALNG)[tid] + IN_L(I_ALNB)[tid];
        F.out[OUT_AV + (size_t)b * 512 + tid] = av;
        const int g = tid >> 7; const float mixed = IN_L(I_AWS)[(size_t)g * 128 * 128] * av + IN_L(I_ABS)[g * 128];
        ((bf16*)(ws + SM_MIXSB))[(size_t)b * 1024 + tid] = (bf16)f2bf(((const float*)(ws + SM_US))[b * 512 + tid] * mixed);
    }
    {
        const int sub = lane & 15, kq = lane >> 4;
        f32x4 qh[4];
#pragma unroll
        for (int h = 0; h < 4; ++h) qh[h] = *(const LAS f32x4*)(qi_s + 64 * h + 4 * sub);
        const float w0 = wi_s[0], w1 = wi_s[1], w2 = wi_s[2], w3 = wi_s[3];
        const float* cki = IN_L(I_CKI) + 4 * sub;
#define SU_LOAD(buf, phys, half) { const float* base_ = cki + (size_t)(phys) * (128 * 64) + (half) * (64 * 64); \
            _Pragma("unroll") for (int it = 0; it < 16; ++it) buf[it] = __builtin_nontemporal_load((const f32x4*)(base_ + (4 * it + kq) * 64)); }
#define SU_SCORE(buf, pg_, half) { \
            _Pragma("unroll") for (int it = 0; it < 16; ++it) { const int key = (half) * 64 + 4 * it + kq; const f32x4 kv = buf[it]; \
                const float d0 = dpp_sum16(dot4(kv, qh[0])), d1 = dpp_sum16(dot4(kv, qh[1])), d2 = dpp_sum16(dot4(kv, qh[2])), d3 = dpp_sum16(dot4(kv, qh[3])); \
                float s = w0 * fmaxf(d0, 0.f); s = __builtin_fmaf(w1, fmaxf(d1, 0.f), s); s = __builtin_fmaf(w2, fmaxf(d2, 0.f), s); s = __builtin_fmaf(w3, fmaxf(d3, 0.f), s); \
                if (sub == 0) sc[(pg_) * 128 + key] = s; } }
        {
            f32x4 kvA[16], kvB[16];
            int phys_cur = __builtin_amdgcn_readfirstlane(pt[w]);
            SU_LOAD(kvA, phys_cur, 0)
#pragma unroll 1
            for (int pg = w; pg < NPAGE; pg += NWAVES) {
                const int pgn = (pg + NWAVES < NPAGE) ? pg + NWAVES : pg;
                const int phys_nv = pt[pgn];
                SU_LOAD(kvB, phys_cur, 1)
                __builtin_amdgcn_sched_barrier(0);
                SU_SCORE(kvA, pg, 0)
                const int phys_next = __builtin_amdgcn_readfirstlane(phys_nv);
                if (pg + NWAVES < NPAGE) SU_LOAD(kvA, phys_next, 0)
                __builtin_amdgcn_sched_barrier(0);
                SU_SCORE(kvB, pg, 1)
                phys_cur = phys_next;
            }
        }
#undef SU_LOAD
#undef SU_SCORE
        if (w == 0) { const f32x4 kv = *(const f32x4*)(F.out + OUT_KIS + (size_t)b * 64 + 4 * sub);
            const float d0 = dpp_sum16(dot4(kv, qh[0])), d1 = dpp_sum16(dot4(kv, qh[1])), d2 = dpp_sum16(dot4(kv, qh[2])), d3 = dpp_sum16(dot4(kv, qh[3]));
            float s = w0 * fmaxf(d0, 0.f); s = __builtin_fmaf(w1, fmaxf(d1, 0.f), s); s = __builtin_fmaf(w2, fmaxf(d2, 0.f), s); s = __builtin_fmaf(w3, fmaxf(d3, 0.f), s);
            if (lane == 0) sc[PAST] = s; }
    }
    __syncthreads();
    unsigned x[17];
#pragma unroll
    for (int i = 0; i < 17; ++i) { const int p = tid + 512 * i; x[i] = __float_as_uint(sc[p < PAST + 1 ? p : PAST]); }
    __builtin_amdgcn_sched_barrier(0);
#pragma unroll
    for (int i = 0; i < 17; ++i) { const int p = tid + 512 * i; x[i] = (p <= PAST) ? ord_f32(__uint_as_float(x[i])) : 0u; }
    unsigned prefix = 0u;
#pragma unroll 1
    for (int bit = 31; bit >= 0; --bit) { const unsigned T = prefix | (1u << bit); unsigned c = 0u;
#pragma unroll
        for (int i = 0; i < 17; ++i) cnt_ge(c, x[i], T);
        const unsigned cnt = wave_sum_u32(c);
        LAS unsigned* slot = cnts + 8 * (bit & 1);
        if (lane == 0) slot[w] = cnt;
        __syncthreads();
        unsigned tot = 0;
#pragma unroll
        for (int i = 0; i < 8; ++i) tot += slot[i];
        if (tot >= 256u) prefix = T;
        if (tot == 256u) break; }
    const unsigned thr = prefix;
    {
        const unsigned long long lt = (1ull << lane) - 1ull;
        int cg = 0;
#pragma unroll
        for (int i = 0; i < 17; ++i) cg += __builtin_popcountll(__ballot(x[i] > thr));
        if (lane == 0) cnts[16 + w] = (unsigned)cg;
#pragma unroll
        for (int i = 0; i < 17; ++i) { const unsigned long long gb = __ballot(x[i] > thr), tb = __ballot(x[i] == thr);
            if (lane == 0) { cw[(i * 8 + w) * 2] = (unsigned)__builtin_popcountll(gb); cw[(i * 8 + w) * 2 + 1] = (unsigned)__builtin_popcountll(tb); } }
        __syncthreads();
        unsigned ngt = 0;
#pragma unroll
        for (int i = 0; i < 8; ++i) ngt += cnts[16 + i];
        const unsigned need = 256u - ngt;
        unsigned run_gt = 0, run_ti = 0;
#pragma unroll
        for (int i = 0; i < 17; ++i) {
            unsigned my_g = run_gt, my_t = run_ti;
#pragma unroll
            for (int ww = 0; ww < 8; ++ww) { const unsigned a = cw[(i * 8 + ww) * 2], c = cw[(i * 8 + ww) * 2 + 1]; if (ww < w) { my_g += a; my_t += c; } run_gt += a; run_ti += c; }
            const unsigned long long gb = __ballot(x[i] > thr), tb = __ballot(x[i] == thr); const int p = tid + 512 * i;
            if ((gb >> lane) & 1ull) sel[my_g + (unsigned)__builtin_popcountll(gb & lt)] = p;
            else if ((tb >> lane) & 1ull) { const unsigned rk = my_t + (unsigned)__builtin_popcountll(tb & lt); if (rk < need) sel[ngt + rk] = p; }
            __builtin_amdgcn_sched_barrier(0);
        }
    }
    __syncthreads();
    {
        LAS int* ro_s = (LAS int*)cw;
        if (tid < 256) { const int p = sel[tid]; ro_s[tid] = (p < PAST) ? pt[p >> 7] * 128 + (p & 127) : -1; }
        __syncthreads();
        const int h = w, g = h >> 2; const float* ck = IN_L(I_CK); const float* cv = IN_L(I_CV);
        const int sub = lane & 15, kq = lane >> 4;
        const f32x4 qv = *(const LAS f32x4*)(q_s + 64 * h + 4 * sub);
        const float* knew = F.out + OUT_KS + ((size_t)b * 2 + g) * 64 + 4 * sub; const float* vnew = F.out + OUT_VS + ((size_t)b * 2 + g) * 64 + 4 * sub;
#pragma unroll 1
        for (int it0 = 0; it0 < 64; it0 += 32) { f32x4 kr16[32];
#pragma unroll
            for (int i = 0; i < 32; ++i) { const int ro = ro_s[4 * (it0 + i) + kq]; kr16[i] = *(const f32x4*)((ro >= 0) ? ck + ((size_t)ro * 2 + g) * 64 + 4 * sub : knew); }
            __builtin_amdgcn_sched_barrier(0);
#pragma unroll
            for (int i = 0; i < 32; ++i) { const float d = dpp_sum16(dot4(kr16[i], qv)); if (sub == 0) p_s[h * 256 + 4 * (it0 + i) + kq] = d * 0.125f; } }
        LDS_WAIT(); asm volatile("" ::: "memory");
        const float l0 = p_s[h * 256 + lane], l1 = p_s[h * 256 + lane + 64], l2 = p_s[h * 256 + lane + 128], l3 = p_s[h * 256 + lane + 192];
        const float mx = wave_max(fmaxf(fmaxf(l0, l1), fmaxf(l2, l3)));
        const float e0 = __expf(l0 - mx), e1 = __expf(l1 - mx), e2 = __expf(l2 - mx), e3 = __expf(l3 - mx);
        p_s[h * 256 + lane] = e0; p_s[h * 256 + lane + 64] = e1; p_s[h * 256 + lane + 128] = e2; p_s[h * 256 + lane + 192] = e3;
        const float ls = (e0 + e1) + (e2 + e3);
        const float linv = 1.0f / wave_sum(ls);
        LDS_WAIT(); asm volatile("" ::: "memory");
        f32x4 acc = (f32x4){0.f, 0.f, 0.f, 0.f};
#pragma unroll 1
        for (int it0 = 0; it0 < 64; it0 += 32) { f32x4 vr16[32];
#pragma unroll
            for (int i = 0; i < 32; ++i) { const int ro = ro_s[4 * (it0 + i) + kq]; vr16[i] = *(const f32x4*)((ro >= 0) ? cv + ((size_t)ro * 2 + g) * 64 + 4 * sub : vnew); }
            __builtin_amdgcn_sched_barrier(0);
#pragma unroll
            for (int i = 0; i < 32; ++i) acc = acc + vr16[i] * p_s[h * 256 + 4 * (it0 + i) + kq]; }
#pragma unroll
        for (int i = 0; i < 4; ++i) { acc[i] += __shfl_xor(acc[i], 16); acc[i] += __shfl_xor(acc[i], 32); }
        if (kq == 0) { const f32x4 o = acc * linv; u32x2 wv; wv.x = pk2(o[0], o[1]); wv.y = pk2(o[2], o[3]); *(u32x2*)((bf16*)(ws + SM_MIXSB) + (size_t)b * 1024 + 512 + 64 * h + 4 * sub) = wv; }
    }
    __syncthreads();
}

__global__ void __launch_bounds__(NWAVES * 64, 2) hymba_fwd(Args args) {
    extern __shared__ __attribute__((aligned(16))) unsigned char lds[];
    Frame F;
    F.lds = (LAS unsigned char*)lds;
    F.MISC = (volatile LAS unsigned*)(F.lds + MISC_OFF);
    F.tid = threadIdx.x; F.lane = F.tid & 63; F.wave = __builtin_amdgcn_readfirstlane(F.tid >> 6);
    F.G = gridDim.x; { const int bx = blockIdx.x; F.vcu = (F.G % 8 == 0) ? (bx % 8) * (F.G / 8) + bx / 8 : bx; }
    F.out = args.out; F.ws = args.ws; const Args& A = args;
    unsigned char* ws = args.ws;
    F.ctl = (gu32*)(ws + WS_CTL);
    for (int u = F.tid; u < (LDS_BYTES - LDSCTL_OFF) / 4; u += NWAVES * 64) ((LAS unsigned*)(F.lds + LDSCTL_OFF))[u] = 0u;
    __syncthreads();
    if (F.tid < 22) { const unsigned long long* ka = (const unsigned long long*)__builtin_amdgcn_kernarg_segment_ptr();
        ((volatile LAS unsigned long long*)(F.lds + LDSCTL_OFF))[F.tid] = ka[F.tid]; }
    __syncthreads();
    XcdBarrier bar; bar.bar = (unsigned*)(F.ctl + CW_BAR); bar.x = 0; bar.st = nullptr;
    if (N_LAUNCHES == 1) bar = xcd_barrier_post((unsigned*)(F.ctl + CW_BAR), F.MISC + 8);
#define GRID_BAR() do { if (N_LAUNCHES == 1) xcd_barrier(bar); } while (0)
    const int lo = args.ph_lo, hi = args.ph_hi;
#define IN(k) (lo <= (k) && (k) < hi)
#define BOTH(k) (IN(k) && IN((k) + 1))
    const int c = (int)blockIdx.x;

    if (IN(0)) { p0_prologue(F, A); if (BOTH(0)) GRID_BAR(); }

    if (IN(1)) {
        pg8::Gemm g{(const bf16*)(ws + WS_XB), (const bf16*)(ws + WS_W1UP), MP, 2 * FF, DM}; pg8::StaticOrder S; S.init(MP, 2 * FF, F.G, c);
        pg8::EpiSwiGLU<false> E{(bf16*)(ws + WS_H), FF, nullptr, nullptr, nullptr, 0u};
        pg8::gemm_phase<pg8::EpiSwiGLU<false>, pg8::StaticOrder, true, true>(F.lds + RING_OFF, g, S, E);
        finalize_cvec(F, 0);
        thin_stage<1>(F, A, F.G - 1 - F.vcu, F.G);
        if (BOTH(1)) GRID_BAR();
    }
    if (IN(2)) {
        pg8::Gemm g{(const bf16*)(ws + WS_H), (const bf16*)(ws + WS_W1DN), MP, DM, FF}; pg8::StaticOrder S; S.init(MP, DM, F.G, c);
        pg8::EpiZ<0, true> E{(const bf16*)(ws + WS_XB), nullptr, nullptr, nullptr, (bf16*)(ws + WS_Z1), (float*)(ws + WS_STZ1), (unsigned)(size_t)(F.lds + XLDS_OFF)};
        pg8::gemm_phase<pg8::EpiZ<0, true>, pg8::StaticOrder, true, true>(F.lds + RING_OFF, g, S, E);
        thin_stage<2>(F, A, F.G - 1 - F.vcu, F.G);
        if (BOTH(2)) GRID_BAR();
    }
    if (IN(3)) {
        pg8::EpiWin E{(bf16*)(ws + WS_U), (bf16*)(ws + WS_GV), (bf16*)(ws + WS_Q), (bf16*)(ws + WS_K), (bf16*)(ws + WS_VT), (bf16*)(ws + WS_QI), (bf16*)(ws + WS_KI),
                      (float*)(ws + WS_GVST), (float*)(ws + WS_WI), F.out + OUT_KP, F.out + OUT_VP, F.out + OUT_KIP, (const float*)(ws + WS_ROPEC), (const float*)(ws + WS_ROPES),
                      (const float*)(ws + WS_STZ1), (const float*)(ws + CV_C1IN), (const float*)(ws + CV_C2IN), (unsigned)(size_t)(F.lds + XLDS_OFF + 8192), 0};
        { pg8::Gemm g{(const bf16*)(ws + WS_Z1), (const bf16*)(ws + WS_WIN), MP, 2048, DM}; pg8::StaticOrder S; S.init(MP, 2048, F.G, c);
          pg8::gemm_phase<pg8::EpiWin, pg8::StaticOrder, true, true>(F.lds + RING_OFF, g, S, E); }
        __syncthreads();
        { pg8::Gemm g{(const bf16*)(ws + WS_Z1), (const bf16*)(ws + WS_WIN) + (size_t)2048 * DM, MP, 256, DM}; pg8::StaticOrder S; S.init(MP, 256, F.G, c);
          E.pn_off = 8;
          pg8::gemm_phase<pg8::EpiWin, pg8::StaticOrder, true, true, true>(F.lds + RING_OFF, g, S, E); }
        if (c >= 128) { thin_stage<3>(F, A, c - 128, 128); p0_wout(F, A, c - 128, 128); }
        if (BOTH(3)) GRID_BAR();
    }
    if (IN(4)) {
#ifndef PROBE_Q_DUP
#define PROBE_Q_DUP 0
#endif
        constexpr int N_SMP = NS * (PROBE_Q_DUP == 1 ? 2 : 1), N_ATT = NB * 32 * (PROBE_Q_DUP == 2 ? 2 : 1), N_GM = NB * 16 * 4 * (PROBE_Q_DUP == 3 ? 2 : 1);
        constexpr int Q_SAMPLE = N_SMP, Q_ATTN = Q_SAMPLE + N_ATT, Q_GM = Q_ATTN + N_GM, Q_TOTAL = Q_GM + LATE_UNITS;
        gu32* qhead = F.ctl + CW_QUEUE; volatile LAS unsigned* qslot = F.MISC + 16;
        if (F.tid == 0) qslot[0] = __hip_atomic_fetch_add(qhead, 1u, RLX_AGENT);
        __syncthreads();
        int item = __builtin_amdgcn_readfirstlane((int)qslot[0]); int par = 0;
        while (item < Q_TOTAL) {
            unsigned nxt = 0u; if (F.tid == 0) nxt = __hip_atomic_fetch_add(qhead, 1u, RLX_AGENT);
            if (item < Q_SAMPLE) sample_unit(F, A, item % NS);
            else if (item < Q_ATTN) { const int i = (item - Q_SAMPLE) % (NB * 32); topk_attn_unit(F, i & 15, 31 - (i >> 4)); }
            else if (item < Q_GM) { const int L = (item - Q_ATTN) % (NB * 16 * 4); gmlp_unit(F, A, L >> 6, (L >> 2) & 15, L & 3); }
            else late_weight_unit(F, A, item - Q_GM);
            par ^= 1; if (F.tid == 0) qslot[par] = nxt;
            __syncthreads();
            item = __builtin_amdgcn_readfirstlane((int)qslot[par]);
        }
        if (BOTH(4)) GRID_BAR();
    }
    if (IN(5)) {
        pg8::Gemm g{(const bf16*)(ws + WS_MIX), (const bf16*)(ws + WS_WOUT), MP, DM, DM}; pg8::StaticOrder S; S.init(MP, DM, F.G, c);
        pg8::EpiZ<1, false> E{(const bf16*)(ws + WS_Z1), (const float*)(ws + WS_STZ1), IN_F(I_LN1G), IN_F(I_LN1B), (bf16*)(ws + WS_Z2), (float*)(ws + WS_STZ2), (unsigned)(size_t)(F.lds + XLDS_OFF)};
        pg8::gemm_phase<pg8::EpiZ<1, false>, pg8::StaticOrder, true, true>(F.lds + RING_OFF, g, S, E);
        finalize_cvec(F, 1);
        thin_stage<6>(F, A, F.G - 1 - F.vcu, F.G);
        if (BOTH(5)) GRID_BAR();
    }
    if (IN(6)) {
        pg8::Gemm g{(const bf16*)(ws + WS_Z2), (const bf16*)(ws + WS_W2UP), MP, 2 * FF, DM}; pg8::StaticOrder S; S.init(MP, 2 * FF, F.G, c);
        pg8::EpiSwiGLU<true> E{(bf16*)(ws + WS_H), FF, (const float*)(ws + WS_STZ2), (const float*)(ws + CV_C1UP), (const float*)(ws + CV_C2UP), (unsigned)(size_t)(F.lds + XLDS_OFF + 8192)};
        pg8::gemm_phase<pg8::EpiSwiGLU<true>, pg8::StaticOrder, true, true>(F.lds + RING_OFF, g, S, E);
        thin_stage<7>(F, A, F.G - 1 - F.vcu, F.G);
        if (BOTH(6)) GRID_BAR();
    }
    if (IN(7)) {
        pg8::Gemm g{(const bf16*)(ws + WS_H), (const bf16*)(ws + WS_W2DN), MP, DM, FF}; pg8::StaticOrder S; S.init(MP, DM, F.G, c);
        pg8::EpiZ<1, true> E{(const bf16*)(ws + WS_Z2), (const float*)(ws + WS_STZ2), IN_F(I_LN2G), IN_F(I_LN2B), (bf16*)(ws + WS_Z3), (float*)(ws + WS_STZ3), (unsigned)(size_t)(F.lds + XLDS_OFF)};
        pg8::gemm_phase<pg8::EpiZ<1, true>, pg8::StaticOrder, true, true>(F.lds + RING_OFF, g, S, E);
        thin_stage<8>(F, A, F.G - 1 - F.vcu, F.G);
        if (BOTH(7)) GRID_BAR();
    }
    if (IN(8)) { thin_final_ln(F, A); final_ln_rows(F, A); }
#undef IN
#undef BOTH
#undef GRID_BAR
}

extern "C" void kernel_launch(void* const* d_in, const int* in_sizes, int n_in, void* d_out, int out_size, void* d_ws, size_t ws_size, hipStream_t stream) {
    static int grid = 0;
    if (grid == 0) {
        if (n_in != 22 || in_sizes[0] != MP * DM || (size_t)out_size != OUT_TOTAL || ws_size < WS_END) {
            fprintf(stderr, "kernel_launch: unexpected shapes (n_in %d, in0 %d, out %d, ws %zu); nothing launched\n", n_in, n_in > 0 ? in_sizes[0] : -1, out_size, ws_size); grid = -1; return; }
        int dev = 0, cus = 0, per_cu = 0;
        if (hipGetDevice(&dev) != hipSuccess || hipDeviceGetAttribute(&cus, hipDeviceAttributeMultiprocessorCount, dev) != hipSuccess) { fprintf(stderr, "kernel_launch: device query failed\n"); grid = -1; return; }
        if (hipFuncSetAttribute((const void*)hymba_fwd, hipFuncAttributeMaxDynamicSharedMemorySize, LDS_BYTES) != hipSuccess) { fprintf(stderr, "kernel_launch: hipFuncSetAttribute failed\n"); grid = -1; return; }
        if (hipOccupancyMaxActiveBlocksPerMultiprocessor(&per_cu, (const void*)hymba_fwd, NWAVES * 64, LDS_BYTES) != hipSuccess || per_cu < 1)
            fprintf(stderr, "kernel_launch: note: occupancy query reports %d workgroups per CU\n", per_cu);
        (void)hipGetLastError();
        grid = cus;
        if (grid != 256) fprintf(stderr, "kernel_launch: %d CUs; the fused LayerNorm phases need 256 workgroups: output will be NaN\n", grid);
    }
    if (grid < 0) return;
    if (hipMemsetAsync((char*)d_ws + WS_CTL, 0, CTL_ZERO_BYTES, stream) != hipSuccess) { fprintf(stderr, "kernel_launch: memset failed\n"); return; }
    Args a{};
    for (int i = 0; i < 22; ++i) a.in[i] = d_in[i];
    a.out = (float*)d_out; a.ws = (unsigned char*)d_ws;
    for (int li = 0; li < N_LAUNCHES; ++li) {
        a.ph_lo = (N_LAUNCHES == 1) ? 0 : li; a.ph_hi = (N_LAUNCHES == 1) ? N_PHASES : li + 1;
        hipLaunchKernelGGL(hymba_fwd, dim3(grid), dim3(NWAVES * 64), LDS_BYTES, stream, a);
        const hipError_t le = hipPeekAtLastError();
        if (le != hipSuccess) { fprintf(stderr, "kernel_launch: launch %d failed: %s\n", li, hipGetErrorName(le)); break; }
    }
}
```

```cpp
#include <hip/hip_runtime.h>
#include <cstdio>
#include <cstdint>
namespace pg8 {
#define PG8_LAS __attribute__((address_space(3)))
typedef unsigned short bf16_t;
typedef short bf16x8 __attribute__((ext_vector_type(8)));
typedef float f32x4 __attribute__((ext_vector_type(4)));
typedef unsigned u32x4 __attribute__((ext_vector_type(4)));
constexpr int BM = 256, BK = 64, HALF = 128, HTB = HALF * BK * 2  , STAGE_BYTES = 8 * HTB, NXCD = 8, WGM = 8;

__host__ __device__ __forceinline__ int lds_byte(int r, int c) { const int st = (r >> 4) * 2 + (c >> 5), rr = r & 15, cc = c & 31, ob = rr * 64 + cc * 2; return st * 1024 + (ob ^ (((ob >> 9) & 1) << 5)); }
__host__ __device__ __forceinline__ void stage_rc(int b, int& R, int& C) { const int st = b / 1024, sb = b % 1024, swz = sb ^ (((sb >> 9) & 1) << 5); R = (st >> 1) * 16 + swz / 64; C = (st & 1) * 32 + (swz % 64) / 2; }
__host__ __device__ __forceinline__ int perm32(int rho) { const int n = rho >> 4, i = rho & 15; return 8 * (i >> 2) + 4 * n + (i & 3); }

struct Unit { int pm, pn; };
struct Gemm { const bf16_t* A; const bf16_t* Bt; int M, N, K; };

struct StaticOrder {
    int nM, nN, nwg, G, c;
    __host__ __device__ void init(int M, int N, int G_, int c_) { nM = M / BM; nN = N / BM; nwg = nM * nN; G = G_; c = c_; }
    __host__ __device__ bool next(int i, Unit& u) const {
        const long L = (long)i * G + c; if (L >= nwg) return false;
        int wgid = (int)L; { const int q = nwg / NXCD, r = nwg % NXCD, xcd = wgid % NXCD, off = wgid / NXCD; wgid = (xcd < r ? xcd * (q + 1) : r * (q + 1) + (xcd - r) * q) + off; }
        const int nig = WGM * nN, gid = wgid / nig, fm = gid * WGM, gsz = (nM - fm) < WGM ? (nM - fm) : WGM;
        u.pm = fm + ((wgid % nig) % gsz); u.pn = (wgid % nig) / gsz; return true;
    }
    __device__ __forceinline__ void a_ready(const Unit&) const {}
    __device__ __forceinline__ void done(const Unit&) const {}
};

__device__ __forceinline__ unsigned cvt_pk_bf16(float lo, float hi) { unsigned r; asm volatile("v_cvt_pk_bf16_f32 %0, %1, %2" : "=v"(r) : "v"(lo), "v"(hi)); return r; }
typedef float f32x2 __attribute__((ext_vector_type(2)));
template <class Epi, class Sched, bool ALIGN_EPI = false, bool SP2 = false, bool HALF_N = false>
__device__ __forceinline__ void gemm_phase(PG8_LAS unsigned char* lds, const Gemm g, const Sched& S, const Epi& E) {
    int tid_ = threadIdx.x; asm volatile("" : "+v"(tid_));
    const int tid = tid_, wid = __builtin_amdgcn_readfirstlane(tid >> 6), lane = tid & 63, wr = wid >> 2, wc = wid & 3, fr = lane & 15, fq = lane >> 4;
    const int K = g.K, nt = K / BK;
    unsigned voffA[2], voffB[2];
#pragma unroll
    for (int i = 0; i < 2; ++i) { int R, C; stage_rc(tid * 16 + i * 8192, R, C); const int Rb = Epi::PERM ? ((R & ~31) + perm32(R & 31)) : R;
        voffA[i] = (unsigned)(R * K + C) * 2u; voffB[i] = (unsigned)(Rb * K + C) * 2u; }
    const size_t kstep = (size_t)(BK * 2);
    const size_t hstep = (size_t)HALF * K * 2;
    const size_t tstep = 2 * hstep;
    const unsigned ldsw = (unsigned)wid * 1024u;
    const int aoff = lds_byte(wr * 64 + fr, fq * 8), boff = lds_byte(wc * 32 + fr, fq * 8);
#define PG8_SA(b, h) (((b) * 2 + (h)) * HTB)
#define PG8_SB(b, h) ((4 + (b) * 2 + (h)) * HTB)
#define PG8_STAGE(bufoff, gbase, voff) do { _Pragma("unroll") for (int _i = 0; _i < 2; ++_i) \
        __builtin_amdgcn_global_load_lds((const unsigned*)((const char*)(gbase) + (voff)[_i]), (PG8_LAS unsigned*)(lds + (bufoff) + ldsw + _i * 8192), 16, 0, 0); } while (0)
#define PG8_LDA(dst, b, h) do { _Pragma("unroll") for (int m = 0; m < 4; ++m) _Pragma("unroll") for (int k = 0; k < 2; ++k) dst[m][k] = *(const PG8_LAS bf16x8*)(lds + PG8_SA(b, h) + aoff + m * 2048 + k * 1024); } while (0)
#define PG8_LDB(dst, b, h) do { _Pragma("unroll") for (int n = 0; n < 2; ++n) _Pragma("unroll") for (int k = 0; k < 2; ++k) dst[n][k] = *(const PG8_LAS bf16x8*)(lds + PG8_SB(b, h) + boff + n * 2048 + k * 1024); } while (0)
#define PG8_MMA(ai, bj, At, Bt) do { __builtin_amdgcn_s_setprio(1); _Pragma("unroll") for (int m = 0; m < 4; ++m) _Pragma("unroll") for (int n = 0; n < 2; ++n) _Pragma("unroll") for (int k = 0; k < 2; ++k) \
        acc[ai][bj][m][n] = __builtin_amdgcn_mfma_f32_16x16x32_bf16(Bt[n][k], At[m][k], acc[ai][bj][m][n], 0, 0, 0); __builtin_amdgcn_s_setprio(0); } while (0)
#define PG8_WAIT_V(n) asm volatile("s_waitcnt vmcnt(" #n ")" ::: "memory")
#define PG8_WAIT_L(n) asm volatile("s_waitcnt lgkmcnt(" #n ")" ::: "memory")
#define PG8_BAR __builtin_amdgcn_s_barrier()
#define PG8_SCHED __builtin_amdgcn_sched_barrier(0)
    Unit cur, nxt; int ui = 0;
    if (!S.next(0, cur)) return;
    f32x4 acc[2][2][4][2];
#pragma unroll
    for (int a = 0; a < 2; ++a)
#pragma unroll
        for (int b = 0; b < 2; ++b)
#pragma unroll
            for (int m = 0; m < 4; ++m)
#pragma unroll
                for (int n = 0; n < 2; ++n) acc[a][b][m][n] = (f32x4){0.f, 0.f, 0.f, 0.f};
    bf16x8 At[4][2], B0[2][2], B1[2][2];
    const char* cA = (const char*)g.A + (size_t)cur.pm * tstep; const char* cB = (const char*)g.Bt + (size_t)cur.pn * tstep;
    S.a_ready(cur);
    if constexpr (SP2) {
        PG8_STAGE(PG8_SB(0, 0), cB, voffB); PG8_STAGE(PG8_SB(0, 1), cB + hstep, voffB); PG8_STAGE(PG8_SA(0, 0), cA, voffA); PG8_STAGE(PG8_SA(0, 1), cA + hstep, voffA);
        if (wr == 1) PG8_BAR;
        PG8_WAIT_V(2); PG8_BAR;
        PG8_STAGE(PG8_SB(1, 0), cB + kstep, voffB); PG8_STAGE(PG8_SA(1, 0), cA + kstep, voffA); PG8_STAGE(PG8_SB(1, 1), cB + hstep + kstep, voffB);
        PG8_WAIT_V(6); PG8_BAR;
    } else {
        PG8_STAGE(PG8_SB(0, 0), cB, voffB); PG8_STAGE(PG8_SA(0, 0), cA, voffA); PG8_STAGE(PG8_SB(0, 1), cB + hstep, voffB); PG8_STAGE(PG8_SA(0, 1), cA + hstep, voffA);
        if (wr == 1) PG8_BAR;
        PG8_WAIT_V(4); PG8_BAR;
        PG8_STAGE(PG8_SB(1, 0), cB + kstep, voffB); PG8_STAGE(PG8_SA(1, 0), cA + kstep, voffA); PG8_STAGE(PG8_SB(1, 1), cB + hstep + kstep, voffB);
        PG8_WAIT_V(6); PG8_BAR;
    }
    for (;;) {
        const bool has_next = S.next(ui + 1, nxt);
        const char* nA = has_next ? (const char*)g.A + (size_t)nxt.pm * tstep : cA; const char* nB = has_next ? (const char*)g.Bt + (size_t)nxt.pn * tstep : cB;
        for (int t = 0; t < nt; t += 2) {
            const bool last = (t == nt - 2);
            const char* a1 = cA + (size_t)(t + 1) * kstep;
            const char* a2 = last ? nA : cA + (size_t)(t + 2) * kstep; const char* b2 = last ? nB : cB + (size_t)(t + 2) * kstep;
            const char* a3 = a2 + kstep; const char* b3 = b2 + kstep;
            if (last && has_next) S.a_ready(nxt);
            if constexpr (SP2) {
            PG8_LDB(B0, 0, 0); if constexpr (!HALF_N) PG8_LDB(B1, 0, 1); PG8_SCHED; PG8_LDA(At, 0, 0); PG8_STAGE(PG8_SA(1, 1), a1 + hstep, voffA);
            PG8_WAIT_V(8); PG8_WAIT_L(0); PG8_BAR; PG8_MMA(0, 0, At, B0); if constexpr (!HALF_N) PG8_MMA(0, 1, At, B1); PG8_BAR; PG8_SCHED;
            PG8_LDA(At, 0, 1); PG8_STAGE(PG8_SB(0, 0), b2, voffB); PG8_STAGE(PG8_SB(0, 1), b2 + hstep, voffB); PG8_STAGE(PG8_SA(0, 0), a2, voffA);
            PG8_WAIT_V(8); PG8_WAIT_L(0); PG8_BAR; PG8_MMA(1, 0, At, B0); if constexpr (!HALF_N) PG8_MMA(1, 1, At, B1); PG8_BAR; PG8_SCHED;
            PG8_LDB(B0, 1, 0); if constexpr (!HALF_N) PG8_LDB(B1, 1, 1); PG8_SCHED; PG8_LDA(At, 1, 0); PG8_STAGE(PG8_SA(0, 1), a2 + hstep, voffA);
            PG8_WAIT_V(8); PG8_WAIT_L(0); PG8_BAR; PG8_MMA(0, 0, At, B0); if constexpr (!HALF_N) PG8_MMA(0, 1, At, B1); PG8_BAR; PG8_SCHED;
            PG8_LDA(At, 1, 1); PG8_STAGE(PG8_SB(1, 0), b3, voffB); PG8_STAGE(PG8_SB(1, 1), b3 + hstep, voffB); PG8_STAGE(PG8_SA(1, 0), a3, voffA);
            PG8_WAIT_V(8); PG8_WAIT_L(0); PG8_BAR; PG8_MMA(1, 0, At, B0); if constexpr (!HALF_N) PG8_MMA(1, 1, At, B1); PG8_BAR; PG8_SCHED;
            } else {
            PG8_LDB(B0, 0, 0); PG8_SCHED; PG8_LDA(At, 0, 0); PG8_STAGE(PG8_SA(1, 1), a1 + hstep, voffA);
            PG8_WAIT_L(8); PG8_BAR; PG8_WAIT_L(0); PG8_MMA(0, 0, At, B0); PG8_BAR; PG8_SCHED;
            PG8_LDB(B1, 0, 1); PG8_STAGE(PG8_SB(0, 0), b2, voffB);
            PG8_BAR; PG8_WAIT_L(0); PG8_MMA(0, 1, At, B1); PG8_BAR;
            PG8_LDA(At, 0, 1); PG8_STAGE(PG8_SA(0, 0), a2, voffA);
            PG8_BAR; PG8_WAIT_L(0); PG8_MMA(1, 0, At, B0); PG8_BAR; PG8_SCHED;
            PG8_STAGE(PG8_SB(0, 1), b2 + hstep, voffB);
            PG8_WAIT_V(6); PG8_BAR; PG8_MMA(1, 1, At, B1); PG8_BAR;
            PG8_LDB(B0, 1, 0); PG8_SCHED; PG8_LDA(At, 1, 0); PG8_STAGE(PG8_SA(0, 1), a2 + hstep, voffA);
            PG8_WAIT_L(8); PG8_BAR; PG8_WAIT_L(0); PG8_MMA(0, 0, At, B0); PG8_BAR; PG8_SCHED;
            PG8_LDB(B1, 1, 1); PG8_STAGE(PG8_SB(1, 0), b3, voffB);
            PG8_BAR; PG8_WAIT_L(0); PG8_MMA(0, 1, At, B1); PG8_BAR;
            PG8_LDA(At, 1, 1); PG8_STAGE(PG8_SA(1, 0), a3, voffA);
            PG8_BAR; PG8_WAIT_L(0); PG8_MMA(1, 0, At, B0); PG8_BAR; PG8_SCHED;
            PG8_STAGE(PG8_SB(1, 1), b3 + hstep, voffB);
            PG8_WAIT_V(6); PG8_BAR; PG8_MMA(1, 1, At, B1); PG8_BAR;
            }
        }
        if constexpr (ALIGN_EPI) { if (wr == 0) PG8_BAR; }
        if constexpr (!Epi::AFTER_DRAIN) { E(acc, cur, wr, wc, fr, fq); S.done(cur); }
        if (!has_next) break;
#pragma unroll
        for (int a = 0; a < 2; ++a)
#pragma unroll
            for (int b = 0; b < 2; ++b)
#pragma unroll
                for (int m = 0; m < 4; ++m)
#pragma unroll
                    for (int n = 0; n < 2; ++n) acc[a][b][m][n] = (f32x4){0.f, 0.f, 0.f, 0.f};
        cur = nxt; cA = nA; cB = nB; ++ui;
        if constexpr (ALIGN_EPI) { if (wr == 1) PG8_BAR; }
    }
    PG8_WAIT_V(0);
    if constexpr (!ALIGN_EPI) { if (wr == 0) PG8_BAR; }
    PG8_BAR;
    if constexpr (Epi::AFTER_DRAIN) { E.fused(acc, cur, wr, wc, fr, fq, lds, wid, lane); S.done(cur); }
#undef PG8_SA
#undef PG8_SB
#undef PG8_STAGE
#undef PG8_LDA
#undef PG8_LDB
#undef PG8_MMA
#undef PG8_WAIT_V
#undef PG8_WAIT_L
#undef PG8_BAR
#undef PG8_SCHED
}
}
namespace pg8 {
typedef unsigned u32x2 __attribute__((ext_vector_type(2)));
constexpr float kAlpha = 1.189207115002721f;
__device__ __forceinline__ float silu_f(float x) { return x * __builtin_amdgcn_rcpf(1.f + __builtin_amdgcn_exp2f(-1.4426950408889634f * x)); }
__device__ __forceinline__ float gelu_f(float x) { const float t = x * (1.f + 0.044715f * x * x); return x * __builtin_amdgcn_rcpf(1.f + __builtin_amdgcn_exp2f(-2.3022081981f * t)); }
__device__ __forceinline__ f32x4 sigmoid_scaled4(const f32x4 t) {
    const f32x4 e = (f32x4){__builtin_amdgcn_exp2f(t[0]), __builtin_amdgcn_exp2f(t[1]), __builtin_amdgcn_exp2f(t[2]), __builtin_amdgcn_exp2f(t[3])} + 1.0f;
    return (f32x4){__builtin_amdgcn_rcpf(e[0]), __builtin_amdgcn_rcpf(e[1]), __builtin_amdgcn_rcpf(e[2]), __builtin_amdgcn_rcpf(e[3])};
}
__device__ __forceinline__ f32x4 silu4(const f32x4 x) { return x * sigmoid_scaled4(x * -1.4426950408889634f); }
__device__ __forceinline__ f32x4 gelu4(const f32x4 x) { return x * sigmoid_scaled4((x * (x * x * 0.044715f + 1.0f)) * -2.3022081981f); }
__device__ __forceinline__ u32x4 pack8(const f32x4 a, const f32x4 b) { u32x4 w; w.x = cvt_pk_bf16(a[0], a[1]); w.y = cvt_pk_bf16(a[2], a[3]); w.z = cvt_pk_bf16(b[0], b[1]); w.w = cvt_pk_bf16(b[2], b[3]); return w; }
__device__ __forceinline__ f32x4 unpack4(const u32x2 w) { f32x4 r; r[0] = __uint_as_float(w.x << 16); r[1] = __uint_as_float(w.x & 0xffff0000u); r[2] = __uint_as_float(w.y << 16); r[3] = __uint_as_float(w.y & 0xffff0000u); return r; }

__device__ __forceinline__ void stats_from(const f32x4 a, const f32x4 b, float& mean, float& rstd) {
    mean = ((a[0] + a[2]) + (b[0] + b[2])) * 0.25f;
    const float d0 = a[0] - mean, d1 = a[2] - mean, d2 = b[0] - mean, d3 = b[2] - mean;
    rstd = 1.0f / sqrtf((((a[1] + a[3]) + (b[1] + b[3])) + 256.f * ((d0 * d0 + d1 * d1) + (d2 * d2 + d3 * d3))) * (1.f / 1024.f) + 1e-5f);
}
typedef float f32x2t __attribute__((ext_vector_type(2)));
__device__ __forceinline__ void panel_stats_to_lds(const float* st, int pm, PG8_LAS f32x2t* T, int tid) {
    if (tid < 256) { const size_t row = (size_t)(pm * BM + tid); float mean, rstd; stats_from(*(const f32x4*)(st + row * 8), *(const f32x4*)(st + row * 8 + 4), mean, rstd); T[tid] = (f32x2t){mean, rstd}; }
    asm volatile("s_waitcnt lgkmcnt(0)" ::: "memory"); __builtin_amdgcn_s_barrier(); asm volatile("" ::: "memory");
}
__device__ __forceinline__ void fold_ln(f32x4 (&acc)[2][2][4][2], const float* st, const float* c1, const float* c2, const Unit& u, int wr, int wc, int fr, int fq, unsigned tlds) {
    PG8_LAS f32x2t* T = (PG8_LAS f32x2t*)(size_t)tlds;
    const int rl0 = wr * 64 + fr, col0 = u.pn * BM + wc * 32 + 8 * fq;
    f32x4 c1v[2][2], c2v[2][2];
#pragma unroll
    for (int bj = 0; bj < 2; ++bj)
#pragma unroll
        for (int n = 0; n < 2; ++n) { c1v[bj][n] = *(const f32x4*)(c1 + col0 + bj * HALF + 4 * n); c2v[bj][n] = *(const f32x4*)(c2 + col0 + bj * HALF + 4 * n); }
    __builtin_amdgcn_sched_barrier(0);
    panel_stats_to_lds(st, u.pm, T, (wr * 4 + wc) * 64 + fq * 16 + fr);
#pragma unroll
    for (int ai = 0; ai < 2; ++ai)
#pragma unroll
        for (int m = 0; m < 4; ++m) { const f32x2t t = T[ai * HALF + m * 16 + rl0]; const float tq = -t.y * t.x;
#pragma unroll
            for (int bj = 0; bj < 2; ++bj)
#pragma unroll
                for (int n = 0; n < 2; ++n) acc[ai][bj][m][n] = acc[ai][bj][m][n] * t.y + (c1v[bj][n] * tq + c2v[bj][n]); }
}

template <int RESMODE, bool HALFACC> struct EpiZ {
    static constexpr bool PERM = true, AFTER_DRAIN = false;
    const bf16_t* res; const float* stprev; const float* gamma; const float* beta; bf16_t* Z; float* ST; unsigned xlds; static constexpr float racc = HALFACC ? 0.5f : 1.0f;
    __device__ __forceinline__ void operator()(f32x4 (&acc)[2][2][4][2], const Unit& u, int wr, int wc, int fr, int fq) const {
        asm volatile("" : "+v"(fr), "+v"(fq));
        typedef float f32x2v __attribute__((ext_vector_type(2)));
        PG8_LAS f32x2v* P = (PG8_LAS f32x2v*)(size_t)xlds;
        const int rl0 = wr * 64 + fr, col0 = u.pn * BM + wc * 32 + 8 * fq;
        PG8_LAS f32x2t* T = (PG8_LAS f32x2t*)(size_t)(xlds + 8192);
        f32x4 gmm[2][2], btt[2][2];
        if (RESMODE == 1) {
#pragma unroll
            for (int bj = 0; bj < 2; ++bj) { const float* gp = gamma + col0 + bj * HALF; const float* bp = beta + col0 + bj * HALF;
                gmm[bj][0] = *(const f32x4*)gp; gmm[bj][1] = *(const f32x4*)(gp + 4); btt[bj][0] = *(const f32x4*)bp; btt[bj][1] = *(const f32x4*)(bp + 4); } }
        if (RESMODE == 1) panel_stats_to_lds(stprev, u.pm, T, (wr * 4 + wc) * 64 + fq * 16 + fr);
#pragma unroll
        for (int ai = 0; ai < 2; ++ai) {
            u32x4 raw[4][2];
#pragma unroll
            for (int m = 0; m < 4; ++m) { const size_t off = (size_t)(u.pm * BM + ai * HALF + m * 16 + rl0) * 1024 + col0;
                raw[m][0] = *(const u32x4*)(res + off); raw[m][1] = *(const u32x4*)(res + off + HALF); }
            __builtin_amdgcn_sched_barrier(0);
#pragma unroll
            for (int m = 0; m < 4; ++m) { const int rl = ai * HALF + m * 16 + rl0; const size_t off = (size_t)(u.pm * BM + rl) * 1024 + col0;
                float mu = 0.f, rs = 1.f; if (RESMODE == 1) { const f32x2t t = T[rl]; mu = t.x; rs = t.y; }
                float s = 0.f, q = 0.f;
#pragma unroll
                for (int bj = 0; bj < 2; ++bj) { const u32x4 rw = raw[m][bj];
                    f32x4 r0 = unpack4((u32x2){rw.x, rw.y}), r1 = unpack4((u32x2){rw.z, rw.w});
                    if (RESMODE == 1) { r0 = (r0 - mu) * rs * gmm[bj][0] + btt[bj][0]; r1 = (r1 - mu) * rs * gmm[bj][1] + btt[bj][1]; }
                    const f32x4 z0 = r0 * kAlpha + acc[ai][bj][m][0] * racc, z1 = r1 * kAlpha + acc[ai][bj][m][1] * racc;
                    *(u32x4*)(Z + off + bj * HALF) = pack8(z0, z1);
#pragma unroll
                    for (int i = 0; i < 4; ++i) { s += z0[i] + z1[i]; q += z0[i] * z0[i] + z1[i] * z1[i]; } }
                s += __shfl_xor(s, 16); s += __shfl_xor(s, 32); q += __shfl_xor(q, 16); q += __shfl_xor(q, 32);
                const float mw = s * (1.0f / 64.0f); q = fmaxf(q - s * mw, 0.f);
                if (fq == 0) P[rl * 4 + wc] = (f32x2v){mw, q}; }
            asm volatile("" ::: "memory"); }
        asm volatile("s_waitcnt lgkmcnt(0)" ::: "memory"); __builtin_amdgcn_s_barrier(); asm volatile("" ::: "memory");
        const int tid = (wr * 4 + wc) * 64 + fq * 16 + fr;
        if (tid < 256) { const f32x2v a = P[tid * 4 + 0], b = P[tid * 4 + 1], c = P[tid * 4 + 2], d = P[tid * 4 + 3];
            const float mt = ((a.x + b.x) + (c.x + d.x)) * 0.25f; const float da = a.x - mt, db = b.x - mt, dc = c.x - mt, dd = d.x - mt;
            const float m2 = ((a.y + b.y) + (c.y + d.y)) + 64.0f * ((da * da + db * db) + (dc * dc + dd * dd));
            *(f32x2v*)(ST + ((size_t)(u.pm * BM + tid) * 4 + u.pn) * 2) = (f32x2v){mt, m2}; }
        asm volatile("s_waitcnt lgkmcnt(0)" ::: "memory"); __builtin_amdgcn_s_barrier(); asm volatile("" ::: "memory");
    }
};

template <bool FOLD> struct EpiSwiGLU {
    static constexpr bool PERM = true, AFTER_DRAIN = false;
    bf16_t* H; int ldh; const float* st; const float* c1; const float* c2; unsigned tlds;
    __device__ __forceinline__ void operator()(f32x4 (&acc)[2][2][4][2], const Unit& u, int wr, int wc, int fr, int fq) const {
        asm volatile("" : "+v"(fr), "+v"(fq));
        const int row0 = u.pm * BM + wr * 64 + fr, col0 = u.pn * HALF + wc * 32 + 8 * fq;
        if (FOLD) fold_ln(acc, st, c1, c2, u, wr, wc, fr, fq, tlds);
#pragma unroll
        for (int ai = 0; ai < 2; ++ai)
#pragma unroll
            for (int m = 0; m < 4; ++m) {
                const f32x4 h0 = silu4(acc[ai][0][m][0]) * acc[ai][1][m][0], h1 = silu4(acc[ai][0][m][1]) * acc[ai][1][m][1];
                *(u32x4*)(H + (size_t)(row0 + ai * HALF + m * 16) * ldh + col0) = pack8(h0, h1);
            }
    }
};

struct EpiWin {
    static constexpr bool PERM = true, AFTER_DRAIN = false;
    bf16_t *U, *GV, *Q, *Kb, *VT, *QI, *KI; float *GVST, *WI, *outK, *outV, *outKI; const float *ropeC, *ropeS; const float *st, *c1, *c2; unsigned tlds; int pn_off;
    __device__ __forceinline__ void operator()(f32x4 (&acc)[2][2][4][2], const Unit& u, int wr, int wc, int fr, int fq) const {
        asm volatile("" : "+v"(fr), "+v"(fq));
        const int pn = u.pn + pn_off, rl0 = wr * 64 + fr, rowb = u.pm * BM + rl0, cl = wc * 32 + 8 * fq;
        const int j0 = 4 * (4 * (wc & 1) + fq);
        PG8_LAS f32x2t* T = (PG8_LAS f32x2t*)(size_t)tlds;
        const float* c1p = c1 + pn * BM + cl; const float* c2p = c2 + pn * BM + cl;
        const bool roped = pn >= 4;
        f32x4 cc1[2][2], cc2[2][2];
#pragma unroll
        for (int bj = 0; bj < 2; ++bj)
#pragma unroll
            for (int n = 0; n < 2; ++n) { cc1[bj][n] = *(const f32x4*)(c1p + bj * HALF + 4 * n); cc2[bj][n] = *(const f32x4*)(c2p + bj * HALF + 4 * n); }
        f32x4 rc = (f32x4){1.f, 1.f, 1.f, 1.f}, rsn = (f32x4){0.f, 0.f, 0.f, 0.f};
        if (roped) { const int t0 = rowb & 2047; rc = *(const f32x4*)(ropeC + t0 * 32 + j0); rsn = *(const f32x4*)(ropeS + t0 * 32 + j0); }
        __builtin_amdgcn_sched_barrier(0);
        panel_stats_to_lds(st, u.pm, T, (wr * 4 + wc) * 64 + fq * 16 + fr);
#define WIN_ROW(ai, m) const f32x2t tr_ = T[(ai) * HALF + (m) * 16 + rl0]; const float tq_ = -tr_.y * tr_.x
#define WIN_F(ai, bj, m, n) (acc[ai][bj][m][n] * tr_.y + (cc1[bj][n] * tq_ + cc2[bj][n]))
#define WIN_ROPE_NEXT(ai, m) const f32x4 c = rc, s = rsn; if ((ai) * 4 + (m) < 7) { const int gn_ = (ai) * 4 + (m) + 1; const int tn_ = (rowb + (gn_ >> 2) * HALF + (gn_ & 3) * 16) & 2047; \
            rc = *(const f32x4*)(ropeC + tn_ * 32 + j0); rsn = *(const f32x4*)(ropeS + tn_ * 32 + j0); } __builtin_amdgcn_sched_barrier(0)
        if (pn < 2) {
#pragma unroll
            for (int ai = 0; ai < 2; ++ai)
#pragma unroll
                for (int m = 0; m < 4; ++m) { WIN_ROW(ai, m); bf16_t* p = U + (size_t)(rowb + ai * HALF + m * 16) * 512 + pn * 256 + cl;
#pragma unroll
                    for (int bj = 0; bj < 2; ++bj) { const f32x4 x0 = WIN_F(ai, bj, m, 0), x1 = WIN_F(ai, bj, m, 1);
                        *(u32x4*)(p + bj * HALF) = pack8(gelu4(x0), gelu4(x1)); } }
        } else if (pn < 4) {
#pragma unroll
            for (int ai = 0; ai < 2; ++ai)
#pragma unroll
                for (int m = 0; m < 4; ++m) { WIN_ROW(ai, m); const size_t row = (size_t)(rowb + ai * HALF + m * 16); bf16_t* p = GV + row * 512 + (pn - 2) * 256 + cl;
                    f32x4 g[2][2]; float s = 0.f;
#pragma unroll
                    for (int bj = 0; bj < 2; ++bj) {
#pragma unroll
                        for (int n = 0; n < 2; ++n) { g[bj][n] = gelu4(WIN_F(ai, bj, m, n)); s += (g[bj][n][0] + g[bj][n][1]) + (g[bj][n][2] + g[bj][n][3]); }
                        *(u32x4*)(p + bj * HALF) = pack8(g[bj][0], g[bj][1]); }
                    s += __shfl_xor(s, 16); s += __shfl_xor(s, 32);
                    const float mw = s * (1.0f / 64.0f); float q = 0.f;
#pragma unroll
                    for (int bj = 0; bj < 2; ++bj)
#pragma unroll
                        for (int n = 0; n < 2; ++n)
#pragma unroll
                            for (int i = 0; i < 4; ++i) { const float d = g[bj][n][i] - mw; q += d * d; }
                    q += __shfl_xor(q, 16); q += __shfl_xor(q, 32);
                    if (fq == 0) *(f32x2t*)(GVST + ((row * 2 + (pn - 2)) * 4 + wc) * 2) = (f32x2t){mw, q}; }
        } else if (pn == 4 || pn == 5 || pn == 7) {
            bf16_t* dst = (pn == 7) ? QI : Q + (pn - 4) * 256; const int ld = (pn == 7) ? 256 : 512;
            const float qsc = (pn == 7) ? 1.0f : 0.125f * 1.4426950408889634f;
#pragma unroll
            for (int ai = 0; ai < 2; ++ai)
#pragma unroll
                for (int m = 0; m < 4; ++m) { WIN_ROW(ai, m); const int row = rowb + ai * HALF + m * 16; WIN_ROPE_NEXT(ai, m);
#pragma unroll
                    for (int bj = 0; bj < 2; ++bj) { const f32x4 x1 = WIN_F(ai, bj, m, 0), x2 = WIN_F(ai, bj, m, 1);
                        *(u32x4*)(dst + (size_t)row * ld + bj * HALF + cl) = pack8((x1 * c - x2 * s) * qsc, (x2 * c + x1 * s) * qsc); } }
        } else if (pn == 6) {
#pragma unroll
            for (int ai = 0; ai < 2; ++ai)
#pragma unroll
                for (int m = 0; m < 4; ++m) { WIN_ROW(ai, m); const int row = rowb + ai * HALF + m * 16; const int t = row & 2047; WIN_ROPE_NEXT(ai, m);
                    const f32x4 x1 = WIN_F(ai, 0, m, 0), x2 = WIN_F(ai, 0, m, 1); const f32x4 o1 = x1 * c - x2 * s, o2 = x2 * c + x1 * s;
                    *(u32x4*)(Kb + (size_t)row * 128 + cl) = pack8(o1, o2);
                    float* ok = outK + (size_t)row * 128 + (wc >> 1) * 64 + j0; *(f32x4*)ok = o1; *(f32x4*)(ok + 32) = o2;
                    const f32x4 v0 = WIN_F(ai, 1, m, 0), v1 = WIN_F(ai, 1, m, 1);
                    float* ov = outV + (size_t)row * 128 + cl; *(f32x4*)ov = v0; *(f32x4*)(ov + 4) = v1;
                    *(u32x4*)(VT + (size_t)row * 128 + cl) = pack8(v0, v1); }
        } else {
            if (wc < 2) {
#pragma unroll
                for (int ai = 0; ai < 2; ++ai)
#pragma unroll
                    for (int m = 0; m < 4; ++m) { WIN_ROW(ai, m); const int row = rowb + ai * HALF + m * 16; WIN_ROPE_NEXT(ai, m);
                        const f32x4 x1 = WIN_F(ai, 0, m, 0), x2 = WIN_F(ai, 0, m, 1); const f32x4 o1 = x1 * c - x2 * s, o2 = x2 * c + x1 * s;
                        *(u32x4*)(KI + (size_t)row * 64 + cl) = pack8(o1, o2);
                        float* ok = outKI + (size_t)row * 64 + j0; *(f32x4*)ok = o1; *(f32x4*)(ok + 32) = o2; }
            } else if (wc == 2 && fq == 0) {
#pragma unroll
                for (int ai = 0; ai < 2; ++ai)
#pragma unroll
                    for (int m = 0; m < 4; ++m) { WIN_ROW(ai, m); const int row = rowb + ai * HALF + m * 16; *(f32x4*)(WI + (size_t)row * 4) = WIN_F(ai, 0, m, 0) * 0.0625f; }
            }
        }
#undef WIN_ROPE_NEXT
        __builtin_amdgcn_s_waitcnt(0x0F70);
#undef WIN_ROW
#undef WIN_F
    }
};
}
constexpr int NWAVES = 8;
#ifndef MK_N_LAUNCHES
#define MK_N_LAUNCHES 1
#endif
constexpr int N_PHASES = 9;
constexpr int N_LAUNCHES = MK_N_LAUNCHES;

constexpr int DM = 1024, NB = 16, SEQ = 2048, MP = NB * SEQ, NS = 128, FF = 2816, INW = 2116, INWP = 2304, PAST = 8192, NPAGE = 64;
constexpr float LN_EPS = 1e-5f, kAlpha = pg8::kAlpha;
constexpr size_t OUT_Y = 0, OUT_YS = 33554432, OUT_KP = 33685504, OUT_VP = 37879808, OUT_KIP = 42074112, OUT_KS = 44171264, OUT_VS = 44187648, OUT_KIS = 44204032, OUT_AV = 44212224, OUT_TOTAL = 44277760;

constexpr size_t MiB = 1u << 20;
constexpr size_t WS_CTL = 0, CTL_ZERO_BYTES = 1 * MiB;
constexpr size_t WS_ROPEC = 1 * MiB, WS_ROPES = WS_ROPEC + 2049 * 32 * 4;
constexpr size_t WS_W1UP = 2 * MiB, WS_W1DN = 13 * MiB, WS_WIN = 19 * MiB, WS_WOUT = 24 * MiB, WS_W2UP = 26 * MiB, WS_W2DN = 37 * MiB;
constexpr size_t WS_XB = 64 * MiB;
constexpr size_t WS_H = 128 * MiB;
constexpr size_t WS_Z1 = 304 * MiB;
constexpr size_t WS_U = 368 * MiB;
constexpr size_t WS_GV = 400 * MiB;
constexpr size_t WS_GVST = 432 * MiB;
constexpr size_t WS_Q = 434 * MiB;
constexpr size_t WS_K = 466 * MiB;
constexpr size_t WS_VT = 474 * MiB;
constexpr size_t WS_QI = 482 * MiB;
constexpr size_t WS_KI = 498 * MiB;
constexpr size_t WS_WI = 502 * MiB;
constexpr size_t WS_MASK = 503 * MiB;
constexpr size_t WS_MIX = 512 * MiB;
constexpr size_t WS_Z2 = 576 * MiB;
constexpr size_t WS_SMP = 644 * MiB;
constexpr size_t SM_HS = WS_SMP, SM_Z1 = SM_HS + 128 * 2816 * 4, SM_ST1 = SM_Z1 + 128 * 1024 * 4, SM_US = SM_ST1 + 128 * 64 * 8, SM_GVS = SM_US + 128 * 512 * 4,
                 SM_QS = SM_GVS + 128 * 512 * 4, SM_QIS = SM_QS + 128 * 512 * 4, SM_WIS = SM_QIS + 128 * 256 * 4, SM_MIXS = SM_WIS + 128 * 4 * 4, SM_Z2 = SM_MIXS + 128 * 1024 * 4,
                 SM_ST2 = SM_Z2 + 128 * 1024 * 4, SM_Z3 = SM_ST2 + 128 * 64 * 8, SM_XSB = SM_Z3 + 128 * 1024 * 4, SM_MIXSB = SM_XSB + 128 * 1024 * 2, SM_Z1B = SM_MIXSB + 128 * 1024 * 2, SM_Z2B = SM_Z1B + 128 * 1024 * 2, SM_END = SM_Z2B + 128 * 1024 * 2;
constexpr size_t WS_Z3 = 304 * MiB;
constexpr size_t WS_STZ3 = 651 * MiB;
constexpr size_t WS_STZ1 = 652 * MiB, WS_STZ2 = 653 * MiB;
constexpr size_t WS_PS = 654 * MiB;
constexpr size_t PS_IN = WS_PS, PS_UP = WS_PS + 2 * 16 * 2304 * 4;
constexpr size_t WS_CV = 656 * MiB;
constexpr size_t CV_C1IN = WS_CV, CV_C2IN = CV_C1IN + 2304 * 4, CV_C1UP = CV_C2IN + 2304 * 4, CV_C2UP = CV_C1UP + 5632 * 4;
constexpr size_t WS_AWSB = 657 * MiB;
constexpr size_t WS_END = 658 * MiB;
static_assert(SM_END <= WS_END, "d_ws map");
constexpr int CW_TMO = 0, CW_CODE = 1;
constexpr int CW_BAR = 4096;
constexpr int CW_QUEUE = 64;

constexpr int RING_OFF = 0, RING_BYTES = 147968;
constexpr int XLDS_OFF = 131072;
constexpr int LDSCTL_OFF = RING_BYTES, MISC_OFF = LDSCTL_OFF + 320;
constexpr int LDS_BYTES = 163840;
static_assert(MISC_OFF + 128 <= LDS_BYTES, "LDS map");
#define GAS __attribute__((address_space(1)))
#define LAS __attribute__((address_space(3)))
typedef unsigned short bf16;
typedef unsigned v4u __attribute__((ext_vector_type(4)));
typedef float f32x4 __attribute__((ext_vector_type(4)));
typedef short bf16x8 __attribute__((ext_vector_type(8)));
typedef GAS unsigned gu32;
typedef GAS unsigned long long gu64;
#define RLX_AGENT __ATOMIC_RELAXED, __HIP_MEMORY_SCOPE_AGENT
#define LDS_WAIT() asm volatile("s_waitcnt lgkmcnt(0)" ::: "memory")
#define VM_WAIT() asm volatile("s_waitcnt vmcnt(0)" ::: "memory")
__device__ __forceinline__ unsigned long long rt() { return __builtin_amdgcn_s_memrealtime(); }
__device__ __forceinline__ unsigned f2bf(float f) { unsigned u = __builtin_bit_cast(unsigned, f); return (u + 0x7fffu + ((u >> 16) & 1u)) >> 16; }
__device__ __forceinline__ unsigned pk2(float lo, float hi) { return f2bf(lo) | (f2bf(hi) << 16); }

#define XB_TMO      128
#define XB_XCNT(j)  (256  + 64 * (j))
#define XB_XSUB(j)  (1280 + 64 * (j))
#define XB_XGEN(j)  (2304 + 64 * (j))
#define XB_TOP      3328
#define XB_TOPGEN   3392
#define XCD_BAR_WORDS 3456
#define XB_SPIN_CAP (1u << 18)

__device__ __forceinline__ unsigned xb_ld(unsigned* p)              { return __hip_atomic_load(p, __ATOMIC_RELAXED, __HIP_MEMORY_SCOPE_AGENT); }
__device__ __forceinline__ unsigned xb_add(unsigned* p, unsigned v) { return __hip_atomic_fetch_add(p, v, __ATOMIC_RELAXED, __HIP_MEMORY_SCOPE_AGENT); }
__device__ __forceinline__ unsigned xb_xcc_id() { return (unsigned)__builtin_amdgcn_s_getreg((3 << 11) | 20) & 0xFu; }
#define XB_SPIN(cond, bar) do { unsigned _sp = 0; while (cond) { __builtin_amdgcn_s_sleep(1); \
    if ((++_sp & 255u) == 0u) { if (xb_ld(&(bar)[XB_TMO])) break; if (_sp > XB_SPIN_CAP) { atomicAdd(&(bar)[XB_TMO], 1u); break; } } } } while (0)

struct XcdBarrier {
    unsigned* bar; unsigned x;
    volatile LAS unsigned* st;
};

__device__ __forceinline__ XcdBarrier xcd_barrier_post(unsigned* bar, volatile LAS unsigned* st) {
    XcdBarrier b; b.bar = bar; b.x = xb_xcc_id(); b.st = st;
    if (threadIdx.x == 0) (void)xb_add(&bar[XB_XCNT(b.x)], 1u);
    return b;
}
__device__ __forceinline__ void xcd_barrier_complete(unsigned* bar, unsigned x, unsigned& nloc, unsigned& nx) {
    const unsigned G = gridDim.x * gridDim.y * gridDim.z;
    unsigned sum, cnt, mine, sp = 0u;
    for (;;) {
        sum = 0u; cnt = 0u; mine = 0u;
#pragma unroll
        for (unsigned j = 0; j < 16; ++j) { const unsigned c = xb_ld(&bar[XB_XCNT(j)]); sum += c; cnt += (c > 0u) ? 1u : 0u; mine = (j == x) ? c : mine; }
        if (sum == G) break;
        __builtin_amdgcn_s_sleep(1);
        if ((++sp & 255u) == 0u) { if (xb_ld(&bar[XB_TMO])) break; if (sp > XB_SPIN_CAP) { atomicAdd(&bar[XB_TMO], 1u); break; } }
    }
    nloc = mine > 0u ? mine : 1u; nx = cnt > 0u ? cnt : 1u;
}

__device__ __forceinline__ void xcd_barrier(const XcdBarrier& b) {
    asm volatile("s_waitcnt vmcnt(0)" ::: "memory");
    __syncthreads();
    if (threadIdx.x == 0) {
        unsigned* bar = b.bar;
        __builtin_amdgcn_s_waitcnt(0);
        unsigned nloc = b.st[0], nx = b.st[1];
        if (nloc == 0u) { xcd_barrier_complete(bar, b.x, nloc, nx); b.st[0] = nloc; b.st[1] = nx; }
        const unsigned old = xb_add(&bar[XB_XSUB(b.x)], 1u);
        const unsigned gen = old / nloc;
        if (old + 1u == (gen + 1u) * nloc) {
            __builtin_amdgcn_fence(__ATOMIC_RELEASE, "agent");
            asm volatile("s_waitcnt vmcnt(0)" ::: "memory");
            const unsigned og = xb_add(&bar[XB_TOP], 1u);
            const unsigned tg = og / nx;
            if (og + 1u == (tg + 1u) * nx) xb_add(&bar[XB_TOPGEN], 1u);
            else XB_SPIN(xb_ld(&bar[XB_TOPGEN]) == tg, bar);
            __builtin_amdgcn_fence(__ATOMIC_ACQUIRE, "agent");
            xb_add(&bar[XB_XGEN(b.x)], 1u);
            asm volatile("s_waitcnt vmcnt(0)" ::: "memory");
        } else {
            XB_SPIN(xb_ld(&bar[XB_XGEN(b.x)]) == gen, bar);
            __builtin_amdgcn_fence(__ATOMIC_ACQUIRE, "agent");
            asm volatile("s_waitcnt vmcnt(0)" ::: "memory");
        }
    }
    __syncthreads();
}
typedef float f32x2 __attribute__((ext_vector_type(2)));
typedef unsigned u32x2 __attribute__((ext_vector_type(2)));
typedef float f32x16 __attribute__((ext_vector_type(16)));
struct Frame {
    LAS unsigned char* lds;
    volatile LAS unsigned* MISC;
    gu32* ctl;
    int tid, lane, wave, vcu, G;
    float* out; unsigned char* ws;
};
struct Args { const void* in[22]; float* out; unsigned char* ws; int ph_lo, ph_hi; };
#define IN_F(k) ((const float*)A.in[k])
__device__ __forceinline__ const float* in_lds(const Frame& F, int k) {
    const volatile LAS unsigned* t = (const volatile LAS unsigned*)(F.lds + LDSCTL_OFF);
    const unsigned lo = (unsigned)__builtin_amdgcn_readfirstlane((int)t[2 * k]), hi = (unsigned)__builtin_amdgcn_readfirstlane((int)t[2 * k + 1]);
    return (const float*)(const GAS float*)(((unsigned long long)hi << 32) | lo);
}
#define IN_L(k) in_lds(F, k)
__device__ __forceinline__ void launder(Frame& F) { unsigned long long w = (unsigned long long)F.ws, o = (unsigned long long)F.out; int t = F.tid, l = F.lane, wv = F.wave; asm volatile("" : "+s"(w), "+s"(o), "+v"(t), "+v"(l), "+s"(wv));
    F.ws = (unsigned char*)(GAS unsigned char*)w; F.out = (float*)(GAS float*)o; F.tid = t; F.lane = l; F.wave = wv; }
enum { I_XP = 0, I_XS, I_CK, I_CV, I_CKI, I_PT, I_LN1G, I_LN1B, I_W1UP, I_W1DN, I_LN2G, I_LN2B, I_WIN, I_ALNG, I_ALNB, I_AWS, I_ABS, I_WOUT, I_LN3G, I_LN3B, I_W2UP, I_W2DN };

__device__ __forceinline__ float wave_sum(float v) {
#pragma unroll
    for (int o = 1; o < 64; o <<= 1) v += __shfl_xor(v, o);
    return v;
}
__device__ __forceinline__ float wave_max(float v) {
#pragma unroll
    for (int o = 1; o < 64; o <<= 1) v = fmaxf(v, __shfl_xor(v, o));
    return v;
}
__device__ __forceinline__ f32x4 mfma16(const bf16x8 a, const bf16x8 b, const f32x4 c) { return __builtin_amdgcn_mfma_f32_16x16x32_bf16(a, b, c, 0, 0, 0); }
__device__ __forceinline__ f32x16 mfma32(const bf16x8 a, const bf16x8 b, const f32x16 c) { return __builtin_amdgcn_mfma_f32_32x32x16_bf16(a, b, c, 0, 0, 0); }
__device__ __forceinline__ bf16x8 as_bf16x8(const v4u w) { return __builtin_bit_cast(bf16x8, w); }

template <int MODE> __device__ __forceinline__ int dest_row(int n) {
    if (MODE == 1) { const int half = n >= FF ? 1 : 0, j = n - half * FF; return 256 * (j >> 7) + 128 * half + (j & 127); }
    if (MODE == 2) { const bool rp = (n >= 1024 && n < 1664) || (n >= 1792 && n < 2112);
        if (rp) { const int base = n & ~63, cc = n & 63; return base + 8 * ((cc & 31) >> 2) + 4 * (cc >> 5) + (cc & 3); }
        return n; }
    return n;
}
template <int MODE, bool FOLD> __device__ __forceinline__ void p0_item(const float* W, int K, int N, int Npad, bf16* WT, LAS float* scr, int item, int lane, const float* gamma, const float* beta, float* ps1, float* ps2) {
    const int nblk = Npad / 32, kb = item / nblk, nb = item % nblk, k0 = 64 * kb, n0 = 32 * nb;
    const int nsrc = n0 + (lane & 31); const bool ok = nsrc < N;
    { float wv[32];
#pragma unroll
      for (int i = 0; i < 32; ++i) { const int kk = 2 * i + (lane >> 5); wv[i] = ok ? __builtin_nontemporal_load(W + (size_t)(k0 + kk) * N + nsrc) : 0.f; }
      __builtin_amdgcn_sched_barrier(0);
#pragma unroll
      for (int i = 0; i < 32; ++i) { const int kk = 2 * i + (lane >> 5); scr[kk * 33 + (lane & 31)] = wv[i]; } }
    LDS_WAIT(); asm volatile("" ::: "memory");
    const int c = lane & 7;
    f32x4 g0 = (f32x4){1.f, 1.f, 1.f, 1.f}, g1 = g0, b0 = (f32x4){0.f, 0.f, 0.f, 0.f}, b1 = b0;
    if (FOLD) { g0 = *(const f32x4*)(gamma + k0 + 8 * c); g1 = *(const f32x4*)(gamma + k0 + 8 * c + 4); b0 = *(const f32x4*)(beta + k0 + 8 * c); b1 = *(const f32x4*)(beta + k0 + 8 * c + 4); }
#pragma unroll
    for (int j = 0; j < 4; ++j) { const int n = (lane >> 3) + 8 * j; const LAS float* s = scr + (8 * c) * 33 + n;
        const float w0 = s[0 * 33], w1 = s[1 * 33], w2 = s[2 * 33], w3 = s[3 * 33], w4 = s[4 * 33], w5 = s[5 * 33], w6 = s[6 * 33], w7 = s[7 * 33];
        v4u o; o.x = pk2(w0 * g0[0], w1 * g0[1]); o.y = pk2(w2 * g0[2], w3 * g0[3]); o.z = pk2(w4 * g1[0], w5 * g1[1]); o.w = pk2(w6 * g1[2], w7 * g1[3]);
        const int dr = dest_row<MODE>(n0 + n);
        *(GAS v4u*)(WT + (size_t)dr * K + k0 + 8 * c) = o;
        if (FOLD) {
            float s1 = ((__uint_as_float(o.x << 16) + __uint_as_float(o.x & 0xffff0000u)) + (__uint_as_float(o.y << 16) + __uint_as_float(o.y & 0xffff0000u)))
                     + ((__uint_as_float(o.z << 16) + __uint_as_float(o.z & 0xffff0000u)) + (__uint_as_float(o.w << 16) + __uint_as_float(o.w & 0xffff0000u)));
            float s2 = ((w0 * b0[0] + w1 * b0[1]) + (w2 * b0[2] + w3 * b0[3])) + ((w4 * b1[0] + w5 * b1[1]) + (w6 * b1[2] + w7 * b1[3]));
            s1 += __shfl_xor(s1, 1); s1 += __shfl_xor(s1, 2); s1 += __shfl_xor(s1, 4); s2 += __shfl_xor(s2, 1); s2 += __shfl_xor(s2, 2); s2 += __shfl_xor(s2, 4);
            if (c == 0) { ps1[(size_t)kb * Npad + dr] = s1; ps2[(size_t)kb * Npad + dr] = s2; }
        } }
    LDS_WAIT(); asm volatile("" ::: "memory");
}
__device__ const float ROPE_INV[32] = {
    1.0f, 0.7498942093324559f, 0.5623413251903491f, 0.4216965034285822f, 0.31622776601683794f, 0.23713737056616552f, 0.1778279410038923f, 0.1333521432163324f,
    0.1f, 0.07498942093324559f, 0.05623413251903491f, 0.04216965034285822f, 0.03162277660168379f, 0.023713737056616554f, 0.01778279410038923f, 0.01333521432163324f,
    0.01f, 0.007498942093324558f, 0.005623413251903491f, 0.004216965034285822f, 0.0031622776601683794f, 0.0023713737056616554f, 0.0017782794100389228f, 0.001333521432163324f,
    0.001f, 0.0007498942093324559f, 0.0005623413251903491f, 0.00042169650342858224f, 0.00031622776601683794f, 0.00023713737056616554f, 0.00017782794100389227f, 0.0001333521432163324f };
__device__ __forceinline__ void p0_prologue(Frame& F, const Args& A) {
    LAS float* scr = (LAS float*)(F.lds + RING_OFF + F.wave * 16384);
    const int gw = F.vcu * NWAVES + F.wave, NGW = F.G * NWAVES;
    unsigned char* ws = F.ws;
    constexpr int I_UP = (DM / 64) * (2 * FF / 32), I_DN = (FF / 64) * (DM / 32), I_IN = (DM / 64) * (INWP / 32);
    constexpr int NITEMS = I_UP + I_DN + I_IN;
    for (int it = gw; it < NITEMS; it += NGW) {
        int r = it;
        if (r < I_UP) { p0_item<1, false>(IN_F(I_W1UP), DM, 2 * FF, 2 * FF, (bf16*)(ws + WS_W1UP), scr, r, F.lane, nullptr, nullptr, nullptr, nullptr); continue; } r -= I_UP;
        if (r < I_DN) { p0_item<0, false>(IN_F(I_W1DN), FF, DM, DM, (bf16*)(ws + WS_W1DN), scr, r, F.lane, nullptr, nullptr, nullptr, nullptr); continue; } r -= I_DN;
        p0_item<2, true>(IN_F(I_WIN), DM, INW, INWP, (bf16*)(ws + WS_WIN), scr, r, F.lane, IN_F(I_LN1G), IN_F(I_LN1B), (float*)(ws + PS_IN), (float*)(ws + PS_IN) + 16 * INWP);
    }
    { const size_t gt = (size_t)F.vcu * (NWAVES * 64) + F.tid, NT = (size_t)F.G * NWAVES * 64; const float* x = IN_F(I_XP); bf16* xb = (bf16*)(ws + WS_XB);
      static_assert(((size_t)MP * DM / 8) % ((size_t)256 * NWAVES * 64 * 8) == 0, "x conversion: whole batches of 8 per thread on a 256-workgroup grid");
      for (size_t e0 = gt; e0 < (size_t)MP * DM / 8; e0 += 8 * NT) {
          f32x4 a[8], b[8];
#pragma unroll
          for (int i = 0; i < 8; ++i) { const size_t e = e0 + (size_t)i * NT; if (e < (size_t)MP * DM / 8) { a[i] = __builtin_nontemporal_load((const f32x4*)(x + e * 8)); b[i] = __builtin_nontemporal_load((const f32x4*)(x + e * 8 + 4)); } }
          __builtin_amdgcn_sched_barrier(0);
#pragma unroll
          for (int i = 0; i < 8; ++i) { const size_t e = e0 + (size_t)i * NT; if (e < (size_t)MP * DM / 8) {
              v4u o; o.x = pk2(a[i][0], a[i][1]); o.y = pk2(a[i][2], a[i][3]); o.z = pk2(b[i][0], b[i][1]); o.w = pk2(b[i][2], b[i][3]); *(GAS v4u*)(xb + e * 8) = o; } } } }
    { const int gt = F.vcu * (NWAVES * 64) + F.tid; const float* x = IN_F(I_XS); bf16* xb = (bf16*)(ws + SM_XSB);
      if (gt < NS * DM / 8) { const f32x4 a = *(const GAS f32x4*)(x + gt * 8), b = *(const GAS f32x4*)(x + gt * 8 + 4);
          v4u o; o.x = pk2(a[0], a[1]); o.y = pk2(a[2], a[3]); o.z = pk2(b[0], b[1]); o.w = pk2(b[2], b[3]); *(GAS v4u*)(xb + gt * 8) = o; } }
    { const int gt = F.vcu * (NWAVES * 64) + F.tid; if (gt < 4 * 128 * 128) { const int t = (gt >> 7) & 127, s = gt & 127; const float v = IN_F(I_AWS)[gt];
          ((bf16*)(ws + WS_AWSB))[gt] = (bf16)f2bf((s > t) ? 0.f : v); } }
    { const int gt = F.vcu * (NWAVES * 64) + F.tid, NT = F.G * NWAVES * 64; float* rc = (float*)(ws + WS_ROPEC); float* rs = (float*)(ws + WS_ROPES);
      for (int e = gt; e < 2049 * 32; e += NT) { const int t = e >> 5, j = e & 31; const float pos = (t == 2048) ? 8192.f : (float)t; const float ang = pos * ROPE_INV[j];
          double rev = (double)ang * 0.15915494309189535; rev -= __builtin_floor(rev); const float fr = (float)rev;
          rc[e] = __builtin_amdgcn_cosf(fr); rs[e] = __builtin_amdgcn_sinf(fr); } }
}

__device__ __forceinline__ void p0_wout(Frame& F, const Args& A, int rank, int nrank) {
    launder(F); unsigned char* ws = F.ws; LAS float* scr = (LAS float*)(F.lds + RING_OFF + F.wave * 16384);
    constexpr int I_OUT = (DM / 64) * (DM / 32);
    for (int it = rank * NWAVES + F.wave; it < I_OUT; it += nrank * NWAVES) p0_item<0, false>(IN_L(I_WOUT), DM, DM, DM, (bf16*)(ws + WS_WOUT), scr, it, F.lane, nullptr, nullptr, nullptr, nullptr);
}
constexpr int LATE_ITEMS = (DM / 64) * (2 * FF / 32) + (FF / 64) * (DM / 32), LATE_UNITS = LATE_ITEMS / NWAVES;
static_assert(LATE_ITEMS % NWAVES == 0, "late weight units");
__device__ __forceinline__ void late_weight_unit(Frame& F, const Args& A, int unit) {
    launder(F); unsigned char* ws = F.ws; LAS float* scr = (LAS float*)(F.lds + RING_OFF + F.wave * 16384);
    constexpr int I_UP = (DM / 64) * (2 * FF / 32);
    const int r = unit * NWAVES + F.wave;
    if (r < I_UP) p0_item<1, true>(IN_L(I_W2UP), DM, 2 * FF, 2 * FF, (bf16*)(ws + WS_W2UP), scr, r, F.lane, IN_L(I_LN2G), IN_L(I_LN2B), (float*)(ws + PS_UP), (float*)(ws + PS_UP) + 16 * 2 * FF);
    else p0_item<0, false>(IN_L(I_W2DN), FF, DM, DM, (bf16*)(ws + WS_W2DN), scr, r - I_UP, F.lane, nullptr, nullptr, nullptr, nullptr);
    __syncthreads();
}
__device__ __forceinline__ void finalize_cvec(Frame& F, int sel) {
    unsigned char* ws = F.ws; const int gt = F.vcu * (NWAVES * 64) + F.tid + (sel ? 2 * INWP : 0);
    if (sel == 0 && gt >= 2 * INWP) return;
    if (gt < 2 * INWP) { const int which = gt / INWP, n = gt % INWP; const float* p = (const float*)(ws + PS_IN) + (size_t)which * 16 * INWP + n; float s = 0.f;
#pragma unroll
        for (int kb = 0; kb < 16; ++kb) s += p[(size_t)kb * INWP];
        ((float*)(ws + (which ? CV_C2IN : CV_C1IN)))[n] = s; }
    else if (gt < 2 * INWP + 4 * FF) { const int g2 = gt - 2 * INWP, which = g2 / (2 * FF), n = g2 % (2 * FF); const float* p = (const float*)(ws + PS_UP) + (size_t)which * 16 * 2 * FF + n; float s = 0.f;
#pragma unroll
        for (int kb = 0; kb < 16; ++kb) s += p[(size_t)kb * 2 * FF];
        ((float*)(ws + (which ? CV_C2UP : CV_C1UP)))[n] = s; }
}

constexpr int TH_RED = 0, TH_STAT = 131072;
__device__ __forceinline__ void thin_rowstats(const float* stat, int row, int fq, float& mean, float& rstd) {
    float s = 0.f, q = 0.f; const f32x4* p = (const f32x4*)((const f32x2*)stat + row * 64 + fq * 16);
    f32x4 v8[8];
#pragma unroll
    for (int i = 0; i < 8; ++i) v8[i] = p[i];
    __builtin_amdgcn_sched_barrier(0);
#pragma unroll
    for (int i = 0; i < 8; ++i) { s += v8[i][0] + v8[i][2]; q += v8[i][1] + v8[i][3]; }
    s += __shfl_xor(s, 16); s += __shfl_xor(s, 32); q += __shfl_xor(q, 16); q += __shfl_xor(q, 32);
    mean = s * (1.f / 1024.f); const float var = fmaxf(q * (1.f / 1024.f) - mean * mean, 0.f); rstd = 1.0f / sqrtf(var + LN_EPS);
}
__device__ __forceinline__ void thin_putstat(float* stat, int row, int unit, int fq, const f32x4 z) {
    float s = (z[0] + z[1]) + (z[2] + z[3]), q = (z[0] * z[0] + z[1] * z[1]) + (z[2] * z[2] + z[3] * z[3]);
    s += __shfl_xor(s, 16); s += __shfl_xor(s, 32); q += __shfl_xor(q, 16); q += __shfl_xor(q, 32);
    if (fq == 0) ((f32x2*)stat)[row * 64 + unit] = (f32x2){s, q};
}
template <int K, int NBR> __device__ __forceinline__ void thin_gemm(Frame& F, f32x4 (&out)[NBR], const bf16* Asrc, const bf16* const (&brow)[NBR]) {
    const int lane = F.lane, fr = lane & 15, fq = lane >> 4, w = F.wave;
    constexpr int KS = K / 8; static_assert(KS % 32 == 0, "K slice");
    f32x4 acc[8][NBR];
#pragma unroll
    for (int rt = 0; rt < 8; ++rt)
#pragma unroll
        for (int nb = 0; nb < NBR; ++nb) acc[rt][nb] = (f32x4){0.f, 0.f, 0.f, 0.f};
    constexpr int NSTEP = KS / 32, BATCH = (K == DM) ? 2 : 4;
#pragma unroll 1
    for (int s0 = 0; s0 < NSTEP; s0 += BATCH) {
        bf16x8 bf[BATCH][NBR], af[BATCH][8];
#pragma unroll
        for (int bi = 0; bi < BATCH; ++bi) if (s0 + bi < NSTEP) { const int k0 = w * KS + 32 * (s0 + bi) + 8 * fq;
#pragma unroll
            for (int nb = 0; nb < NBR; ++nb) bf[bi][nb] = *(const bf16x8*)(brow[nb] + k0);
#pragma unroll
            for (int rt = 0; rt < 8; ++rt) af[bi][rt] = *(const bf16x8*)(Asrc + (size_t)(16 * rt + fr) * K + k0); }
        __builtin_amdgcn_sched_barrier(0);
#pragma unroll
        for (int bi = 0; bi < BATCH; ++bi) if (s0 + bi < NSTEP) {
#pragma unroll
            for (int rt = 0; rt < 8; ++rt)
#pragma unroll
                for (int nb = 0; nb < NBR; ++nb) acc[rt][nb] = mfma16(bf[bi][nb], af[bi][rt], acc[rt][nb]); }
        __builtin_amdgcn_sched_barrier(0);
    }
    LAS f32x4* red = (LAS f32x4*)(F.lds + RING_OFF + TH_RED);
#pragma unroll
    for (int rt = 0; rt < 8; ++rt)
#pragma unroll
        for (int nb = 0; nb < NBR; ++nb) red[((nb * 8 + w) * 128 + 16 * rt + fr) * 4 + fq] = acc[rt][nb];
    __syncthreads();
#pragma unroll
    for (int nb = 0; nb < NBR; ++nb) { f32x4 s = red[((nb * 8 + 0) * 128 + 16 * w + fr) * 4 + fq];
#pragma unroll
        for (int ws = 1; ws < 8; ++ws) s = s + red[((nb * 8 + ws) * 128 + 16 * w + fr) * 4 + fq];
        out[nb] = s; }
    __syncthreads();
}
template <int STAGE> __device__ __forceinline__ void thin_stage(Frame& F, const Args& A, int unit0, int ustride) {
    launder(F); unsigned char* ws = F.ws; const int lane = F.lane, fr = lane & 15, fq = lane >> 4, w = F.wave; const int row = 16 * w + fr;
    constexpr int NU = (STAGE == 1 || STAGE == 7) ? FF / 16 : (STAGE == 3) ? (INW + 15) / 16 : DM / 16;
    bf16* HSB = (bf16*)(ws + SM_HS); float* Z1 = (float*)(ws + SM_Z1); float* ST1 = (float*)(ws + SM_ST1); float* Z2 = (float*)(ws + SM_Z2); float* ST2 = (float*)(ws + SM_ST2); float* Z3 = (float*)(ws + SM_Z3);
    if (unit0 < 0 || unit0 >= NU) return;
    float mean = 0.f, rstd = 1.f, mean1 = 0.f, rstd1 = 1.f;
    if (STAGE == 3 || STAGE == 6) thin_rowstats(ST1, row, fq, mean1, rstd1);
    if (STAGE == 7 || STAGE == 8) thin_rowstats(ST2, row, fq, mean, rstd);
    for (int unit = unit0; unit < NU; unit += ustride) {
        const int c0 = 16 * unit + 4 * fq;
        if (STAGE == 1 || STAGE == 7) {
            const bf16* Bt = (const bf16*)(ws + (STAGE == 1 ? WS_W1UP : WS_W2UP));
            const int rg = 256 * (unit >> 3) + 16 * (unit & 7) + fr;
            const bf16* const brow[2] = {Bt + (size_t)rg * DM, Bt + (size_t)(rg + 128) * DM};
            f32x4 acc[2]; f32x4 c1g = (f32x4){0.f, 0.f, 0.f, 0.f}, c1u = c1g, c2g = c1g, c2u = c1g;
            if (STAGE == 7) { const float* c1 = (const float*)(ws + CV_C1UP) + 256 * (unit >> 3) + 16 * (unit & 7) + 4 * fq; const float* c2 = (const float*)(ws + CV_C2UP) + 256 * (unit >> 3) + 16 * (unit & 7) + 4 * fq;
                c1g = *(const f32x4*)c1; c1u = *(const f32x4*)(c1 + 128); c2g = *(const f32x4*)c2; c2u = *(const f32x4*)(c2 + 128); }
            thin_gemm<DM, 2>(F, acc, (const bf16*)(ws + (STAGE == 1 ? SM_XSB : SM_Z2B)), brow);
            if (STAGE == 7) { const float rm = -rstd * mean;
                acc[0] = acc[0] * rstd + (c1g * rm + c2g); acc[1] = acc[1] * rstd + (c1u * rm + c2u); }
            f32x4 h;
#pragma unroll
            for (int i = 0; i < 4; ++i) h[i] = pg8::silu_f(acc[0][i]) * acc[1][i];
            u32x2 o; o.x = pk2(h[0], h[1]); o.y = pk2(h[2], h[3]); *(u32x2*)(HSB + (size_t)row * FF + c0) = o;
        } else if (STAGE == 2 || STAGE == 8) {
            const bf16* Bt = (const bf16*)(ws + (STAGE == 2 ? WS_W1DN : WS_W2DN));
            const bf16* const brow[1] = {Bt + (size_t)(16 * unit + fr) * FF};
            f32x4 acc[1];
            thin_gemm<FF, 1>(F, acc, HSB, brow);
            f32x4 res = *(const f32x4*)((STAGE == 2 ? IN_L(I_XS) : (const float*)Z2) + (size_t)row * DM + c0);
            if (STAGE == 8) res = (res - mean) * rstd * *(const f32x4*)(IN_L(I_LN2G) + c0) + *(const f32x4*)(IN_L(I_LN2B) + c0);
            const f32x4 z = res * kAlpha + acc[0] * 0.5f;
            *(f32x4*)((STAGE == 2 ? Z1 : Z3) + (size_t)row * DM + c0) = z;
            if (STAGE == 2) { thin_putstat(ST1, row, unit, fq, z); u32x2 o; o.x = pk2(z[0], z[1]); o.y = pk2(z[2], z[3]); *(u32x2*)((bf16*)(ws + SM_Z1B) + (size_t)row * DM + c0) = o; }
        } else if (STAGE == 6) {
            const bf16* Bt = (const bf16*)(ws + WS_WOUT);
            const bf16* const brow[1] = {Bt + (size_t)(16 * unit + fr) * DM};
            f32x4 acc[1];
            const f32x4 z1 = *(const f32x4*)(Z1 + (size_t)row * DM + c0);
            thin_gemm<DM, 1>(F, acc, (const bf16*)(ws + SM_MIXSB), brow);
            const f32x4 x1 = (z1 - mean1) * rstd1 * *(const f32x4*)(IN_L(I_LN1G) + c0) + *(const f32x4*)(IN_L(I_LN1B) + c0);
            const f32x4 z = x1 * kAlpha + acc[0];
            *(f32x4*)(Z2 + (size_t)row * DM + c0) = z;
            thin_putstat(ST2, row, unit, fq, z); { u32x2 o; o.x = pk2(z[0], z[1]); o.y = pk2(z[2], z[3]); *(u32x2*)((bf16*)(ws + SM_Z2B) + (size_t)row * DM + c0) = o; }
        } else {
            const bf16* Bt = (const bf16*)(ws + WS_WIN);
            const bf16* const brow[1] = {Bt + (size_t)(16 * unit + fr) * DM};
            f32x4 acc[1];
            const f32x4 c1v = *(const f32x4*)((const float*)(ws + CV_C1IN) + c0), c2v = *(const f32x4*)((const float*)(ws + CV_C2IN) + c0);
            thin_gemm<DM, 1>(F, acc, (const bf16*)(ws + SM_Z1B), brow);
            const f32x4 v = acc[0] * rstd1 + (c1v * (-rstd1 * mean1) + c2v);
            const bool roped = (c0 >= 1024 && c0 < 1664) || (c0 >= 1792 && c0 < 2112);
            f32x4 pr;
#pragma unroll
            for (int i = 0; i < 4; ++i) pr[i] = __shfl_xor(v[i], 16);
            if (c0 < 512) { f32x4 o;
#pragma unroll
                for (int i = 0; i < 4; ++i) o[i] = pg8::gelu_f(v[i]);
                *(f32x4*)((float*)(ws + SM_US) + (size_t)row * 512 + c0) = o;
            } else if (c0 < 1024) { f32x4 o;
#pragma unroll
                for (int i = 0; i < 4; ++i) o[i] = pg8::gelu_f(v[i]);
                *(f32x4*)((float*)(ws + SM_GVS) + (size_t)row * 512 + (c0 - 512)) = o;
            } else if (roped) {
                const int base = c0 & ~63, p = c0 & 63, g = p >> 3, n = (p >> 2) & 1;
                const f32x4 c = *(const f32x4*)((const float*)(ws + WS_ROPEC) + 2048 * 32 + 4 * g), s = *(const f32x4*)((const float*)(ws + WS_ROPES) + 2048 * 32 + 4 * g);
                const f32x4 o = n ? (v * c + pr * s) : (v * c - pr * s);
                const int oc = base + 32 * n + 4 * g;
                float* dst;
                if (oc < 1536) dst = (float*)(ws + SM_QS) + (size_t)row * 512 + (oc - 1024);
                else if (oc < 1664) dst = F.out + OUT_KS + (size_t)row * 128 + (oc - 1536);
                else if (oc < 2048) dst = (float*)(ws + SM_QIS) + (size_t)row * 256 + (oc - 1792);
                else dst = F.out + OUT_KIS + (size_t)row * 64 + (oc - 2048);
                *(f32x4*)dst = o;
            } else if (c0 < 1792) { *(f32x4*)(F.out + OUT_VS + (size_t)row * 128 + (c0 - 1664)) = v;
            } else if (c0 == 2112) { *(f32x4*)((float*)(ws + SM_WIS) + (size_t)row * 4) = v * 0.0625f; }
        }
    }
}
__device__ __forceinline__ void thin_final_ln(Frame& F, const Args& A) {
    const int gw = (F.G - 1 - F.vcu) * NWAVES + F.wave; if (gw >= NS) return;
    const float* z = (const float*)(F.ws + SM_Z3) + (size_t)gw * DM; const GAS f32x4* zr = (const GAS f32x4*)z + F.lane;
    f32x4 v[4]; float s = 0.f;
#pragma unroll
    for (int j = 0; j < 4; ++j) { v[j] = zr[64 * j]; s += (v[j].x + v[j].y) + (v[j].z + v[j].w); }
    const float mean = wave_sum(s) * (1.f / DM); float s2 = 0.f;
#pragma unroll
    for (int j = 0; j < 4; ++j) { v[j] = v[j] - mean; s2 += (v[j].x * v[j].x + v[j].y * v[j].y) + (v[j].z * v[j].z + v[j].w * v[j].w); }
    const float rstd = 1.f / sqrtf(wave_sum(s2) * (1.f / DM) + LN_EPS);
    const f32x4* g = (const f32x4*)IN_L(I_LN3G) + F.lane; const f32x4* b = (const f32x4*)IN_L(I_LN3B) + F.lane; f32x4* o = (f32x4*)(F.out + OUT_YS + (size_t)gw * DM) + F.lane;
#pragma unroll
    for (int j = 0; j < 4; ++j) o[64 * j] = v[j] * rstd * g[64 * j] + b[64 * j];
}

__device__ __forceinline__ void final_ln_rows(Frame& F, const Args& A) {
    launder(F); unsigned char* ws = F.ws; const int lane = F.lane;
    const int gw = F.vcu * NWAVES + F.wave, NGW = F.G * NWAVES;
    const float* g3 = IN_L(I_LN3G); const float* b3 = IN_L(I_LN3B);
    f32x4 gv[4], bv[4];
#pragma unroll
    for (int j = 0; j < 4; ++j) { gv[j] = *(const f32x4*)(g3 + 256 * j + 4 * lane); bv[j] = *(const f32x4*)(b3 + 256 * j + 4 * lane); }
    const bf16* Z = (const bf16*)(ws + WS_Z3); const float* ST = (const float*)(ws + WS_STZ3);
#pragma unroll 1
    for (int row0 = gw; row0 < MP; row0 += 4 * NGW) {
        u32x2 raw[4][4]; f32x4 sa[4], sb[4];
#pragma unroll
        for (int r = 0; r < 4; ++r) { const size_t row = (size_t)row0 + (size_t)r * NGW; if (row < (size_t)MP) { sa[r] = *(const f32x4*)(ST + row * 8); sb[r] = *(const f32x4*)(ST + row * 8 + 4);
#pragma unroll
            for (int j = 0; j < 4; ++j) raw[r][j] = __builtin_nontemporal_load((const u32x2*)(Z + row * DM + 256 * j + 4 * lane)); } }
        __builtin_amdgcn_sched_barrier(0);
#pragma unroll
        for (int r = 0; r < 4; ++r) { const size_t row = (size_t)row0 + (size_t)r * NGW; if (row < (size_t)MP) { float mu, rs; pg8::stats_from(sa[r], sb[r], mu, rs);
            float* o = F.out + OUT_Y + row * DM + 4 * lane;
#pragma unroll
            for (int j = 0; j < 4; ++j) __builtin_nontemporal_store((pg8::unpack4(raw[r][j]) - mu) * rs * gv[j] + bv[j], (f32x4*)(o + 256 * j)); } }
    }
}
constexpr int GM_LD = 136;
__device__ __forceinline__ void gmlp_unit(Frame& F, const Args& A, int b, int c, int g) {
    launder(F); unsigned char* ws = F.ws; const int tid = F.tid, lane = F.lane, fr = lane & 15, fq = lane >> 4, w = F.wave;
    LAS bf16* wsA = (LAS bf16*)(F.lds + RING_OFF); LAS bf16* vnT = wsA + 128 * GM_LD;
    const int m0 = b * SEQ + 128 * c;
    const int s_ = tid >> 2, dq_ = tid & 3; const size_t row_ = (size_t)(m0 + s_);
    const f32x4* st = (const f32x4*)((const float*)(ws + WS_GVST) + row_ * 16);
    const bf16* gv = (const bf16*)(ws + WS_GV) + row_ * 512 + 128 * g + 32 * dq_;
    f32x4 stv[4]; v4u raw4[4];
    {
        const int t = tid >> 2, sb = 32 * (tid & 3); const bf16* src = (const bf16*)(ws + WS_AWSB) + ((size_t)(g * 128 + t) * 128 + sb);
        v4u wv4[4];
#pragma unroll
        for (int i = 0; i < 4; ++i) wv4[i] = *(const v4u*)(src + 8 * i);
#pragma unroll
        for (int i = 0; i < 4; ++i) { stv[i] = st[i]; raw4[i] = *(const v4u*)(gv + 8 * i); }
        __builtin_amdgcn_sched_barrier(0);
#pragma unroll
        for (int i = 0; i < 4; ++i) *(LAS v4u*)(wsA + t * GM_LD + sb + 8 * i) = wv4[i];
    }
    {
        const int s = s_, dq = dq_;
        const f32x4 p0 = stv[0], p1 = stv[1], p2 = stv[2], p3 = stv[3];
        const float mean = ((p0[0] + p0[2]) + (p1[0] + p1[2]) + (p2[0] + p2[2]) + (p3[0] + p3[2])) * 0.125f;
        float m2 = (p0[1] + p0[3]) + (p1[1] + p1[3]) + (p2[1] + p2[3]) + (p3[1] + p3[3]);
        { const float d0 = p0[0] - mean, d1 = p0[2] - mean, d2 = p1[0] - mean, d3 = p1[2] - mean, d4 = p2[0] - mean, d5 = p2[2] - mean, d6 = p3[0] - mean, d7 = p3[2] - mean;
          m2 += 64.f * ((d0 * d0 + d1 * d1) + (d2 * d2 + d3 * d3) + (d4 * d4 + d5 * d5) + (d6 * d6 + d7 * d7)); }
        const float rstd = 1.0f / sqrtf(m2 * (1.f / 512.f) + LN_EPS);
        const float* lg = IN_L(I_ALNG) + 128 * g + 32 * dq; const float* lb = IN_L(I_ALNB) + 128 * g + 32 * dq;
#pragma unroll
        for (int i = 0; i < 4; ++i) { const v4u raw = raw4[i];
            const f32x4 x0 = pg8::unpack4((u32x2){raw.x, raw.y}), x1 = pg8::unpack4((u32x2){raw.z, raw.w});
            const f32x4 g0 = *(const f32x4*)(lg + 8 * i), g1 = *(const f32x4*)(lg + 8 * i + 4), b0 = *(const f32x4*)(lb + 8 * i), b1 = *(const f32x4*)(lb + 8 * i + 4);
            const f32x4 y0 = (x0 - mean) * rstd * g0 + b0, y1 = (x1 - mean) * rstd * g1 + b1;
            const int d = 32 * dq + 8 * i;
#pragma unroll
            for (int e = 0; e < 4; ++e) { vnT[(d + e) * GM_LD + s] = (bf16)f2bf(y0[e]); vnT[(d + 4 + e) * GM_LD + s] = (bf16)f2bf(y1[e]); } }
    }
    __syncthreads();
    {
        f32x4 acc[8];
#pragma unroll
        for (int dt = 0; dt < 8; ++dt) acc[dt] = (f32x4){0.f, 0.f, 0.f, 0.f};
        const int t = 16 * w + fr; const size_t row = (size_t)(m0 + t); const float bias = IN_L(I_ABS)[g * 128 + t];
        const bf16* up = (const bf16*)(ws + WS_U) + row * 512 + 128 * g + 4 * fq; bf16* op = (bf16*)(ws + WS_MIX) + row * 1024 + 128 * g + 4 * fq;
        u32x2 u8[8];
#pragma unroll
        for (int dt = 0; dt < 8; ++dt) u8[dt] = *(const u32x2*)(up + 16 * dt);
        __builtin_amdgcn_sched_barrier(0);
        const int nsteps = (w + 2) >> 1;
        for (int st = 0; st < nsteps; ++st) { const int s0 = 32 * st + 8 * fq;
            const bf16x8 bfr = *(const LAS bf16x8*)(wsA + (16 * w + fr) * GM_LD + s0);
#pragma unroll
            for (int dt = 0; dt < 8; ++dt) { const bf16x8 afr = *(const LAS bf16x8*)(vnT + (16 * dt + fr) * GM_LD + s0); acc[dt] = mfma16(afr, bfr, acc[dt]); } }
        __builtin_amdgcn_sched_barrier(0);
#pragma unroll
        for (int dt = 0; dt < 8; ++dt) { const f32x4 uu = pg8::unpack4(u8[dt]); const f32x4 o = uu * (acc[dt] + bias);
            u32x2 wv; wv.x = pk2(o[0], o[1]); wv.y = pk2(o[2], o[3]); *(u32x2*)(op + 16 * dt) = wv; }
    }
    __syncthreads();
}

__device__ __forceinline__ unsigned ord_f32(float x) { unsigned u = __float_as_uint(x); if (u == 0x80000000u) u = 0u; return (u & 0x80000000u) ? ~u : (u | 0x80000000u); }
__device__ __forceinline__ unsigned ord_f32_nz(float x) { const unsigned u = __float_as_uint(x); return u ^ ((unsigned)((int)u >> 31) | 0x80000000u); }
constexpr int SC_LD = 2052;
constexpr int TA_SC = 0, TA_MASK = 16 * SC_LD * 4, TA_END = TA_MASK + 64 * 64 * 4;
static_assert(TA_END <= RING_BYTES, "topk/attention LDS");
__device__ __forceinline__ void cnt_ge(unsigned& c, unsigned x, unsigned T) {
    asm volatile("v_cmp_le_u32_e32 vcc, %2, %1\n\ts_nop 1\n\tv_addc_co_u32_e32 %0, vcc, 0, %0, vcc" : "+v"(c) : "v"(x), "s"(T) : "vcc");
}
__device__ __forceinline__ unsigned wave_sum_u32(unsigned v) {
    v += (unsigned)__builtin_amdgcn_update_dpp(0, (int)v, 0xB1, 0xF, 0xF, true);
    v += (unsigned)__builtin_amdgcn_update_dpp(0, (int)v, 0x4E, 0xF, 0xF, true);
    v += (unsigned)__builtin_amdgcn_update_dpp(0, (int)v, 0x141, 0xF, 0xF, true);
    v += (unsigned)__builtin_amdgcn_update_dpp(0, (int)v, 0x140, 0xF, 0xF, true);
    return (unsigned)__builtin_amdgcn_readlane((int)v, 0) + (unsigned)__builtin_amdgcn_readlane((int)v, 16) + (unsigned)__builtin_amdgcn_readlane((int)v, 32) + (unsigned)__builtin_amdgcn_readlane((int)v, 48);
}
__device__ __forceinline__ void transpose32(unsigned (&a)[32]) {
#define T32_STAGE(J, M) _Pragma("unroll") for (int k = 0; k < 32; ++k) if (!(k & (J))) { const unsigned lo = a[k], hi = a[k + (J)]; a[k] = (lo & (M)) | ((hi << (J)) & ~(M)); a[k + (J)] = ((lo >> (J)) & (M)) | (hi & ~(M)); }
    T32_STAGE(16, 0x0000FFFFu) T32_STAGE(8, 0x00FF00FFu) T32_STAGE(4, 0x0F0F0F0Fu) T32_STAGE(2, 0x33333333u) T32_STAGE(1, 0x55555555u)
#undef T32_STAGE
}
template <int J> __device__ __forceinline__ void ties_by_index(unsigned cand, int need, int base, unsigned& sel) {
    if constexpr (J < 32) { const bool tb = ((cand >> J) & 1u) != 0u; const unsigned long long tie = __ballot(tb);
        const int rank = base + (int)__builtin_amdgcn_mbcnt_hi((unsigned)(tie >> 32), __builtin_amdgcn_mbcnt_lo((unsigned)tie, 0u));
        sel |= ((unsigned)tb & (unsigned)(rank < need)) << J;
        ties_by_index<J + 1>(cand, need, base + __builtin_popcountll(tie), sel); }
}
__device__ __forceinline__ void select_rows(const LAS float* sc, LAS unsigned* mask16, int qbase, int w, int lane) {
    const int ra = 2 * w, rb = 2 * w + 1, qa = qbase + ra, qb = qbase + rb;
    unsigned PA[32], PB[32];
#pragma unroll
    for (int i = 0; i < 32; ++i) { const int k = 64 * i + lane; PA[i] = __float_as_uint(sc[ra * SC_LD + k]); PB[i] = __float_as_uint(sc[rb * SC_LD + k]); }
    __builtin_amdgcn_sched_barrier(0);
#pragma unroll
    for (int i = 0; i < 32; ++i) { const int k = 64 * i + lane; PA[i] = (k <= qa) ? ord_f32_nz(__uint_as_float(PA[i])) : 0u; PB[i] = (k <= qb) ? ord_f32_nz(__uint_as_float(PB[i])) : 0u; }
    transpose32(PA); transpose32(PB);
    unsigned candA = ~0u, candB = ~0u, selA = 0u, selB = 0u; int abA = 0, abB = 0;
#pragma unroll
    for (int b = 31; b >= 0; --b) {
        const unsigned tA = candA & PA[b], tB = candB & PB[b];
        const unsigned tot = wave_sum_u32((unsigned)__builtin_popcount(tA) | ((unsigned)__builtin_popcount(tB) << 16));
        { const int nA = abA + (int)(tot & 0xffffu); const bool take = nA >= 256, ex = nA == 256;
          selA |= (take && !ex) ? 0u : tA; candA = take ? (ex ? 0u : tA) : (candA & ~PA[b]); abA = take ? (ex ? 256 : abA) : nA; }
        { const int nB = abB + (int)(tot >> 16); const bool take = nB >= 256, ex = nB == 256;
          selB |= (take && !ex) ? 0u : tB; candB = take ? (ex ? 0u : tB) : (candB & ~PB[b]); abB = take ? (ex ? 256 : abB) : nB; }
        if (abA == 256 && abB == 256) break;
    }
    {
        const unsigned tot = wave_sum_u32((unsigned)__builtin_popcount(candA) | ((unsigned)__builtin_popcount(candB) << 16));
        const int needA = 256 - abA, needB = 256 - abB;
        if ((int)(tot & 0xffffu) == needA) selA |= candA; else ties_by_index<0>(candA, needA, 0, selA);
        if ((int)(tot >> 16) == needB) selB |= candB; else ties_by_index<0>(candB, needB, 0, selB);
    }
    mask16[ra * 64 + lane] = selA; mask16[rb * 64 + lane] = selB;
}
__device__ __forceinline__ void topk_load_k(Frame& F, int b, int ntile_max, bf16x8 (&k0)[8], bf16x8 (&k1)[8]) {
    launder(F); const int lane = F.lane, fr = lane & 15, fq = lane >> 4, w = F.wave;
    const bf16* kib = (const bf16*)(F.ws + WS_KI) + ((size_t)b * SEQ + fr) * 64 + 8 * fq;
#pragma unroll
    for (int i = 0; i < 8; ++i) { const int kt = w + NWAVES * i; k0[i] = bf16x8{}; k1[i] = bf16x8{}; if (kt < ntile_max) { const bf16* kp = kib + (size_t)kt * 16 * 64; k0[i] = *(const bf16x8*)kp; k1[i] = *(const bf16x8*)(kp + 32); } }
    __builtin_amdgcn_sched_barrier(0);
}
__device__ __forceinline__ void topk16(Frame& F, int b, int q0, LAS unsigned* mask16, const bf16x8 (&kh0)[8], const bf16x8 (&kh1)[8]) {
    launder(F); unsigned char* ws = F.ws; const int lane = F.lane, fr = lane & 15, fq = lane >> 4, w = F.wave;
    const size_t rowq = (size_t)b * SEQ + q0;
    if (q0 < 256) {
#pragma unroll
        for (int rr = 0; rr < 2; ++rr) { const int r = 2 * w + rr, q = q0 + r; const int d = q - lane;
            mask16[r * 64 + lane] = (d < 0) ? 0u : ((2u << (d >> 6)) - 1u); }
        return;
    }
    LAS float* sc = (LAS float*)(F.lds + RING_OFF + TA_SC);
    {
        const bf16* qip = (const bf16*)(ws + WS_QI) + (rowq + fr) * 256 + 8 * fq;
        bf16x8 qf[4][2];
#pragma unroll
        for (int h = 0; h < 4; ++h) { qf[h][0] = *(const bf16x8*)(qip + 64 * h); qf[h][1] = *(const bf16x8*)(qip + 64 * h + 32); }
        const f32x4 wq = *(const f32x4*)((const float*)(ws + WS_WI) + (rowq + fr) * 4);
        const int ntile = (q0 >> 4) + 1;
        const bf16* kib = (const bf16*)(ws + WS_KI) + ((size_t)b * SEQ + fr) * 64 + 8 * fq;
        bf16x8 k0[8], k1[8];
#pragma unroll
        for (int i = 0; i < 8; ++i) { const int kt = w + 64 + NWAVES * i; if (kt < ntile) { const bf16* kp = kib + (size_t)kt * 16 * 64; k0[i] = *(const bf16x8*)kp; k1[i] = *(const bf16x8*)(kp + 32); } }
        __builtin_amdgcn_sched_barrier(0);
#define TOPK_TILE(KA, KB, kt) { f32x4 s = (f32x4){0.f, 0.f, 0.f, 0.f}; \
            _Pragma("unroll") for (int h = 0; h < 4; ++h) { f32x4 d = mfma16(KA, qf[h][0], (f32x4){0.f, 0.f, 0.f, 0.f}); d = mfma16(KB, qf[h][1], d); \
                _Pragma("unroll") for (int e = 0; e < 4; ++e) s[e] = __builtin_fmaf(wq[h], fmaxf(d[e], 0.f), s[e]); } \
            *(LAS f32x4*)(sc + fr * SC_LD + 16 * (kt) + 4 * fq) = s; }
#pragma unroll
        for (int i = 0; i < 8; ++i) { const int kt = w + NWAVES * i; if (kt < ntile) TOPK_TILE(kh0[i], kh1[i], kt) }
        __builtin_amdgcn_sched_barrier(0);
#pragma unroll
        for (int i = 0; i < 8; ++i) { const int kt = w + 64 + NWAVES * i; if (kt < ntile) TOPK_TILE(k0[i], k1[i], kt) }
#undef TOPK_TILE
    }
    __syncthreads();
    select_rows(sc, mask16, q0, w, lane);
    __syncthreads();
}

typedef float f32x8 __attribute__((ext_vector_type(8)));
constexpr int AT_SLOTB = 8192, AT_LK = 0, AT_LV = 3 * AT_SLOTB, AT_MT = 6 * AT_SLOTB, AT_QS = AT_MT + 32 * 128 * 4, AT_END = AT_QS + 8 * 4096;
static_assert(AT_END <= TA_MASK, "attention rings + tile-major mask overlay the score image");
__device__ __forceinline__ void at_glds16(const void* g, unsigned lds_dst) { unsigned keep;
    asm volatile("s_mov_b32 %0, m0\n\ts_mov_b32 m0, %2\n\ts_nop 0\n\tglobal_load_lds_dwordx4 %1, off\n\ts_mov_b32 m0, %0" : "=&s"(keep) : "v"(g), "s"(lds_dst) : "memory"); }
typedef short at_v4i16 __attribute__((ext_vector_type(4)));
__device__ __forceinline__ u32x2 at_vtr(const LAS char* p) { return __builtin_bit_cast(u32x2, __builtin_amdgcn_ds_read_tr16_b64_v4i16((LAS at_v4i16*)p)); }
__device__ __forceinline__ void at_kload2(bf16x8* kf, const LAS char* kp, int j) { kf[2 * j] = *(const LAS bf16x8*)(kp + j * 2048); kf[2 * j + 1] = *(const LAS bf16x8*)(kp + j * 2048 + 512); }
#define AT_MX3(a, b, c) __builtin_fmaxf(__builtin_fmaxf((a), (b)), (c))
__device__ __forceinline__ float at_rowmax(const f32x16& p0, const f32x16& p1) {
    float a = AT_MX3(p0[0], p0[1], p1[0]), b = AT_MX3(p0[2], p0[3], p1[1]); a = AT_MX3(a, p1[2], p1[3]);
#pragma unroll
    for (int r = 4; r < 16; r += 4) { a = AT_MX3(a, p0[r], p0[r + 1]); b = AT_MX3(b, p0[r + 2], p0[r + 3]); a = AT_MX3(a, p1[r], p1[r + 1]); b = AT_MX3(b, p1[r + 2], p1[r + 3]); }
    const float m = __builtin_fmaxf(a, b); auto rr = __builtin_amdgcn_permlane32_swap(__float_as_uint(m), __float_as_uint(m), false, false);
    return __builtin_fmaxf(__uint_as_float(rr[0]), __uint_as_float(rr[1])); }
__device__ __forceinline__ void mask_to_tiles(Frame& F, const LAS unsigned* mask64) {
    const int tid = F.tid;
    if (tid < 128) { const int row = tid >> 1, hf = tid & 1;
        const LAS v4u* mp = (const LAS v4u*)(mask64 + row * 64 + 4 * hf);
        unsigned a[32];
#pragma unroll
        for (int kh = 0; kh < 2; ++kh)
#pragma unroll
            for (int i4 = 0; i4 < 4; ++i4) { const v4u v = mp[8 * kh + 2 * i4]; a[8 * kh + 2 * i4] = v.x; a[8 * kh + 2 * i4 + 16] = v.y; a[8 * kh + 2 * i4 + 1] = v.z; a[8 * kh + 2 * i4 + 17] = v.w; }
        transpose32(a);
        LAS unsigned* mt = (LAS unsigned*)(F.lds + RING_OFF + AT_MT) + tid;
#pragma unroll
        for (int t = 0; t < 32; ++t) mt[t * 128] = a[t]; }
}
#define AT_SBAR() __builtin_amdgcn_sched_barrier(0)
#define AT_PIN(x) asm volatile("" : "+v"(x))
#define AT_WAIT_BAR(N) asm volatile("s_waitcnt vmcnt(" #N ") lgkmcnt(0)\n\ts_barrier" ::: "memory")
#define AT_MEXP(v, pos, W) __uint_as_float(__float_as_uint(__builtin_amdgcn_exp2f(v)) & (unsigned)__builtin_amdgcn_sbfe((int)(W), (pos), 1))
#define AT_PMASK(j, W) ({ unsigned m_; if ((j) == 15) asm("v_pk_ashrrev_i16 %0, 15, %1 op_sel_hi:[0,1]" : "=v"(m_) : "v"(W)); \
    else asm("v_pk_lshlrev_b16 %0, %2, %1 op_sel_hi:[0,1]\n\tv_pk_ashrrev_i16 %0, 15, %0 op_sel_hi:[0,1]" : "=v"(m_) : "v"(W), "n"(15 - (j))); m_; })
#ifdef PROBE_DUPMASK
#define AT_MEXPC(v, pos, W) ({ unsigned m_, m2_; asm("v_bfe_i32 %0, %1, %2, 1" : "=v"(m_) : "v"(W), "n"(pos)); unsigned r_ = __float_as_uint(__builtin_amdgcn_exp2f(v)) & m_; asm volatile("v_bfe_i32 %0, %2, %3, 1\n\tv_and_b32 %1, %1, %0" : "=&v"(m2_), "+v"(r_) : "v"(W), "n"(pos)); __uint_as_float(r_); })
#else
#define AT_MEXPC(v, pos, W) ({ unsigned m_; asm("v_bfe_i32 %0, %1, %2, 1" : "=v"(m_) : "v"(W), "n"(pos)); __uint_as_float(__float_as_uint(__builtin_amdgcn_exp2f(v)) & m_); })
#endif
__device__ __forceinline__ void attn_unit(Frame& F, int b, int qt, int g) {
    launder(F); unsigned char* ws = F.ws; const int lane = F.lane, r32 = lane & 31, hi = lane >> 5; const int wid = __builtin_amdgcn_readfirstlane(F.wave);
    const int hh = wid & 3, qs = wid >> 2, head = 4 * g + hh, q0 = 64 * qt + 32 * qs; const size_t qrow = (size_t)b * SEQ + q0 + r32;
    const int NT = qt + 1;
    const LAS char* shm = (const LAS char*)(F.lds + RING_OFF); const unsigned lds0 = (unsigned)(size_t)shm;
    const bf16* ksrc = (const bf16*)(ws + WS_K) + ((size_t)b * SEQ + lane) * 128 + 64 * g + 8 * wid;
    const bf16* vsrc = (const bf16*)(ws + WS_VT) + ((size_t)b * SEQ + 16 * (wid & 3) + (lane >> 2)) * 128 + 64 * g + (wid >> 2) * 32 + (lane & 3) * 8;
    const unsigned kdst = lds0 + AT_LK + wid * 1024, vdst = lds0 + AT_LV + wid * 1024;
#define DMA_K(t, slot) at_glds16(ksrc + (size_t)min((int)(t), NT - 1) * (64 * 128), (unsigned)__builtin_amdgcn_readfirstlane((int)(kdst + (slot))))
#define DMA_V(t, slot) at_glds16(vsrc + (size_t)min((int)(t), NT - 1) * (64 * 128), (unsigned)__builtin_amdgcn_readfirstlane((int)(vdst + (slot))))
    const LAS char* kp0 = shm + AT_LK + hi * 1024 + r32 * 16;
    const LAS char* vp0 = shm + AT_LV + ((lane >> 4) & 1) * 32 + (lane & 3) * 8 + (4 * hi + ((lane & 15) >> 2)) * 64;
    const LAS unsigned* mT = (const LAS unsigned*)(shm + AT_MT) + 2 * (32 * qs + r32) + hi;
    DMA_K(0, 0); DMA_V(0, 0); DMA_K(1, AT_SLOTB);
    bf16x8 qr[4];
    const LAS char* qsp = shm + AT_QS + wid * 4096 + lane * 16;
    { const bf16* qp = (const bf16*)(ws + WS_Q) + qrow * 512 + 64 * head + 8 * hi;
#pragma unroll
      for (int ks = 0; ks < 4; ++ks) qr[ks] = *(const bf16x8*)(qp + 16 * ks);
#pragma unroll
      for (int ks = 0; ks < 4; ++ks) *(LAS bf16x8*)(shm + AT_QS + wid * 4096 + lane * 16 + ks * 1024) = qr[ks]; }
#define QRD(i) do { qv[i] = *(const LAS bf16x8*)(qsp + ((i) & 3) * 1024); } while (0)
    float mhat = 0.f, fsc = 1.f; f32x16 o[2]; o[0] = f32x16{}; o[1] = f32x16{}; f32x16 negm = f32x16{}; AT_PIN(negm);
    f32x16 lacc = f32x16{};
    v4u onesw = (v4u){0x3F803F80u, 0x3F803F80u, 0x3F803F80u, 0x3F803F80u}; AT_PIN(onesw);
    bool resc = false;
    f32x16 pA0, pA1, pB0, pB1; bf16x8 kf[8]; u32x2 vlo[8], vhi[8]; v4u pw0, pw1, pw2, pw3;
    int sl_prev = 0, sl_cur = 0, sl_next = AT_SLOTB;
#define ROT() do { sl_prev = sl_cur; sl_cur = sl_next; sl_next = (sl_next == 2 * AT_SLOTB) ? 0 : sl_next + AT_SLOTB; } while (0)
#define RESC() do { if (resc) { o[0] = o[0] * fsc; o[1] = o[1] * fsc; lacc = lacc * fsc; } } while (0)
    DMA_K(2, 2 * AT_SLOTB);
    AT_WAIT_BAR(3);
#pragma unroll
    for (int d0 = 0; d0 < 4; ++d0) at_kload2(kf, kp0, d0);
    pA0 = mfma32(kf[0], qr[0], negm); pA1 = mfma32(kf[1], qr[0], negm); pA0 = mfma32(kf[2], qr[1], pA0); pA1 = mfma32(kf[3], qr[1], pA1);
    pA0 = mfma32(kf[4], qr[2], pA0); pA1 = mfma32(kf[5], qr[2], pA1); pA0 = mfma32(kf[6], qr[3], pA0); pA1 = mfma32(kf[7], qr[3], pA1);
    { const float rm = at_rowmax(pA0, pA1); mhat = rm;
#pragma unroll
      for (int r = 0; r < 16; ++r) negm[r] = -mhat;
      AT_PIN(negm);
#pragma unroll
      for (int r = 0; r < 16; ++r) { pA0[r] = __builtin_amdgcn_exp2f(pA0[r] - rm); pA1[r] = pA1[r] - rm; } }
    AT_WAIT_BAR(0);
    DMA_K(3, 0); DMA_V(1, AT_SLOTB); ROT();
#pragma unroll
    for (int d0 = 0; d0 < 4; ++d0) at_kload2(kf, kp0 + sl_cur, d0);
    AT_WAIT_BAR(2);
#define PKW(P, i) pg8::cvt_pk_bf16(P[i], P[(i) + 1])
#define PKM(P, i, J0) (PKW(P, i) & AT_PMASK((J0) + (i) / 2, mwp))
#define PAF(k) as_bf16x8(pw##k)
#define VFR(i) as_bf16x8((v4u){vlo[i].x, vlo[i].y, vhi[i].x, vhi[i].y})
#define VRD(i) do { vlo[i] = at_vtr(vp_ + (((i) >> 2) * 4096 + ((i) & 3) * 1024)); vhi[i] = at_vtr(vp_ + (((i) >> 2) * 4096 + ((i) & 3) * 1024 + 512)); } while (0)
#define KRD(d0) do { at_kload2(kf, kp0 + sl_next, d0); AT_SBAR(); } while (0)
#define GAPA(MF, W0, W1, PW) do { MF; W0; W1; AT_PIN(PW); AT_SBAR(); } while (0)
#define MX1(X, i) X[i] = __builtin_amdgcn_exp2f(X[i])
#define GAPAX(MF, W0, W1, PW, X, EXPS) do { MF; W0; W1; AT_PIN(PW); EXPS; AT_PIN(X); AT_SBAR(); } while (0)
#define LSUM(k) do { lacc = mfma32(as_bf16x8(onesw), PAF(k), lacc); AT_SBAR(); } while (0)
#define GAPB(MF, X, i) do { MF; X[i] = __builtin_amdgcn_exp2f(X[i]); X[(i) + 1] = __builtin_amdgcn_exp2f(X[(i) + 1]); AT_PIN(X); AT_SBAR(); } while (0)
#define STEP(C0, C1, P0, P1, t) do { AT_SBAR(); \
    const LAS char* vp_ = vp0 + sl_prev; const unsigned mwp = mT[((t) - 1) * 128]; \
    bf16x8 qv[8]; QRD(0); QRD(1); AT_SBAR(); \
    QRD(2); AT_SBAR(); GAPAX(C0 = mfma32(kf[0], qv[0], negm), pw0[0] = PKM(P0, 0, 0),  pw0[1] = PKM(P0, 2, 0),  pw0, P1, MX1(P1, 0); MX1(P1, 1); MX1(P1, 2)); \
    QRD(3); AT_SBAR(); GAPAX(C0 = mfma32(kf[2], qv[1], C0),   pw0[2] = PKM(P0, 4, 0),  pw0[3] = PKM(P0, 6, 0),  pw0, P1, MX1(P1, 3); MX1(P1, 4); MX1(P1, 5)); \
    QRD(4); AT_SBAR(); GAPAX(C0 = mfma32(kf[4], qv[2], C0),   pw1[0] = PKM(P0, 8, 0),  pw1[1] = PKM(P0, 10, 0), pw1, P1, MX1(P1, 6); MX1(P1, 7)); LSUM(0); \
    QRD(5); AT_SBAR(); GAPAX(C0 = mfma32(kf[6], qv[3], C0),   pw1[2] = PKM(P0, 12, 0), pw1[3] = PKM(P0, 14, 0), pw1, P1, MX1(P1, 8); MX1(P1, 9)); \
    QRD(6); AT_SBAR(); GAPAX(C1 = mfma32(kf[1], qv[4], negm), pw2[0] = PKM(P1, 0, 8),  pw2[1] = PKM(P1, 2, 8),  pw2, P1, MX1(P1, 10); MX1(P1, 11)); LSUM(1); \
    QRD(7); AT_SBAR(); GAPAX(C1 = mfma32(kf[3], qv[5], C1),   pw2[2] = PKM(P1, 4, 8),  pw2[3] = PKM(P1, 6, 8),  pw2, P1, MX1(P1, 12); MX1(P1, 13)); \
    GAPAX(C1 = mfma32(kf[5], qv[6], C1),   pw3[0] = PKM(P1, 8, 8),  pw3[1] = PKM(P1, 10, 8), pw3, P1, MX1(P1, 14); MX1(P1, 15)); LSUM(2); \
    GAPA(C1 = mfma32(kf[7], qv[7], C1),    pw3[2] = PKM(P1, 12, 8), pw3[3] = PKM(P1, 14, 8), pw3); LSUM(3); \
    DMA_K((t) + 3, sl_cur); DMA_V((t) + 1, sl_next);                                                       \
    VRD(0); VRD(4); AT_SBAR();                                                                             \
    { const float rm = at_rowmax(C0, C1); resc = false;                                                    \
      if (__builtin_expect(__any(rm > 8.f), 0)) { const float dl = __builtin_fmaxf(rm, 0.f); mhat += dl;    \
          _Pragma("unroll") for (int r = 0; r < 16; ++r) { C0[r] -= dl; C1[r] -= dl; } \
          _Pragma("unroll") for (int r = 0; r < 16; ++r) negm[r] = -mhat; \
          AT_PIN(negm); fsc = __builtin_amdgcn_exp2f(-dl); resc = true; } } \
    AT_SBAR(); \
    VRD(1); AT_SBAR(); GAPB(o[0] = mfma32(VFR(0), PAF(0), o[0]), C0, 0); \
    VRD(5); AT_SBAR(); GAPB(o[1] = mfma32(VFR(4), PAF(0), o[1]), C0, 2); \
    KRD(0); VRD(2); AT_SBAR(); GAPB(o[0] = mfma32(VFR(1), PAF(1), o[0]), C0, 4); \
    KRD(1); VRD(6); AT_SBAR(); GAPB(o[1] = mfma32(VFR(5), PAF(1), o[1]), C0, 6); \
    KRD(2); VRD(3); AT_SBAR(); GAPB(o[0] = mfma32(VFR(2), PAF(2), o[0]), C0, 8); \
    KRD(3); VRD(7); AT_SBAR(); GAPB(o[1] = mfma32(VFR(6), PAF(2), o[1]), C0, 10); \
    GAPB(o[0] = mfma32(VFR(3), PAF(3), o[0]), C0, 12);              GAPB(o[1] = mfma32(VFR(7), PAF(3), o[1]), C0, 14); \
    } while (0)
    int t = 1;
    for (; t + 1 < NT; t += 2) {
        STEP(pB0, pB1, pA0, pA1, t);     AT_WAIT_BAR(2); RESC(); ROT();
        STEP(pA0, pA1, pB0, pB1, t + 1); AT_WAIT_BAR(2); RESC(); ROT();
    }
    if (t < NT) { STEP(pB0, pB1, pA0, pA1, t); AT_WAIT_BAR(2); RESC(); ROT(); pA0 = pB0; pA1 = pB1; }
    {
#pragma unroll
      for (int r = 0; r < 16; ++r) pA1[r] = __builtin_amdgcn_exp2f(pA1[r]);
      const unsigned mwp = mT[(NT - 1) * 128];
      pw0 = (v4u){PKM(pA0, 0, 0), PKM(pA0, 2, 0), PKM(pA0, 4, 0), PKM(pA0, 6, 0)}; pw1 = (v4u){PKM(pA0, 8, 0), PKM(pA0, 10, 0), PKM(pA0, 12, 0), PKM(pA0, 14, 0)};
      pw2 = (v4u){PKM(pA1, 0, 8), PKM(pA1, 2, 8), PKM(pA1, 4, 8), PKM(pA1, 6, 8)}; pw3 = (v4u){PKM(pA1, 8, 8), PKM(pA1, 10, 8), PKM(pA1, 12, 8), PKM(pA1, 14, 8)};
      const LAS char* vp_ = vp0 + sl_prev;
#pragma unroll
      for (int i = 0; i < 8; ++i) VRD(i);
      o[0] = mfma32(VFR(0), PAF(0), o[0]); o[1] = mfma32(VFR(4), PAF(0), o[1]); o[0] = mfma32(VFR(1), PAF(1), o[0]); o[1] = mfma32(VFR(5), PAF(1), o[1]);
      o[0] = mfma32(VFR(2), PAF(2), o[0]); o[1] = mfma32(VFR(6), PAF(2), o[1]); o[0] = mfma32(VFR(3), PAF(3), o[0]); o[1] = mfma32(VFR(7), PAF(3), o[1]);
      lacc = mfma32(as_bf16x8(onesw), PAF(0), lacc); lacc = mfma32(as_bf16x8(onesw), PAF(1), lacc); lacc = mfma32(as_bf16x8(onesw), PAF(2), lacc); lacc = mfma32(as_bf16x8(onesw), PAF(3), lacc); }
    const float l_reg = lacc[0];
    asm volatile("s_waitcnt vmcnt(0)" ::: "memory");
    {
        const float linv = 1.0f / l_reg; bf16* op = (bf16*)(ws + WS_MIX) + qrow * 1024 + 512 + 64 * head + 8 * hi;
#pragma unroll
        for (int k = 0; k < 8; k += 2) {
            const int dba = k >> 2, ia = k & 3, ib = ia + 1;
            unsigned ax = pg8::cvt_pk_bf16(o[dba][4 * ia] * linv, o[dba][4 * ia + 1] * linv), ay = pg8::cvt_pk_bf16(o[dba][4 * ia + 2] * linv, o[dba][4 * ia + 3] * linv);
            unsigned bx = pg8::cvt_pk_bf16(o[dba][4 * ib] * linv, o[dba][4 * ib + 1] * linv), by = pg8::cvt_pk_bf16(o[dba][4 * ib + 2] * linv, o[dba][4 * ib + 3] * linv);
            { auto r = __builtin_amdgcn_permlane32_swap(ax, bx, false, false); ax = r[0]; bx = r[1]; }
            { auto r = __builtin_amdgcn_permlane32_swap(ay, by, false, false); ay = r[0]; by = r[1]; }
            *(v4u*)(op + 8 * k) = (v4u){ax, ay, bx, by}; }
    }
    asm volatile("s_waitcnt lgkmcnt(0)\n\ts_barrier" ::: "memory");
#undef DMA_K
#undef DMA_V
#undef ROT
#undef RESC
#undef PKW
#undef PKM
#undef PAF
#undef VFR
#undef VRD
#undef KRD
#undef GAPA
#undef GAPAX
#undef MX1
#undef QRD
#undef LSUM
#undef GAPB
#undef STEP
}
__device__ __forceinline__ void topk_attn_unit(Frame& F, int b, int qt) {
    LAS unsigned* mask64 = (LAS unsigned*)(F.lds + RING_OFF + TA_MASK);
    bf16x8 kh0[8], kh1[8];
    topk_load_k(F, b, (qt < 4) ? 0 : 4 * qt + 4, kh0, kh1);
#pragma unroll 1
    for (int sub = 0; sub < 4; ++sub) topk16(F, b, 64 * qt + 16 * sub, mask64 + sub * 16 * 64, kh0, kh1);
    __syncthreads();
    mask_to_tiles(F, mask64);
    __syncthreads();
#pragma unroll 1
#ifdef PROBE_ATT2
    for (int g = 0; g < 4; ++g) attn_unit(F, b, qt, g & 1);
#else
    for (int g = 0; g < 2; ++g) attn_unit(F, b, qt, g);
#endif
}

__device__ __forceinline__ float dpp_sum16(float v) {
    v += __builtin_bit_cast(float, __builtin_amdgcn_update_dpp(0, __builtin_bit_cast(int, v), 0xB1, 0xF, 0xF, true));
    v += __builtin_bit_cast(float, __builtin_amdgcn_update_dpp(0, __builtin_bit_cast(int, v), 0x4E, 0xF, 0xF, true));
    v += __builtin_bit_cast(float, __builtin_amdgcn_update_dpp(0, __builtin_bit_cast(int, v), 0x141, 0xF, 0xF, true));
    v += __builtin_bit_cast(float, __builtin_amdgcn_update_dpp(0, __builtin_bit_cast(int, v), 0x140, 0xF, 0xF, true));
    return v;
}
__device__ __forceinline__ float dot4(const f32x4 a, const f32x4 b) { return __builtin_fmaf(a[3], b[3], __builtin_fmaf(a[2], b[2], __builtin_fmaf(a[1], b[1], a[0] * b[0]))); }
constexpr int SU_SC = 0, SU_QI = 8208 * 4, SU_WI = SU_QI + 256 * 4, SU_Q = SU_WI + 16, SU_SEL = SU_Q + 512 * 4, SU_P = SU_SEL + 256 * 4, SU_CNT = SU_P + 8 * 256 * 4, SU_CW = SU_CNT + 64 * 4, SU_RED = SU_CW + 2 * 17 * 8 * 4, SU_END = SU_RED + 64 * 4;
static_assert(SU_END <= RING_BYTES, "sample-unit LDS");
__device__ __forceinline__ void sample_unit(Frame& F, const Args& A, int b) {
    launder(F); unsigned char* ws = F.ws; const int tid = F.tid, lane = F.lane, w = F.wave;
    LAS float* sc = (LAS float*)(F.lds + RING_OFF + SU_SC); LAS float* qi_s = (LAS float*)(F.lds + RING_OFF + SU_QI); LAS float* wi_s = (LAS float*)(F.lds + RING_OFF + SU_WI);
    LAS float* q_s = (LAS float*)(F.lds + RING_OFF + SU_Q); LAS int* sel = (LAS int*)(F.lds + RING_OFF + SU_SEL); LAS float* p_s = (LAS float*)(F.lds + RING_OFF + SU_P);
    LAS unsigned* cnts = (LAS unsigned*)(F.lds + RING_OFF + SU_CNT); LAS unsigned* cw = (LAS unsigned*)(F.lds + RING_OFF + SU_CW); LAS float* red = (LAS float*)(F.lds + RING_OFF + SU_RED);
    const int* pt = (const int*)IN_L(I_PT) + b * NPAGE;
    if (tid < 256) qi_s[tid] = ((const float*)(ws + SM_QIS))[b * 256 + tid];
    if (tid < 4) wi_s[tid] = ((const float*)(ws + SM_WIS))[b * 4 + tid];
    q_s[tid] = ((const float*)(ws + SM_QS))[b * 512 + tid];
    {
        const float gv = ((const float*)(ws + SM_GVS))[b * 512 + tid];
        const float s1 = wave_sum(gv); if (lane == 0) red[w] = s1;
        __syncthreads();
        float mean = 0.f;
#pragma unroll
        for (int i = 0; i < 8; ++i) mean += red[i];
        mean *= (1.f / 512.f);
        const float d = gv - mean; const float s2 = wave_sum(d * d); if (lane == 0) red[8 + w] = s2;
        __syncthreads();
        float var = 0.f;
#pragma unroll
        for (int i = 0; i < 8; ++i) var += red[8 + i];
        const float rstd = 1.0f / sqrtf(var * (1.f / 512.f) + LN_EPS);
        const float av = d * rstd * IN_L(I_ALNG)[tid] + IN_L(I_ALNB)[tid];
        F.out[OUT_AV + (size_t)b * 512 + tid] = av;
        const int g = tid >> 7; const float mixed = IN_L(I_AWS)[(size_t)g * 128 * 128] * av + IN_L(I_ABS)[g * 128];
        ((bf16*)(ws + SM_MIXSB))[(size_t)b * 1024 + tid] = (bf16)f2bf(((const float*)(ws + SM_US))[b * 512 + tid] * mixed);
    }
    {
        const int sub = lane & 15, kq = lane >> 4;
        f32x4 qh[4];
#pragma unroll
        for (int h = 0; h < 4; ++h) qh[h] = *(const LAS f32x4*)(qi_s + 64 * h + 4 * sub);
        const float w0 = wi_s[0], w1 = wi_s[1], w2 = wi_s[2], w3 = wi_s[3];
        const float* cki = IN_L(I_CKI) + 4 * sub;
#define SU_LOAD(buf, phys, half) { const float* base_ = cki + (size_t)(phys) * (128 * 64) + (half) * (64 * 64); \
            _Pragma("unroll") for (int it = 0; it < 16; ++it) buf[it] = __builtin_nontemporal_load((const f32x4*)(base_ + (4 * it + kq) * 64)); }
#define SU_SCORE(buf, pg_, half) { \
            _Pragma("unroll") for (int it = 0; it < 16; ++it) { const int key = (half) * 64 + 4 * it + kq; const f32x4 kv = buf[it]; \
                const float d0 = dpp_sum16(dot4(kv, qh[0])), d1 = dpp_sum16(dot4(kv, qh[1])), d2 = dpp_sum16(dot4(kv, qh[2])), d3 = dpp_sum16(dot4(kv, qh[3])); \
                float s = w0 * fmaxf(d0, 0.f); s = __builtin_fmaf(w1, fmaxf(d1, 0.f), s); s = __builtin_fmaf(w2, fmaxf(d2, 0.f), s); s = __builtin_fmaf(w3, fmaxf(d3, 0.f), s); \
                if (sub == 0) sc[(pg_) * 128 + key] = s; } }
        {
            f32x4 kvA[16], kvB[16];
            int phys_cur = __builtin_amdgcn_readfirstlane(pt[w]);
            SU_LOAD(kvA, phys_cur, 0)
#pragma unroll 1
            for (int pg = w; pg < NPAGE; pg += NWAVES) {
                const int pgn = (pg + NWAVES < NPAGE) ? pg + NWAVES : pg;
                const int phys_nv = pt[pgn];
                SU_LOAD(kvB, phys_cur, 1)
                __builtin_amdgcn_sched_barrier(0);
                SU_SCORE(kvA, pg, 0)
                const int phys_next = __builtin_amdgcn_readfirstlane(phys_nv);
                if (pg + NWAVES < NPAGE) SU_LOAD(kvA, phys_next, 0)
                __builtin_amdgcn_sched_barrier(0);
                SU_SCORE(kvB, pg, 1)
                phys_cur = phys_next;
            }
        }
#undef SU_LOAD
#undef SU_SCORE
        if (w == 0) { const f32x4 kv = *(const f32x4*)(F.out + OUT_KIS + (size_t)b * 64 + 4 * sub);
            const float d0 = dpp_sum16(dot4(kv, qh[0])), d1 = dpp_sum16(dot4(kv, qh[1])), d2 = dpp_sum16(dot4(kv, qh[2])), d3 = dpp_sum16(dot4(kv, qh[3]));
            float s = w0 * fmaxf(d0, 0.f); s = __builtin_fmaf(w1, fmaxf(d1, 0.f), s); s = __builtin_fmaf(w2, fmaxf(d2, 0.f), s); s = __builtin_fmaf(w3, fmaxf(d3, 0.f), s);
            if (lane == 0) sc[PAST] = s; }
    }
    __syncthreads();
    unsigned x[17];
#pragma unroll
    for (int i = 0; i < 17; ++i) { const int p = tid + 512 * i; x[i] = __float_as_uint(sc[p < PAST + 1 ? p : PAST]); }
    __builtin_amdgcn_sched_barrier(0);
#pragma unroll
    for (int i = 0; i < 17; ++i) { const int p = tid + 512 * i; x[i] = (p <= PAST) ? ord_f32(__uint_as_float(x[i])) : 0u; }
    unsigned prefix = 0u;
#pragma unroll 1
    for (int bit = 31; bit >= 0; --bit) { const unsigned T = prefix | (1u << bit); unsigned c = 0u;
#pragma unroll
        for (int i = 0; i < 17; ++i) cnt_ge(c, x[i], T);
        const unsigned cnt = wave_sum_u32(c);
        LAS unsigned* slot = cnts + 8 * (bit & 1);
        if (lane == 0) slot[w] = cnt;
        __syncthreads();
        unsigned tot = 0;
#pragma unroll
        for (int i = 0; i < 8; ++i) tot += slot[i];
        if (tot >= 256u) prefix = T;
        if (tot == 256u) break; }
    const unsigned thr = prefix;
    {
        const unsigned long long lt = (1ull << lane) - 1ull;
        int cg = 0;
#pragma unroll
        for (int i = 0; i < 17; ++i) cg += __builtin_popcountll(__ballot(x[i] > thr));
        if (lane == 0) cnts[16 + w] = (unsigned)cg;
#pragma unroll
        for (int i = 0; i < 17; ++i) { const unsigned long long gb = __ballot(x[i] > thr), tb = __ballot(x[i] == thr);
            if (lane == 0) { cw[(i * 8 + w) * 2] = (unsigned)__builtin_popcountll(gb); cw[(i * 8 + w) * 2 + 1] = (unsigned)__builtin_popcountll(tb); } }
        __syncthreads();
        unsigned ngt = 0;
#pragma unroll
        for (int i = 0; i < 8; ++i) ngt += cnts[16 + i];
        const unsigned need = 256u - ngt;
        unsigned run_gt = 0, run_ti = 0;
#pragma unroll
        for (int i = 0; i < 17; ++i) {
            unsigned my_g = run_gt, my_t = run_ti;
#pragma unroll
            for (int ww = 0; ww < 8; ++ww) { const unsigned a = cw[(i * 8 + ww) * 2], c = cw[(i * 8 + ww) * 2 + 1]; if (ww < w) { my_g += a; my_t += c; } run_gt += a; run_ti += c; }
            const unsigned long long gb = __ballot(x[i] > thr), tb = __ballot(x[i] == thr); const int p = tid + 512 * i;
            if ((gb >> lane) & 1ull) sel[my_g + (unsigned)__builtin_popcountll(gb & lt)] = p;
            else if ((tb >> lane) & 1ull) { const unsigned rk = my_t + (unsigned)__builtin_popcountll(tb & lt); if (rk < need) sel[ngt + rk] = p; }
            __builtin_amdgcn_sched_barrier(0);
        }
    }
    __syncthreads();
    {
        LAS int* ro_s = (LAS int*)cw;
        if (tid < 256) { const int p = sel[tid]; ro_s[tid] = (p < PAST) ? pt[p >> 7] * 128 + (p & 127) : -1; }
        __syncthreads();
        const int h = w, g = h >> 2; const float* ck = IN_L(I_CK); const float* cv = IN_L(I_CV);
        const int sub = lane & 15, kq = lane >> 4;
        const f32x4 qv = *(const LAS f32x4*)(q_s + 64 * h + 4 * sub);
        const float* knew = F.out + OUT_KS + ((size_t)b * 2 + g) * 64 + 4 * sub; const float* vnew = F.out + OUT_VS + ((size_t)b * 2 + g) * 64 + 4 * sub;
#pragma unroll 1
        for (int it0 = 0; it0 < 64; it0 += 32) { f32x4 kr16[32];
#pragma unroll
            for (int i = 0; i < 32; ++i) { const int ro = ro_s[4 * (it0 + i) + kq]; kr16[i] = *(const f32x4*)((ro >= 0) ? ck + ((size_t)ro * 2 + g) * 64 + 4 * sub : knew); }
            __builtin_amdgcn_sched_barrier(0);
#pragma unroll
            for (int i = 0; i < 32; ++i) { const float d = dpp_sum16(dot4(kr16[i], qv)); if (sub == 0) p_s[h * 256 + 4 * (it0 + i) + kq] = d * 0.125f; } }
        LDS_WAIT(); asm volatile("" ::: "memory");
        const float l0 = p_s[h * 256 + lane], l1 = p_s[h * 256 + lane + 64], l2 = p_s[h * 256 + lane + 128], l3 = p_s[h * 256 + lane + 192];
        const float mx = wave_max(fmaxf(fmaxf(l0, l1), fmaxf(l2, l3)));
        const float e0 = __expf(l0 - mx), e1 = __expf(l1 - mx), e2 = __expf(l2 - mx), e3 = __expf(l3 - mx);
        p_s[h * 256 + lane] = e0; p_s[h * 256 + lane + 64] = e1; p_s[h * 256 + lane + 128] = e2; p_s[h * 256 + lane + 192] = e3;
        const float ls = (e0 + e1) + (e2 + e3);
        const float linv = 1.0f / wave_sum(ls);
        LDS_WAIT(); asm volatile("" ::: "memory");
        f32x4 acc = (f32x4){0.f, 0.f, 0.f, 0.f};
#pragma unroll 1
        for (int it0 = 0; it0 < 64; it0 += 32) { f32x4 vr16[32];
#pragma unroll
            for (int i = 0; i < 32; ++i) { const int ro = ro_s[4 * (it0 + i) + kq]; vr16[i] = *(const f32x4*)((ro >= 0) ? cv + ((size_t)ro * 2 + g) * 64 + 4 * sub : vnew); }
            __builtin_amdgcn_sched_barrier(0);
#pragma unroll
            for (int i = 0; i < 32; ++i) acc = acc + vr16[i] * p_s[h * 256 + 4 * (it0 + i) + kq]; }
#pragma unroll
        for (int i = 0; i < 4; ++i) { acc[i] += __shfl_xor(acc[i], 16); acc[i] += __shfl_xor(acc[i], 32); }
        if (kq == 0) { const f32x4 o = acc * linv; u32x2 wv; wv.x = pk2(o[0], o[1]); wv.y = pk2(o[2], o[3]); *(u32x2*)((bf16*)(ws + SM_MIXSB) + (size_t)b * 1024 + 512 + 64 * h + 4 * sub) = wv; }
    }
    __syncthreads();
}

__global__ void __launch_bounds__(NWAVES * 64, 2) hymba_fwd(Args args) {
    extern __shared__ __attribute__((aligned(16))) unsigned char lds[];
    Frame F;
    F.lds = (LAS unsigned char*)lds;
    F.MISC = (volatile LAS unsigned*)(F.lds + MISC_OFF);
    F.tid = threadIdx.x; F.lane = F.tid & 63; F.wave = __builtin_amdgcn_readfirstlane(F.tid >> 6);
    F.G = gridDim.x; { const int bx = blockIdx.x; F.vcu = (F.G % 8 == 0) ? (bx % 8) * (F.G / 8) + bx / 8 : bx; }
    F.out = args.out; F.ws = args.ws; const Args& A = args;
    unsigned char* ws = args.ws;
    F.ctl = (gu32*)(ws + WS_CTL);
    for (int u = F.tid; u < (LDS_BYTES - LDSCTL_OFF) / 4; u += NWAVES * 64) ((LAS unsigned*)(F.lds + LDSCTL_OFF))[u] = 0u;
    __syncthreads();
    if (F.tid < 22) { const unsigned long long* ka = (const unsigned long long*)__builtin_amdgcn_kernarg_segment_ptr();
        ((volatile LAS unsigned long long*)(F.lds + LDSCTL_OFF))[F.tid] = ka[F.tid]; }
    __syncthreads();
    XcdBarrier bar; bar.bar = (unsigned*)(F.ctl + CW_BAR); bar.x = 0; bar.st = nullptr;
    if (N_LAUNCHES == 1) bar = xcd_barrier_post((unsigned*)(F.ctl + CW_BAR), F.MISC + 8);
#define GRID_BAR() do { if (N_LAUNCHES == 1) xcd_barrier(bar); } while (0)
    const int lo = args.ph_lo, hi = args.ph_hi;
#define IN(k) (lo <= (k) && (k) < hi)
#define BOTH(k) (IN(k) && IN((k) + 1))
    const int c = (int)blockIdx.x;

    if (IN(0)) { p0_prologue(F, A); if (BOTH(0)) GRID_BAR(); }

    if (IN(1)) {
        pg8::Gemm g{(const bf16*)(ws + WS_XB), (const bf16*)(ws + WS_W1UP), MP, 2 * FF, DM}; pg8::StaticOrder S; S.init(MP, 2 * FF, F.G, c);
        pg8::EpiSwiGLU<false> E{(bf16*)(ws + WS_H), FF, nullptr, nullptr, nullptr, 0u};
        pg8::gemm_phase<pg8::EpiSwiGLU<false>, pg8::StaticOrder, true, true>(F.lds + RING_OFF, g, S, E);
        finalize_cvec(F, 0);
        thin_stage<1>(F, A, F.G - 1 - F.vcu, F.G);
        if (BOTH(1)) GRID_BAR();
    }
    if (IN(2)) {
        pg8::Gemm g{(const bf16*)(ws + WS_H), (const bf16*)(ws + WS_W1DN), MP, DM, FF}; pg8::StaticOrder S; S.init(MP, DM, F.G, c);
        pg8::EpiZ<0, true> E{(const bf16*)(ws + WS_XB), nullptr, nullptr, nullptr, (bf16*)(ws + WS_Z1), (float*)(ws + WS_STZ1), (unsigned)(size_t)(F.lds + XLDS_OFF)};
        pg8::gemm_phase<pg8::EpiZ<0, true>, pg8::StaticOrder, true, true>(F.lds + RING_OFF, g, S, E);
        thin_stage<2>(F, A, F.G - 1 - F.vcu, F.G);
        if (BOTH(2)) GRID_BAR();
    }
    if (IN(3)) {
        pg8::EpiWin E{(bf16*)(ws + WS_U), (bf16*)(ws + WS_GV), (bf16*)(ws + WS_Q), (bf16*)(ws + WS_K), (bf16*)(ws + WS_VT), (bf16*)(ws + WS_QI), (bf16*)(ws + WS_KI),
                      (float*)(ws + WS_GVST), (float*)(ws + WS_WI), F.out + OUT_KP, F.out + OUT_VP, F.out + OUT_KIP, (const float*)(ws + WS_ROPEC), (const float*)(ws + WS_ROPES),
                      (const float*)(ws + WS_STZ1), (const float*)(ws + CV_C1IN), (const float*)(ws + CV_C2IN), (unsigned)(size_t)(F.lds + XLDS_OFF + 8192), 0};
        { pg8::Gemm g{(const bf16*)(ws + WS_Z1), (const bf16*)(ws + WS_WIN), MP, 2048, DM}; pg8::StaticOrder S; S.init(MP, 2048, F.G, c);
          pg8::gemm_phase<pg8::EpiWin, pg8::StaticOrder, true, true>(F.lds + RING_OFF, g, S, E); }
        __syncthreads();
        { pg8::Gemm g{(const bf16*)(ws + WS_Z1), (const bf16*)(ws + WS_WIN) + (size_t)2048 * DM, MP, 256, DM}; pg8::StaticOrder S; S.init(MP, 256, F.G, c);
          E.pn_off = 8;
          pg8::gemm_phase<pg8::EpiWin, pg8::StaticOrder, true, true, true>(F.lds + RING_OFF, g, S, E); }
        if (c >= 128) { thin_stage<3>(F, A, c - 128, 128); p0_wout(F, A, c - 128, 128); }
        if (BOTH(3)) GRID_BAR();
    }
    if (IN(4)) {
#ifndef PROBE_Q_DUP
#define PROBE_Q_DUP 0
#endif
        constexpr int N_SMP = NS * (PROBE_Q_DUP == 1 ? 2 : 1), N_ATT = NB * 32 * (PROBE_Q_DUP == 2 ? 2 : 1), N_GM = NB * 16 * 4 * (PROBE_Q_DUP == 3 ? 2 : 1);
        constexpr int Q_SAMPLE = N_SMP, Q_ATTN = Q_SAMPLE + N_ATT, Q_GM = Q_ATTN + N_GM, Q_TOTAL = Q_GM + LATE_UNITS;
        gu32* qhead = F.ctl + CW_QUEUE; volatile LAS unsigned* qslot = F.MISC + 16;
        if (F.tid == 0) qslot[0] = __hip_atomic_fetch_add(qhead, 1u, RLX_AGENT);
        __syncthreads();
        int item = __builtin_amdgcn_readfirstlane((int)qslot[0]); int par = 0;
        while (item < Q_TOTAL) {
            unsigned nxt = 0u; if (F.tid == 0) nxt = __hip_atomic_fetch_add(qhead, 1u, RLX_AGENT);
            if (item < Q_SAMPLE) sample_unit(F, A, item % NS);
            else if (item < Q_ATTN) { const int i = (item - Q_SAMPLE) % (NB * 32); topk_attn_unit(F, i & 15, 31 - (i >> 4)); }
            else if (item < Q_GM) { const int L = (item - Q_ATTN) % (NB * 16 * 4); gmlp_unit(F, A, L >> 6, (L >> 2) & 15, L & 3); }
            else late_weight_unit(F, A, item - Q_GM);
            par ^= 1; if (F.tid == 0) qslot[par] = nxt;
            __syncthreads();
            item = __builtin_amdgcn_readfirstlane((int)qslot[par]);
        }
        if (BOTH(4)) GRID_BAR();
    }
    if (IN(5)) {
        pg8::Gemm g{(const bf16*)(ws + WS_MIX), (const bf16*)(ws + WS_WOUT), MP, DM, DM}; pg8::StaticOrder S; S.init(MP, DM, F.G, c);
        pg8::EpiZ<1, false> E{(const bf16*)(ws + WS_Z1), (const float*)(ws + WS_STZ1), IN_F(I_LN1G), IN_F(I_LN1B), (bf16*)(ws + WS_Z2), (float*)(ws + WS_STZ2), (unsigned)(size_t)(F.lds + XLDS_OFF)};
        pg8::gemm_phase<pg8::EpiZ<1, false>, pg8::StaticOrder, true, true>(F.lds + RING_OFF, g, S, E);
        finalize_cvec(F, 1);
        thin_stage<6>(F, A, F.G - 1 - F.vcu, F.G);
        if (BOTH(5)) GRID_BAR();
    }
    if (IN(6)) {
        pg8::Gemm g{(const bf16*)(ws + WS_Z2), (const bf16*)(ws + WS_W2UP), MP, 2 * FF, DM}; pg8::StaticOrder S; S.init(MP, 2 * FF, F.G, c);
        pg8::EpiSwiGLU<true> E{(bf16*)(ws + WS_H), FF, (const float*)(ws + WS_STZ2), (const float*)(ws + CV_C1UP), (const float*)(ws + CV_C2UP), (unsigned)(size_t)(F.lds + XLDS_OFF + 8192)};
        pg8::gemm_phase<pg8::EpiSwiGLU<true>, pg8::StaticOrder, true, true>(F.lds + RING_OFF, g, S, E);
        thin_stage<7>(F, A, F.G - 1 - F.vcu, F.G);
        if (BOTH(6)) GRID_BAR();
    }
    if (IN(7)) {
        pg8::Gemm g{(const bf16*)(ws + WS_H), (const bf16*)(ws + WS_W2DN), MP, DM, FF}; pg8::StaticOrder S; S.init(MP, DM, F.G, c);
        pg8::EpiZ<1, true> E{(const bf16*)(ws + WS_Z2), (const float*)(ws + WS_STZ2), IN_F(I_LN2G), IN_F(I_LN2B), (bf16*)(ws + WS_Z3), (float*)(ws + WS_STZ3), (unsigned)(size_t)(F.lds + XLDS_OFF)};
        pg8::gemm_phase<pg8::EpiZ<1, true>, pg8::StaticOrder, true, true>(F.lds + RING_OFF, g, S, E);
        thin_stage<8>(F, A, F.G - 1 - F.vcu, F.G);
        if (BOTH(7)) GRID_BAR();
    }
    if (IN(8)) { thin_final_ln(F, A); final_ln_rows(F, A); }
#undef IN
#undef BOTH
#undef GRID_BAR
}

extern "C" void kernel_launch(void* const* d_in, const int* in_sizes, int n_in, void* d_out, int out_size, void* d_ws, size_t ws_size, hipStream_t stream) {
    static int grid = 0;
    if (grid == 0) {
        if (n_in != 22 || in_sizes[0] != MP * DM || (size_t)out_size != OUT_TOTAL || ws_size < WS_END) {
            fprintf(stderr, "kernel_launch: unexpected shapes (n_in %d, in0 %d, out %d, ws %zu); nothing launched\n", n_in, n_in > 0 ? in_sizes[0] : -1, out_size, ws_size); grid = -1; return; }
        int dev = 0, cus = 0, per_cu = 0;
        if (hipGetDevice(&dev) != hipSuccess || hipDeviceGetAttribute(&cus, hipDeviceAttributeMultiprocessorCount, dev) != hipSuccess) { fprintf(stderr, "kernel_launch: device query failed\n"); grid = -1; return; }
        if (hipFuncSetAttribute((const void*)hymba_fwd, hipFuncAttributeMaxDynamicSharedMemorySize, LDS_BYTES) != hipSuccess) { fprintf(stderr, "kernel_launch: hipFuncSetAttribute failed\n"); grid = -1; return; }
        if (hipOccupancyMaxActiveBlocksPerMultiprocessor(&per_cu, (const void*)hymba_fwd, NWAVES * 64, LDS_BYTES) != hipSuccess || per_cu < 1)
            fprintf(stderr, "kernel_launch: note: occupancy query reports %d workgroups per CU\n", per_cu);
        (void)hipGetLastError();
        grid = cus;
        if (grid != 256) fprintf(stderr, "kernel_launch: %d CUs; the fused LayerNorm phases need 256 workgroups: output will be NaN\n", grid);
    }
    if (grid < 0) return;
    if (hipMemsetAsync((char*)d_ws + WS_CTL, 0, CTL_ZERO_BYTES, stream) != hipSuccess) { fprintf(stderr, "kernel_launch: memset failed\n"); return; }
    Args a{};
    for (int i = 0; i < 22; ++i) a.in[i] = d_in[i];
    a.out = (float*)d_out; a.ws = (unsigned char*)d_ws;
    for (int li = 0; li < N_LAUNCHES; ++li) {
        a.ph_lo = (N_LAUNCHES == 1) ? 0 : li; a.ph_hi = (N_LAUNCHES == 1) ? N_PHASES : li + 1;
        hipLaunchKernelGGL(hymba_fwd, dim3(grid), dim3(NWAVES * 64), LDS_BYTES, stream, a);
        const hipError_t le = hipPeekAtLastError();
        if (le != hipSuccess) { fprintf(stderr, "kernel_launch: launch %d failed: %s\n", li, hipGetErrorName(le)); break; }
    }
}
```

```cpp
#include <hip/hip_runtime.h>
#include <cstdio>
#include <cstdint>
namespace pg8 {
#define PG8_LAS __attribute__((address_space(3)))
typedef unsigned short bf16_t;
typedef short bf16x8 __attribute__((ext_vector_type(8)));
typedef float f32x4 __attribute__((ext_vector_type(4)));
typedef unsigned u32x4 __attribute__((ext_vector_type(4)));
constexpr int BM = 256, BK = 64, HALF = 128, HTB = HALF * BK * 2  , STAGE_BYTES = 8 * HTB, NXCD = 8, WGM = 8;

__host__ __device__ __forceinline__ int lds_byte(int r, int c) { const int st = (r >> 4) * 2 + (c >> 5), rr = r & 15, cc = c & 31, ob = rr * 64 + cc * 2; return st * 1024 + (ob ^ (((ob >> 9) & 1) << 5)); }
__host__ __device__ __forceinline__ void stage_rc(int b, int& R, int& C) { const int st = b / 1024, sb = b % 1024, swz = sb ^ (((sb >> 9) & 1) << 5); R = (st >> 1) * 16 + swz / 64; C = (st & 1) * 32 + (swz % 64) / 2; }
__host__ __device__ __forceinline__ int perm32(int rho) { const int n = rho >> 4, i = rho & 15; return 8 * (i >> 2) + 4 * n + (i & 3); }

struct Unit { int pm, pn; };
struct Gemm { const bf16_t* A; const bf16_t* Bt; int M, N, K; };

struct StaticOrder {
    int nM, nN, nwg, G, c;
    __host__ __device__ void init(int M, int N, int G_, int c_) { nM = M / BM; nN = N / BM; nwg = nM * nN; G = G_; c = c_; }
    __host__ __device__ bool next(int i, Unit& u) const {
        const long L = (long)i * G + c; if (L >= nwg) return false;
        int wgid = (int)L; { const int q = nwg / NXCD, r = nwg % NXCD, xcd = wgid % NXCD, off = wgid / NXCD; wgid = (xcd < r ? xcd * (q + 1) : r * (q + 1) + (xcd - r) * q) + off; }
        const int nig = WGM * nN, gid = wgid / nig, fm = gid * WGM, gsz = (nM - fm) < WGM ? (nM - fm) : WGM;
        u.pm = fm + ((wgid % nig) % gsz); u.pn = (wgid % nig) / gsz; return true;
    }
    __device__ __forceinline__ void a_ready(const Unit&) const {}
    __device__ __forceinline__ void done(const Unit&) const {}
};

__device__ __forceinline__ unsigned cvt_pk_bf16(float lo, float hi) { unsigned r; asm volatile("v_cvt_pk_bf16_f32 %0, %1, %2" : "=v"(r) : "v"(lo), "v"(hi)); return r; }
typedef float f32x2 __attribute__((ext_vector_type(2)));
template <class Epi, class Sched, bool ALIGN_EPI = false, bool SP2 = false, bool HALF_N = false>
__device__ __forceinline__ void gemm_phase(PG8_LAS unsigned char* lds, const Gemm g, const Sched& S, const Epi& E) {
    int tid_ = threadIdx.x; asm volatile("" : "+v"(tid_));
    const int tid = tid_, wid = __builtin_amdgcn_readfirstlane(tid >> 6), lane = tid & 63, wr = wid >> 2, wc = wid & 3, fr = lane & 15, fq = lane >> 4;
    const int K = g.K, nt = K / BK;
    unsigned voffA[2], voffB[2];
#pragma unroll
    for (int i = 0; i < 2; ++i) { int R, C; stage_rc(tid * 16 + i * 8192, R, C); const int Rb = Epi::PERM ? ((R & ~31) + perm32(R & 31)) : R;
        voffA[i] = (unsigned)(R * K + C) * 2u; voffB[i] = (unsigned)(Rb * K + C) * 2u; }
    const size_t kstep = (size_t)(BK * 2);
    const size_t hstep = (size_t)HALF * K * 2;
    const size_t tstep = 2 * hstep;
    const unsigned ldsw = (unsigned)wid * 1024u;
    const int aoff = lds_byte(wr * 64 + fr, fq * 8), boff = lds_byte(wc * 32 + fr, fq * 8);
#define PG8_SA(b, h) (((b) * 2 + (h)) * HTB)
#define PG8_SB(b, h) ((4 + (b) * 2 + (h)) * HTB)
#define PG8_STAGE(bufoff, gbase, voff) do { _Pragma("unroll") for (int _i = 0; _i < 2; ++_i) \
        __builtin_amdgcn_global_load_lds((const unsigned*)((const char*)(gbase) + (voff)[_i]), (PG8_LAS unsigned*)(lds + (bufoff) + ldsw + _i * 8192), 16, 0, 0); } while (0)
#define PG8_LDA(dst, b, h) do { _Pragma("unroll") for (int m = 0; m < 4; ++m) _Pragma("unroll") for (int k = 0; k < 2; ++k) dst[m][k] = *(const PG8_LAS bf16x8*)(lds + PG8_SA(b, h) + aoff + m * 2048 + k * 1024); } while (0)
#define PG8_LDB(dst, b, h) do { _Pragma("unroll") for (int n = 0; n < 2; ++n) _Pragma("unroll") for (int k = 0; k < 2; ++k) dst[n][k] = *(const PG8_LAS bf16x8*)(lds + PG8_SB(b, h) + boff + n * 2048 + k * 1024); } while (0)
#define PG8_MMA(ai, bj, At, Bt) do { __builtin_amdgcn_s_setprio(1); _Pragma("unroll") for (int m = 0; m < 4; ++m) _Pragma("unroll") for (int n = 0; n < 2; ++n) _Pragma("unroll") for (int k = 0; k < 2; ++k) \
        acc[ai][bj][m][n] = __builtin_amdgcn_mfma_f32_16x16x32_bf16(Bt[n][k], At[m][k], acc[ai][bj][m][n], 0, 0, 0); __builtin_amdgcn_s_setprio(0); } while (0)
#define PG8_WAIT_V(n) asm volatile("s_waitcnt vmcnt(" #n ")" ::: "memory")
#define PG8_WAIT_L(n) asm volatile("s_waitcnt lgkmcnt(" #n ")" ::: "memory")
#define PG8_BAR __builtin_amdgcn_s_barrier()
#define PG8_SCHED __builtin_amdgcn_sched_barrier(0)
    Unit cur, nxt; int ui = 0;
    if (!S.next(0, cur)) return;
    f32x4 acc[2][2][4][2];
#pragma unroll
    for (int a = 0; a < 2; ++a)
#pragma unroll
        for (int b = 0; b < 2; ++b)
#pragma unroll
            for (int m = 0; m < 4; ++m)
#pragma unroll
                for (int n = 0; n < 2; ++n) acc[a][b][m][n] = (f32x4){0.f, 0.f, 0.f, 0.f};
    bf16x8 At[4][2], B0[2][2], B1[2][2];
    const char* cA = (const char*)g.A + (size_t)cur.pm * tstep; const char* cB = (const char*)g.Bt + (size_t)cur.pn * tstep;
    S.a_ready(cur);
    if constexpr (SP2) {
        PG8_STAGE(PG8_SB(0, 0), cB, voffB); PG8_STAGE(PG8_SB(0, 1), cB + hstep, voffB); PG8_STAGE(PG8_SA(0, 0), cA, voffA); PG8_STAGE(PG8_SA(0, 1), cA + hstep, voffA);
        if (wr == 1) PG8_BAR;
        PG8_WAIT_V(2); PG8_BAR;
        PG8_STAGE(PG8_SB(1, 0), cB + kstep, voffB); PG8_STAGE(PG8_SA(1, 0), cA + kstep, voffA); PG8_STAGE(PG8_SB(1, 1), cB + hstep + kstep, voffB);
        PG8_WAIT_V(6); PG8_BAR;
    } else {
        PG8_STAGE(PG8_SB(0, 0), cB, voffB); PG8_STAGE(PG8_SA(0, 0), cA, voffA); PG8_STAGE(PG8_SB(0, 1), cB + hstep, voffB); PG8_STAGE(PG8_SA(0, 1), cA + hstep, voffA);
        if (wr == 1) PG8_BAR;
        PG8_WAIT_V(4); PG8_BAR;
        PG8_STAGE(PG8_SB(1, 0), cB + kstep, voffB); PG8_STAGE(PG8_SA(1, 0), cA + kstep, voffA); PG8_STAGE(PG8_SB(1, 1), cB + hstep + kstep, voffB);
        PG8_WAIT_V(6); PG8_BAR;
    }
    for (;;) {
        const bool has_next = S.next(ui + 1, nxt);
        const char* nA = has_next ? (const char*)g.A + (size_t)nxt.pm * tstep : cA; const char* nB = has_next ? (const char*)g.Bt + (size_t)nxt.pn * tstep : cB;
        for (int t = 0; t < nt; t += 2) {
            const bool last = (t == nt - 2);
            const char* a1 = cA + (size_t)(t + 1) * kstep;
            const char* a2 = last ? nA : cA + (size_t)(t + 2) * kstep; const char* b2 = last ? nB : cB + (size_t)(t + 2) * kstep;
            const char* a3 = a2 + kstep; const char* b3 = b2 + kstep;
            if (last && has_next) S.a_ready(nxt);
            if constexpr (SP2) {
            PG8_LDB(B0, 0, 0); if constexpr (!HALF_N) PG8_LDB(B1, 0, 1); PG8_SCHED; PG8_LDA(At, 0, 0); PG8_STAGE(PG8_SA(1, 1), a1 + hstep, voffA);
            PG8_WAIT_V(8); PG8_WAIT_L(0); PG8_BAR; PG8_MMA(0, 0, At, B0); if constexpr (!HALF_N) PG8_MMA(0, 1, At, B1); PG8_BAR; PG8_SCHED;
            PG8_LDA(At, 0, 1); PG8_STAGE(PG8_SB(0, 0), b2, voffB); PG8_STAGE(PG8_SB(0, 1), b2 + hstep, voffB); PG8_STAGE(PG8_SA(0, 0), a2, voffA);
            PG8_WAIT_V(8); PG8_WAIT_L(0); PG8_BAR; PG8_MMA(1, 0, At, B0); if constexpr (!HALF_N) PG8_MMA(1, 1, At, B1); PG8_BAR; PG8_SCHED;
            PG8_LDB(B0, 1, 0); if constexpr (!HALF_N) PG8_LDB(B1, 1, 1); PG8_SCHED; PG8_LDA(At, 1, 0); PG8_STAGE(PG8_SA(0, 1), a2 + hstep, voffA);
            PG8_WAIT_V(8); PG8_WAIT_L(0); PG8_BAR; PG8_MMA(0, 0, At, B0); if constexpr (!HALF_N) PG8_MMA(0, 1, At, B1); PG8_BAR; PG8_SCHED;
            PG8_LDA(At, 1, 1); PG8_STAGE(PG8_SB(1, 0), b3, voffB); PG8_STAGE(PG8_SB(1, 1), b3 + hstep, voffB); PG8_STAGE(PG8_SA(1, 0), a3, voffA);
            PG8_WAIT_V(8); PG8_WAIT_L(0); PG8_BAR; PG8_MMA(1, 0, At, B0); if constexpr (!HALF_N) PG8_MMA(1, 1, At, B1); PG8_BAR; PG8_SCHED;
            } else {
            PG8_LDB(B0, 0, 0); PG8_SCHED; PG8_LDA(At, 0, 0); PG8_STAGE(PG8_SA(1, 1), a1 + hstep, voffA);
            PG8_WAIT_L(8); PG8_BAR; PG8_WAIT_L(0); PG8_MMA(0, 0, At, B0); PG8_BAR; PG8_SCHED;
            PG8_LDB(B1, 0, 1); PG8_STAGE(PG8_SB(0, 0), b2, voffB);
            PG8_BAR; PG8_WAIT_L(0); PG8_MMA(0, 1, At, B1); PG8_BAR;
            PG8_LDA(At, 0, 1); PG8_STAGE(PG8_SA(0, 0), a2, voffA);
            PG8_BAR; PG8_WAIT_L(0); PG8_MMA(1, 0, At, B0); PG8_BAR; PG8_SCHED;
            PG8_STAGE(PG8_SB(0, 1), b2 + hstep, voffB);
            PG8_WAIT_V(6); PG8_BAR; PG8_MMA(1, 1, At, B1); PG8_BAR;
            PG8_LDB(B0, 1, 0); PG8_SCHED; PG8_LDA(At, 1, 0); PG8_STAGE(PG8_SA(0, 1), a2 + hstep, voffA);
            PG8_WAIT_L(8); PG8_BAR; PG8_WAIT_L(0); PG8_MMA(0, 0, At, B0); PG8_BAR; PG8_SCHED;
            PG8_LDB(B1, 1, 1); PG8_STAGE(PG8_SB(1, 0), b3, voffB);
            PG8_BAR; PG8_WAIT_L(0); PG8_MMA(0, 1, At, B1); PG8_BAR;
            PG8_LDA(At, 1, 1); PG8_STAGE(PG8_SA(1, 0), a3, voffA);
            PG8_BAR; PG8_WAIT_L(0); PG8_MMA(1, 0, At, B0); PG8_BAR; PG8_SCHED;
            PG8_STAGE(PG8_SB(1, 1), b3 + hstep, voffB);
            PG8_WAIT_V(6); PG8_BAR; PG8_MMA(1, 1, At, B1); PG8_BAR;
            }
        }
        if constexpr (ALIGN_EPI) { if (wr == 0) PG8_BAR; }
        if constexpr (!Epi::AFTER_DRAIN) { E(acc, cur, wr, wc, fr, fq); S.done(cur); }
        if (!has_next) break;
#pragma unroll
        for (int a = 0; a < 2; ++a)
#pragma unroll
            for (int b = 0; b < 2; ++b)
#pragma unroll
                for (int m = 0; m < 4; ++m)
#pragma unroll
                    for (int n = 0; n < 2; ++n) acc[a][b][m][n] = (f32x4){0.f, 0.f, 0.f, 0.f};
        cur = nxt; cA = nA; cB = nB; ++ui;
        if constexpr (ALIGN_EPI) { if (wr == 1) PG8_BAR; }
    }
    PG8_WAIT_V(0);
    if constexpr (!ALIGN_EPI) { if (wr == 0) PG8_BAR; }
    PG8_BAR;
    if constexpr (Epi::AFTER_DRAIN) { E.fused(acc, cur, wr, wc, fr, fq, lds, wid, lane); S.done(cur); }
#undef PG8_SA
#undef PG8_SB
#undef PG8_STAGE
#undef PG8_LDA
#undef PG8_LDB
#undef PG8_MMA
#undef PG8_WAIT_V
#undef PG8_WAIT_L
#undef PG8_BAR
#undef PG8_SCHED
}
}
namespace pg8 {
typedef unsigned u32x2 __attribute__((ext_vector_type(2)));
constexpr float kAlpha = 1.189207115002721f;
__device__ __forceinline__ float silu_f(float x) { return x * __builtin_amdgcn_rcpf(1.f + __builtin_amdgcn_exp2f(-1.4426950408889634f * x)); }
__device__ __forceinline__ float gelu_f(float x) { const float t = x * (1.f + 0.044715f * x * x); return x * __builtin_amdgcn_rcpf(1.f + __builtin_amdgcn_exp2f(-2.3022081981f * t)); }
__device__ __forceinline__ f32x4 sigmoid_scaled4(const f32x4 t) {
    const f32x4 e = (f32x4){__builtin_amdgcn_exp2f(t[0]), __builtin_amdgcn_exp2f(t[1]), __builtin_amdgcn_exp2f(t[2]), __builtin_amdgcn_exp2f(t[3])} + 1.0f;
    return (f32x4){__builtin_amdgcn_rcpf(e[0]), __builtin_amdgcn_rcpf(e[1]), __builtin_amdgcn_rcpf(e[2]), __builtin_amdgcn_rcpf(e[3])};
}
__device__ __forceinline__ f32x4 silu4(const f32x4 x) { return x * sigmoid_scaled4(x * -1.4426950408889634f); }
__device__ __forceinline__ f32x4 gelu4(const f32x4 x) { return x * sigmoid_scaled4((x * (x * x * 0.044715f + 1.0f)) * -2.3022081981f); }
__device__ __forceinline__ u32x4 pack8(const f32x4 a, const f32x4 b) { u32x4 w; w.x = cvt_pk_bf16(a[0], a[1]); w.y = cvt_pk_bf16(a[2], a[3]); w.z = cvt_pk_bf16(b[0], b[1]); w.w = cvt_pk_bf16(b[2], b[3]); return w; }
__device__ __forceinline__ f32x4 unpack4(const u32x2 w) { f32x4 r; r[0] = __uint_as_float(w.x << 16); r[1] = __uint_as_float(w.x & 0xffff0000u); r[2] = __uint_as_float(w.y << 16); r[3] = __uint_as_float(w.y & 0xffff0000u); return r; }

__device__ __forceinline__ void stats_from(const f32x4 a, const f32x4 b, float& mean, float& rstd) {
    mean = ((a[0] + a[2]) + (b[0] + b[2])) * 0.25f;
    const float d0 = a[0] - mean, d1 = a[2] - mean, d2 = b[0] - mean, d3 = b[2] - mean;
    rstd = 1.0f / sqrtf((((a[1] + a[3]) + (b[1] + b[3])) + 256.f * ((d0 * d0 + d1 * d1) + (d2 * d2 + d3 * d3))) * (1.f / 1024.f) + 1e-5f);
}
typedef float f32x2t __attribute__((ext_vector_type(2)));
__device__ __forceinline__ void panel_stats_to_lds(const float* st, int pm, PG8_LAS f32x2t* T, int tid) {
    if (tid < 256) { const size_t row = (size_t)(pm * BM + tid); float mean, rstd; stats_from(*(const f32x4*)(st + row * 8), *(const f32x4*)(st + row * 8 + 4), mean, rstd); T[tid] = (f32x2t){mean, rstd}; }
    asm volatile("s_waitcnt lgkmcnt(0)" ::: "memory"); __builtin_amdgcn_s_barrier(); asm volatile("" ::: "memory");
}
__device__ __forceinline__ void fold_ln(f32x4 (&acc)[2][2][4][2], const float* st, const float* c1, const float* c2, const Unit& u, int wr, int wc, int fr, int fq, unsigned tlds) {
    PG8_LAS f32x2t* T = (PG8_LAS f32x2t*)(size_t)tlds;
    const int rl0 = wr * 64 + fr, col0 = u.pn * BM + wc * 32 + 8 * fq;
    f32x4 c1v[2][2], c2v[2][2];
#pragma unroll
    for (int bj = 0; bj < 2; ++bj)
#pragma unroll
        for (int n = 0; n < 2; ++n) { c1v[bj][n] = *(const f32x4*)(c1 + col0 + bj * HALF + 4 * n); c2v[bj][n] = *(const f32x4*)(c2 + col0 + bj * HALF + 4 * n); }
    __builtin_amdgcn_sched_barrier(0);
    panel_stats_to_lds(st, u.pm, T, (wr * 4 + wc) * 64 + fq * 16 + fr);
#pragma unroll
    for (int ai = 0; ai < 2; ++ai)
#pragma unroll
        for (int m = 0; m < 4; ++m) { const f32x2t t = T[ai * HALF + m * 16 + rl0]; const float tq = -t.y * t.x;
#pragma unroll
            for (int bj = 0; bj < 2; ++bj)
#pragma unroll
                for (int n = 0; n < 2; ++n) acc[ai][bj][m][n] = acc[ai][bj][m][n] * t.y + (c1v[bj][n] * tq + c2v[bj][n]); }
}

template <int RESMODE, bool HALFACC> struct EpiZ {
    static constexpr bool PERM = true, AFTER_DRAIN = false;
    const bf16_t* res; const float* stprev; const float* gamma; const float* beta; bf16_t* Z; float* ST; unsigned xlds; static constexpr float racc = HALFACC ? 0.5f : 1.0f;
    __device__ __forceinline__ void operator()(f32x4 (&acc)[2][2][4][2], const Unit& u, int wr, int wc, int fr, int fq) const {
        asm volatile("" : "+v"(fr), "+v"(fq));
        typedef float f32x2v __attribute__((ext_vector_type(2)));
        PG8_LAS f32x2v* P = (PG8_LAS f32x2v*)(size_t)xlds;
        const int rl0 = wr * 64 + fr, col0 = u.pn * BM + wc * 32 + 8 * fq;
        PG8_LAS f32x2t* T = (PG8_LAS f32x2t*)(size_t)(xlds + 8192);
        f32x4 gmm[2][2], btt[2][2];
        if (RESMODE == 1) {
#pragma unroll
            for (int bj = 0; bj < 2; ++bj) { const float* gp = gamma + col0 + bj * HALF; const float* bp = beta + col0 + bj * HALF;
                gmm[bj][0] = *(const f32x4*)gp; gmm[bj][1] = *(const f32x4*)(gp + 4); btt[bj][0] = *(const f32x4*)bp; btt[bj][1] = *(const f32x4*)(bp + 4); } }
        if (RESMODE == 1) panel_stats_to_lds(stprev, u.pm, T, (wr * 4 + wc) * 64 + fq * 16 + fr);
#pragma unroll
        for (int ai = 0; ai < 2; ++ai) {
            u32x4 raw[4][2];
#pragma unroll
            for (int m = 0; m < 4; ++m) { const size_t off = (size_t)(u.pm * BM + ai * HALF + m * 16 + rl0) * 1024 + col0;
                raw[m][0] = *(const u32x4*)(res + off); raw[m][1] = *(const u32x4*)(res + off + HALF); }
            __builtin_amdgcn_sched_barrier(0);
#pragma unroll
            for (int m = 0; m < 4; ++m) { const int rl = ai * HALF + m * 16 + rl0; const size_t off = (size_t)(u.pm * BM + rl) * 1024 + col0;
                float mu = 0.f, rs = 1.f; if (RESMODE == 1) { const f32x2t t = T[rl]; mu = t.x; rs = t.y; }
                float s = 0.f, q = 0.f;
#pragma unroll
                for (int bj = 0; bj < 2; ++bj) { const u32x4 rw = raw[m][bj];
                    f32x4 r0 = unpack4((u32x2){rw.x, rw.y}), r1 = unpack4((u32x2){rw.z, rw.w});
                    if (RESMODE == 1) { r0 = (r0 - mu) * rs * gmm[bj][0] + btt[bj][0]; r1 = (r1 - mu) * rs * gmm[bj][1] + btt[bj][1]; }
                    const f32x4 z0 = r0 * kAlpha + acc[ai][bj][m][0] * racc, z1 = r1 * kAlpha + acc[ai][bj][m][1] * racc;
                    *(u32x4*)(Z + off + bj * HALF) = pack8(z0, z1);
#pragma unroll
                    for (int i = 0; i < 4; ++i) { s += z0[i] + z1[i]; q += z0[i] * z0[i] + z1[i] * z1[i]; } }
                s += __shfl_xor(s, 16); s += __shfl_xor(s, 32); q += __shfl_xor(q, 16); q += __shfl_xor(q, 32);
                const float mw = s * (1.0f / 64.0f); q = fmaxf(q - s * mw, 0.f);
                if (fq == 0) P[rl * 4 + wc] = (f32x2v){mw, q}; }
            asm volatile("" ::: "memory"); }
        asm volatile("s_waitcnt lgkmcnt(0)" ::: "memory"); __builtin_amdgcn_s_barrier(); asm volatile("" ::: "memory");
        const int tid = (wr * 4 + wc) * 64 + fq * 16 + fr;
        if (tid < 256) { const f32x2v a = P[tid * 4 + 0], b = P[tid * 4 + 1], c = P[tid * 4 + 2], d = P[tid * 4 + 3];
            const float mt = ((a.x + b.x) + (c.x + d.x)) * 0.25f; const float da = a.x - mt, db = b.x - mt, dc = c.x - mt, dd = d.x - mt;
            const float m2 = ((a.y + b.y) + (c.y + d.y)) + 64.0f * ((da * da + db * db) + (dc * dc + dd * dd));
            *(f32x2v*)(ST + ((size_t)(u.pm * BM + tid) * 4 + u.pn) * 2) = (f32x2v){mt, m2}; }
        asm volatile("s_waitcnt lgkmcnt(0)" ::: "memory"); __builtin_amdgcn_s_barrier(); asm volatile("" ::: "memory");
    }
};

template <bool FOLD> struct EpiSwiGLU {
    static constexpr bool PERM = true, AFTER_DRAIN = false;
    bf16_t* H; int ldh; const float* st; const float* c1; const float* c2; unsigned tlds;
    __device__ __forceinline__ void operator()(f32x4 (&acc)[2][2][4][2], const Unit& u, int wr, int wc, int fr, int fq) const {
        asm volatile("" : "+v"(fr), "+v"(fq));
        const int row0 = u.pm * BM + wr * 64 + fr, col0 = u.pn * HALF + wc * 32 + 8 * fq;
        if (FOLD) fold_ln(acc, st, c1, c2, u, wr, wc, fr, fq, tlds);
#pragma unroll
        for (int ai = 0; ai < 2; ++ai)
#pragma unroll
            for (int m = 0; m < 4; ++m) {
                const f32x4 h0 = silu4(acc[ai][0][m][0]) * acc[ai][1][m][0], h1 = silu4(acc[ai][0][m][1]) * acc[ai][1][m][1];
                *(u32x4*)(H + (size_t)(row0 + ai * HALF + m * 16) * ldh + col0) = pack8(h0, h1);
            }
    }
};

struct EpiWin {
    static constexpr bool PERM = true, AFTER_DRAIN = false;
    bf16_t *U, *GV, *Q, *Kb, *VT, *QI, *KI; float *GVST, *WI, *outK, *outV, *outKI; const float *ropeC, *ropeS; const float *st, *c1, *c2; unsigned tlds; int pn_off;
    __device__ __forceinline__ void operator()(f32x4 (&acc)[2][2][4][2], const Unit& u, int wr, int wc, int fr, int fq) const {
        asm volatile("" : "+v"(fr), "+v"(fq));
        const int pn = u.pn + pn_off, rl0 = wr * 64 + fr, rowb = u.pm * BM + rl0, cl = wc * 32 + 8 * fq;
        const int j0 = 4 * (4 * (wc & 1) + fq);
        PG8_LAS f32x2t* T = (PG8_LAS f32x2t*)(size_t)tlds;
        const float* c1p = c1 + pn * BM + cl; const float* c2p = c2 + pn * BM + cl;
        const bool roped = pn >= 4;
        f32x4 cc1[2][2], cc2[2][2];
#pragma unroll
        for (int bj = 0; bj < 2; ++bj)
#pragma unroll
            for (int n = 0; n < 2; ++n) { cc1[bj][n] = *(const f32x4*)(c1p + bj * HALF + 4 * n); cc2[bj][n] = *(const f32x4*)(c2p + bj * HALF + 4 * n); }
        f32x4 rc = (f32x4){1.f, 1.f, 1.f, 1.f}, rsn = (f32x4){0.f, 0.f, 0.f, 0.f};
        if (roped) { const int t0 = rowb & 2047; rc = *(const f32x4*)(ropeC + t0 * 32 + j0); rsn = *(const f32x4*)(ropeS + t0 * 32 + j0); }
        __builtin_amdgcn_sched_barrier(0);
        panel_stats_to_lds(st, u.pm, T, (wr * 4 + wc) * 64 + fq * 16 + fr);
#define WIN_ROW(ai, m) const f32x2t tr_ = T[(ai) * HALF + (m) * 16 + rl0]; const float tq_ = -tr_.y * tr_.x
#define WIN_F(ai, bj, m, n) (acc[ai][bj][m][n] * tr_.y + (cc1[bj][n] * tq_ + cc2[bj][n]))
#define WIN_ROPE_NEXT(ai, m) const f32x4 c = rc, s = rsn; if ((ai) * 4 + (m) < 7) { const int gn_ = (ai) * 4 + (m) + 1; const int tn_ = (rowb + (gn_ >> 2) * HALF + (gn_ & 3) * 16) & 2047; \
            rc = *(const f32x4*)(ropeC + tn_ * 32 + j0); rsn = *(const f32x4*)(ropeS + tn_ * 32 + j0); } __builtin_amdgcn_sched_barrier(0)
        if (pn < 2) {
#pragma unroll
            for (int ai = 0; ai < 2; ++ai)
#pragma unroll
                for (int m = 0; m < 4; ++m) { WIN_ROW(ai, m); bf16_t* p = U + (size_t)(rowb + ai * HALF + m * 16) * 512 + pn * 256 + cl;
#pragma unroll
                    for (int bj = 0; bj < 2; ++bj) { const f32x4 x0 = WIN_F(ai, bj, m, 0), x1 = WIN_F(ai, bj, m, 1);
                        *(u32x4*)(p + bj * HALF) = pack8(gelu4(x0), gelu4(x1)); } }
        } else if (pn < 4) {
#pragma unroll
            for (int ai = 0; ai < 2; ++ai)
#pragma unroll
                for (int m = 0; m < 4; ++m) { WIN_ROW(ai, m); const size_t row = (size_t)(rowb + ai * HALF + m * 16); bf16_t* p = GV + row * 512 + (pn - 2) * 256 + cl;
                    f32x4 g[2][2]; float s = 0.f;
#pragma unroll
                    for (int bj = 0; bj < 2; ++bj) {
#pragma unroll
                        for (int n = 0; n < 2; ++n) { g[bj][n] = gelu4(WIN_F(ai, bj, m, n)); s += (g[bj][n][0] + g[bj][n][1]) + (g[bj][n][2] + g[bj][n][3]); }
                        *(u32x4*)(p + bj * HALF) = pack8(g[bj][0], g[bj][1]); }
                    s += __shfl_xor(s, 16); s += __shfl_xor(s, 32);
                    const float mw = s * (1.0f / 64.0f); float q = 0.f;
#pragma unroll
                    for (int bj = 0; bj < 2; ++bj)
#pragma unroll
                        for (int n = 0; n < 2; ++n)
#pragma unroll
                            for (int i = 0; i < 4; ++i) { const float d = g[bj][n][i] - mw; q += d * d; }
                    q += __shfl_xor(q, 16); q += __shfl_xor(q, 32);
                    if (fq == 0) *(f32x2t*)(GVST + ((row * 2 + (pn - 2)) * 4 + wc) * 2) = (f32x2t){mw, q}; }
        } else if (pn == 4 || pn == 5 || pn == 7) {
            bf16_t* dst = (pn == 7) ? QI : Q + (pn - 4) * 256; const int ld = (pn == 7) ? 256 : 512;
            const float qsc = (pn == 7) ? 1.0f : 0.125f * 1.4426950408889634f;
#pragma unroll
            for (int ai = 0; ai < 2; ++ai)
#pragma unroll
                for (int m = 0; m < 4; ++m) { WIN_ROW(ai, m); const int row = rowb + ai * HALF + m * 16; WIN_ROPE_NEXT(ai, m);
#pragma unroll
                    for (int bj = 0; bj < 2; ++bj) { const f32x4 x1 = WIN_F(ai, bj, m, 0), x2 = WIN_F(ai, bj, m, 1);
                        *(u32x4*)(dst + (size_t)row * ld + bj * HALF + cl) = pack8((x1 * c - x2 * s) * qsc, (x2 * c + x1 * s) * qsc); } }
        } else if (pn == 6) {
#pragma unroll
            for (int ai = 0; ai < 2; ++ai)
#pragma unroll
                for (int m = 0; m < 4; ++m) { WIN_ROW(ai, m); const int row = rowb + ai * HALF + m * 16; const int t = row & 2047; WIN_ROPE_NEXT(ai, m);
                    const f32x4 x1 = WIN_F(ai, 0, m, 0), x2 = WIN_F(ai, 0, m, 1); const f32x4 o1 = x1 * c - x2 * s, o2 = x2 * c + x1 * s;
                    *(u32x4*)(Kb + (size_t)row * 128 + cl) = pack8(o1, o2);
                    float* ok = outK + (size_t)row * 128 + (wc >> 1) * 64 + j0; *(f32x4*)ok = o1; *(f32x4*)(ok + 32) = o2;
                    const f32x4 v0 = WIN_F(ai, 1, m, 0), v1 = WIN_F(ai, 1, m, 1);
                    float* ov = outV + (size_t)row * 128 + cl; *(f32x4*)ov = v0; *(f32x4*)(ov + 4) = v1;
                    *(u32x4*)(VT + (size_t)row * 128 + cl) = pack8(v0, v1); }
        } else {
            if (wc < 2) {
#pragma unroll
                for (int ai = 0; ai < 2; ++ai)
#pragma unroll
                    for (int m = 0; m < 4; ++m) { WIN_ROW(ai, m); const int row = rowb + ai * HALF + m * 16; WIN_ROPE_NEXT(ai, m);
                        const f32x4 x1 = WIN_F(ai, 0, m, 0), x2 = WIN_F(ai, 0, m, 1); const f32x4 o1 = x1 * c - x2 * s, o2 = x2 * c + x1 * s;
                        *(u32x4*)(KI + (size_t)row * 64 + cl) = pack8(o1, o2);
                        float* ok = outKI + (size_t)row * 64 + j0; *(f32x4*)ok = o1; *(f32x4*)(ok + 32) = o2; }
            } else if (wc == 2 && fq == 0) {
#pragma unroll
                for (int ai = 0; ai < 2; ++ai)
#pragma unroll
                    for (int m = 0; m < 4; ++m) { WIN_ROW(ai, m); const int row = rowb + ai * HALF + m * 16; *(f32x4*)(WI + (size_t)row * 4) = WIN_F(ai, 0, m, 0) * 0.0625f; }
            }
        }
#undef WIN_ROPE_NEXT
        __builtin_amdgcn_s_waitcnt(0x0F70);
#undef WIN_ROW
#undef WIN_F
    }
};
}
constexpr int NWAVES = 8;
#ifndef MK_N_LAUNCHES
#define MK_N_LAUNCHES 1
#endif
constexpr int N_PHASES = 9;
constexpr int N_LAUNCHES = MK_N_LAUNCHES;

constexpr int DM = 1024, NB = 16, SEQ = 2048, MP = NB * SEQ, NS = 128, FF = 2816, INW = 2116, INWP = 2304, PAST = 8192, NPAGE = 64;
constexpr float LN_EPS = 1e-5f, kAlpha = pg8::kAlpha;
constexpr size_t OUT_Y = 0, OUT_YS = 33554432, OUT_KP = 33685504, OUT_VP = 37879808, OUT_KIP = 42074112, OUT_KS = 44171264, OUT_VS = 44187648, OUT_KIS = 44204032, OUT_AV = 44212224, OUT_TOTAL = 44277760;

constexpr size_t MiB = 1u << 20;
constexpr size_t WS_CTL = 0, CTL_ZERO_BYTES = 1 * MiB;
constexpr size_t WS_ROPEC = 1 * MiB, WS_ROPES = WS_ROPEC + 2049 * 32 * 4;
constexpr size_t WS_W1UP = 2 * MiB, WS_W1DN = 13 * MiB, WS_WIN = 19 * MiB, WS_WOUT = 24 * MiB, WS_W2UP = 26 * MiB, WS_W2DN = 37 * MiB;
constexpr size_t WS_XB = 64 * MiB;
constexpr size_t WS_H = 128 * MiB;
constexpr size_t WS_Z1 = 304 * MiB;
constexpr size_t WS_U = 368 * MiB;
constexpr size_t WS_GV = 400 * MiB;
constexpr size_t WS_GVST = 432 * MiB;
constexpr size_t WS_Q = 434 * MiB;
constexpr size_t WS_K = 466 * MiB;
constexpr size_t WS_VT = 474 * MiB;
constexpr size_t WS_QI = 482 * MiB;
constexpr size_t WS_KI = 498 * MiB;
constexpr size_t WS_WI = 502 * MiB;
constexpr size_t WS_MASK = 503 * MiB;
constexpr size_t WS_MIX = 512 * MiB;
constexpr size_t WS_Z2 = 576 * MiB;
constexpr size_t WS_SMP = 644 * MiB;
constexpr size_t SM_HS = WS_SMP, SM_Z1 = SM_HS + 128 * 2816 * 4, SM_ST1 = SM_Z1 + 128 * 1024 * 4, SM_US = SM_ST1 + 128 * 64 * 8, SM_GVS = SM_US + 128 * 512 * 4,
                 SM_QS = SM_GVS + 128 * 512 * 4, SM_QIS = SM_QS + 128 * 512 * 4, SM_WIS = SM_QIS + 128 * 256 * 4, SM_MIXS = SM_WIS + 128 * 4 * 4, SM_Z2 = SM_MIXS + 128 * 1024 * 4,
                 SM_ST2 = SM_Z2 + 128 * 1024 * 4, SM_Z3 = SM_ST2 + 128 * 64 * 8, SM_XSB = SM_Z3 + 128 * 1024 * 4, SM_MIXSB = SM_XSB + 128 * 1024 * 2, SM_Z1B = SM_MIXSB + 128 * 1024 * 2, SM_Z2B = SM_Z1B + 128 * 1024 * 2, SM_END = SM_Z2B + 128 * 1024 * 2;
constexpr size_t WS_Z3 = 304 * MiB;
constexpr size_t WS_STZ3 = 651 * MiB;
constexpr size_t WS_STZ1 = 652 * MiB, WS_STZ2 = 653 * MiB;
constexpr size_t WS_PS = 654 * MiB;
constexpr size_t PS_IN = WS_PS, PS_UP = WS_PS + 2 * 16 * 2304 * 4;
constexpr size_t WS_CV = 656 * MiB;
constexpr size_t CV_C1IN = WS_CV, CV_C2IN = CV_C1IN + 2304 * 4, CV_C1UP = CV_C2IN + 2304 * 4, CV_C2UP = CV_C1UP + 5632 * 4;
constexpr size_t WS_AWSB = 657 * MiB;
constexpr size_t WS_END = 658 * MiB;
static_assert(SM_END <= WS_END, "d_ws map");
constexpr int CW_TMO = 0, CW_CODE = 1;
constexpr int CW_BAR = 4096;
constexpr int CW_QUEUE = 64;

constexpr int RING_OFF = 0, RING_BYTES = 147968;
constexpr int XLDS_OFF = 131072;
constexpr int LDSCTL_OFF = RING_BYTES, MISC_OFF = LDSCTL_OFF + 320;
constexpr int LDS_BYTES = 163840;
static_assert(MISC_OFF + 128 <= LDS_BYTES, "LDS map");
#define GAS __attribute__((address_space(1)))
#define LAS __attribute__((address_space(3)))
typedef unsigned short bf16;
typedef unsigned v4u __attribute__((ext_vector_type(4)));
typedef float f32x4 __attribute__((ext_vector_type(4)));
typedef short bf16x8 __attribute__((ext_vector_type(8)));
typedef GAS unsigned gu32;
typedef GAS unsigned long long gu64;
#define RLX_AGENT __ATOMIC_RELAXED, __HIP_MEMORY_SCOPE_AGENT
#define LDS_WAIT() asm volatile("s_waitcnt lgkmcnt(0)" ::: "memory")
#define VM_WAIT() asm volatile("s_waitcnt vmcnt(0)" ::: "memory")
__device__ __forceinline__ unsigned long long rt() { return __builtin_amdgcn_s_memrealtime(); }
__device__ __forceinline__ unsigned f2bf(float f) { unsigned u = __builtin_bit_cast(unsigned, f); return (u + 0x7fffu + ((u >> 16) & 1u)) >> 16; }
__device__ __forceinline__ unsigned pk2(float lo, float hi) { return f2bf(lo) | (f2bf(hi) << 16); }

#define XB_TMO      128
#define XB_XCNT(j)  (256  + 64 * (j))
#define XB_XSUB(j)  (1280 + 64 * (j))
#define XB_XGEN(j)  (2304 + 64 * (j))
#define XB_TOP      3328
#define XB_TOPGEN   3392
#define XCD_BAR_WORDS 3456
#define XB_SPIN_CAP (1u << 18)

__device__ __forceinline__ unsigned xb_ld(unsigned* p)              { return __hip_atomic_load(p, __ATOMIC_RELAXED, __HIP_MEMORY_SCOPE_AGENT); }
__device__ __forceinline__ unsigned xb_add(unsigned* p, unsigned v) { return __hip_atomic_fetch_add(p, v, __ATOMIC_RELAXED, __HIP_MEMORY_SCOPE_AGENT); }
__device__ __forceinline__ unsigned xb_xcc_id() { return (unsigned)__builtin_amdgcn_s_getreg((3 << 11) | 20) & 0xFu; }
#define XB_SPIN(cond, bar) do { unsigned _sp = 0; while (cond) { __builtin_amdgcn_s_sleep(1); \
    if ((++_sp & 255u) == 0u) { if (xb_ld(&(bar)[XB_TMO])) break; if (_sp > XB_SPIN_CAP) { atomicAdd(&(bar)[XB_TMO], 1u); break; } } } } while (0)

struct XcdBarrier {
    unsigned* bar; unsigned x;
    volatile LAS unsigned* st;
};

__device__ __forceinline__ XcdBarrier xcd_barrier_post(unsigned* bar, volatile LAS unsigned* st) {
    XcdBarrier b; b.bar = bar; b.x = xb_xcc_id(); b.st = st;
    if (threadIdx.x == 0) (void)xb_add(&bar[XB_XCNT(b.x)], 1u);
    return b;
}
__device__ __forceinline__ void xcd_barrier_complete(unsigned* bar, unsigned x, unsigned& nloc, unsigned& nx) {
    const unsigned G = gridDim.x * gridDim.y * gridDim.z;
    unsigned sum, cnt, mine, sp = 0u;
    for (;;) {
        sum = 0u; cnt = 0u; mine = 0u;
#pragma unroll
        for (unsigned j = 0; j < 16; ++j) { const unsigned c = xb_ld(&bar[XB_XCNT(j)]); sum += c; cnt += (c > 0u) ? 1u : 0u; mine = (j == x) ? c : mine; }
        if (sum == G) break;
        __builtin_amdgcn_s_sleep(1);
        if ((++sp & 255u) == 0u) { if (xb_ld(&bar[XB_TMO])) break; if (sp > XB_SPIN_CAP) { atomicAdd(&bar[XB_TMO], 1u); break; } }
    }
    nloc = mine > 0u ? mine : 1u; nx = cnt > 0u ? cnt : 1u;
}

__device__ __forceinline__ void xcd_barrier(const XcdBarrier& b) {
    asm volatile("s_waitcnt vmcnt(0)" ::: "memory");
    __syncthreads();
    if (threadIdx.x == 0) {
        unsigned* bar = b.bar;
        __builtin_amdgcn_s_waitcnt(0);
        unsigned nloc = b.st[0], nx = b.st[1];
        if (nloc == 0u) { xcd_barrier_complete(bar, b.x, nloc, nx); b.st[0] = nloc; b.st[1] = nx; }
        const unsigned old = xb_add(&bar[XB_XSUB(b.x)], 1u);
        const unsigned gen = old / nloc;
        if (old + 1u == (gen + 1u) * nloc) {
            __builtin_amdgcn_fence(__ATOMIC_RELEASE, "agent");
            asm volatile("s_waitcnt vmcnt(0)" ::: "memory");
            const unsigned og = xb_add(&bar[XB_TOP], 1u);
            const unsigned tg = og / nx;
            if (og + 1u == (tg + 1u) * nx) xb_add(&bar[XB_TOPGEN], 1u);
            else XB_SPIN(xb_ld(&bar[XB_TOPGEN]) == tg, bar);
            __builtin_amdgcn_fence(__ATOMIC_ACQUIRE, "agent");
            xb_add(&bar[XB_XGEN(b.x)], 1u);
            asm volatile("s_waitcnt vmcnt(0)" ::: "memory");
        } else {
            XB_SPIN(xb_ld(&bar[XB_XGEN(b.x)]) == gen, bar);
            __builtin_amdgcn_fence(__ATOMIC_ACQUIRE, "agent");
            asm volatile("s_waitcnt vmcnt(0)" ::: "memory");
        }
    }
    __syncthreads();
}
typedef float f32x2 __attribute__((ext_vector_type(2)));
typedef unsigned u32x2 __attribute__((ext_vector_type(2)));
typedef float f32x16 __attribute__((ext_vector_type(16)));
struct Frame {
    LAS unsigned char* lds;
    volatile LAS unsigned* MISC;
    gu32* ctl;
    int tid, lane, wave, vcu, G;
    float* out; unsigned char* ws;
};
struct Args { const void* in[22]; float* out; unsigned char* ws; int ph_lo, ph_hi; };
#define IN_F(k) ((const float*)A.in[k])
__device__ __forceinline__ const float* in_lds(const Frame& F, int k) {
    const volatile LAS unsigned* t = (const volatile LAS unsigned*)(F.lds + LDSCTL_OFF);
    const unsigned lo = (unsigned)__builtin_amdgcn_readfirstlane((int)t[2 * k]), hi = (unsigned)__builtin_amdgcn_readfirstlane((int)t[2 * k + 1]);
    return (const float*)(const GAS float*)(((unsigned long long)hi << 32) | lo);
}
#define IN_L(k) in_lds(F, k)
__device__ __forceinline__ void launder(Frame& F) { unsigned long long w = (unsigned long long)F.ws, o = (unsigned long long)F.out; int t = F.tid, l = F.lane, wv = F.wave; asm volatile("" : "+s"(w), "+s"(o), "+v"(t), "+v"(l), "+s"(wv));
    F.ws = (unsigned char*)(GAS unsigned char*)w; F.out = (float*)(GAS float*)o; F.tid = t; F.lane = l; F.wave = wv; }
enum { I_XP = 0, I_XS, I_CK, I_CV, I_CKI, I_PT, I_LN1G, I_LN1B, I_W1UP, I_W1DN, I_LN2G, I_LN2B, I_WIN, I_ALNG, I_ALNB, I_AWS, I_ABS, I_WOUT, I_LN3G, I_LN3B, I_W2UP, I_W2DN };

__device__ __forceinline__ float wave_sum(float v) {
#pragma unroll
    for (int o = 1; o < 64; o <<= 1) v += __shfl_xor(v, o);
    return v;
}
__device__ __forceinline__ float wave_max(float v) {
#pragma unroll
    for (int o = 1; o < 64; o <<= 1) v = fmaxf(v, __shfl_xor(v, o));
    return v;
}
__device__ __forceinline__ f32x4 mfma16(const bf16x8 a, const bf16x8 b, const f32x4 c) { return __builtin_amdgcn_mfma_f32_16x16x32_bf16(a, b, c, 0, 0, 0); }
__device__ __forceinline__ f32x16 mfma32(const bf16x8 a, const bf16x8 b, const f32x16 c) { return __builtin_amdgcn_mfma_f32_32x32x16_bf16(a, b, c, 0, 0, 0); }
__device__ __forceinline__ bf16x8 as_bf16x8(const v4u w) { return __builtin_bit_cast(bf16x8, w); }

template <int MODE> __device__ __forceinline__ int dest_row(int n) {
    if (MODE == 1) { const int half = n >= FF ? 1 : 0, j = n - half * FF; return 256 * (j >> 7) + 128 * half + (j & 127); }
    if (MODE == 2) { const bool rp = (n >= 1024 && n < 1664) || (n >= 1792 && n < 2112);
        if (rp) { const int base = n & ~63, cc = n & 63; return base + 8 * ((cc & 31) >> 2) + 4 * (cc >> 5) + (cc & 3); }
        return n; }
    return n;
}
template <int MODE, bool FOLD> __device__ __forceinline__ void p0_item(const float* W, int K, int N, int Npad, bf16* WT, LAS float* scr, int item, int lane, const float* gamma, const float* beta, float* ps1, float* ps2) {
    const int nblk = Npad / 32, kb = item / nblk, nb = item % nblk, k0 = 64 * kb, n0 = 32 * nb;
    const int nsrc = n0 + (lane & 31); const bool ok = nsrc < N;
    { float wv[32];
#pragma unroll
      for (int i = 0; i < 32; ++i) { const int kk = 2 * i + (lane >> 5); wv[i] = ok ? __builtin_nontemporal_load(W + (size_t)(k0 + kk) * N + nsrc) : 0.f; }
      __builtin_amdgcn_sched_barrier(0);
#pragma unroll
      for (int i = 0; i < 32; ++i) { const int kk = 2 * i + (lane >> 5); scr[kk * 33 + (lane & 31)] = wv[i]; } }
    LDS_WAIT(); asm volatile("" ::: "memory");
    const int c = lane & 7;
    f32x4 g0 = (f32x4){1.f, 1.f, 1.f, 1.f}, g1 = g0, b0 = (f32x4){0.f, 0.f, 0.f, 0.f}, b1 = b0;
    if (FOLD) { g0 = *(const f32x4*)(gamma + k0 + 8 * c); g1 = *(const f32x4*)(gamma + k0 + 8 * c + 4); b0 = *(const f32x4*)(beta + k0 + 8 * c); b1 = *(const f32x4*)(beta + k0 + 8 * c + 4); }
#pragma unroll
    for (int j = 0; j < 4; ++j) { const int n = (lane >> 3) + 8 * j; const LAS float* s = scr + (8 * c) * 33 + n;
        const float w0 = s[0 * 33], w1 = s[1 * 33], w2 = s[2 * 33], w3 = s[3 * 33], w4 = s[4 * 33], w5 = s[5 * 33], w6 = s[6 * 33], w7 = s[7 * 33];
        v4u o; o.x = pk2(w0 * g0[0], w1 * g0[1]); o.y = pk2(w2 * g0[2], w3 * g0[3]); o.z = pk2(w4 * g1[0], w5 * g1[1]); o.w = pk2(w6 * g1[2], w7 * g1[3]);
        const int dr = dest_row<MODE>(n0 + n);
        *(GAS v4u*)(WT + (size_t)dr * K + k0 + 8 * c) = o;
        if (FOLD) {
            float s1 = ((__uint_as_float(o.x << 16) + __uint_as_float(o.x & 0xffff0000u)) + (__uint_as_float(o.y << 16) + __uint_as_float(o.y & 0xffff0000u)))
                     + ((__uint_as_float(o.z << 16) + __uint_as_float(o.z & 0xffff0000u)) + (__uint_as_float(o.w << 16) + __uint_as_float(o.w & 0xffff0000u)));
            float s2 = ((w0 * b0[0] + w1 * b0[1]) + (w2 * b0[2] + w3 * b0[3])) + ((w4 * b1[0] + w5 * b1[1]) + (w6 * b1[2] + w7 * b1[3]));
            s1 += __shfl_xor(s1, 1); s1 += __shfl_xor(s1, 2); s1 += __shfl_xor(s1, 4); s2 += __shfl_xor(s2, 1); s2 += __shfl_xor(s2, 2); s2 += __shfl_xor(s2, 4);
            if (c == 0) { ps1[(size_t)kb * Npad + dr] = s1; ps2[(size_t)kb * Npad + dr] = s2; }
        } }
    LDS_WAIT(); asm volatile("" ::: "memory");
}
__device__ const float ROPE_INV[32] = {
    1.0f, 0.7498942093324559f, 0.5623413251903491f, 0.4216965034285822f, 0.31622776601683794f, 0.23713737056616552f, 0.1778279410038923f, 0.1333521432163324f,
    0.1f, 0.07498942093324559f, 0.05623413251903491f, 0.04216965034285822f, 0.03162277660168379f, 0.023713737056616554f, 0.01778279410038923f, 0.01333521432163324f,
    0.01f, 0.007498942093324558f, 0.005623413251903491f, 0.004216965034285822f, 0.0031622776601683794f, 0.0023713737056616554f, 0.0017782794100389228f, 0.001333521432163324f,
    0.001f, 0.0007498942093324559f, 0.0005623413251903491f, 0.00042169650342858224f, 0.00031622776601683794f, 0.00023713737056616554f, 0.00017782794100389227f, 0.0001333521432163324f };
__device__ __forceinline__ void p0_prologue(Frame& F, const Args& A) {
    LAS float* scr = (LAS float*)(F.lds + RING_OFF + F.wave * 16384);
    const int gw = F.vcu * NWAVES + F.wave, NGW = F.G * NWAVES;
    unsigned char* ws = F.ws;
    constexpr int I_UP = (DM / 64) * (2 * FF / 32), I_DN = (FF / 64) * (DM / 32), I_IN = (DM / 64) * (INWP / 32);
    constexpr int NITEMS = I_UP + I_DN + I_IN;
    for (int it = gw; it < NITEMS; it += NGW) {
        int r = it;
        if (r < I_UP) { p0_item<1, false>(IN_F(I_W1UP), DM, 2 * FF, 2 * FF, (bf16*)(ws + WS_W1UP), scr, r, F.lane, nullptr, nullptr, nullptr, nullptr); continue; } r -= I_UP;
        if (r < I_DN) { p0_item<0, false>(IN_F(I_W1DN), FF, DM, DM, (bf16*)(ws + WS_W1DN), scr, r, F.lane, nullptr, nullptr, nullptr, nullptr); continue; } r -= I_DN;
        p0_item<2, true>(IN_F(I_WIN), DM, INW, INWP, (bf16*)(ws + WS_WIN), scr, r, F.lane, IN_F(I_LN1G), IN_F(I_LN1B), (float*)(ws + PS_IN), (float*)(ws + PS_IN) + 16 * INWP);
    }
    { const size_t gt = (size_t)F.vcu * (NWAVES * 64) + F.tid, NT = (size_t)F.G * NWAVES * 64; const float* x = IN_F(I_XP); bf16* xb = (bf16*)(ws + WS_XB);
      static_assert(((size_t)MP * DM / 8) % ((size_t)256 * NWAVES * 64 * 8) == 0, "x conversion: whole batches of 8 per thread on a 256-workgroup grid");
      for (size_t e0 = gt; e0 < (size_t)MP * DM / 8; e0 += 8 * NT) {
          f32x4 a[8], b[8];
#pragma unroll
          for (int i = 0; i < 8; ++i) { const size_t e = e0 + (size_t)i * NT; if (e < (size_t)MP * DM / 8) { a[i] = __builtin_nontemporal_load((const f32x4*)(x + e * 8)); b[i] = __builtin_nontemporal_load((const f32x4*)(x + e * 8 + 4)); } }
          __builtin_amdgcn_sched_barrier(0);
#pragma unroll
          for (int i = 0; i < 8; ++i) { const size_t e = e0 + (size_t)i * NT; if (e < (size_t)MP * DM / 8) {
              v4u o; o.x = pk2(a[i][0], a[i][1]); o.y = pk2(a[i][2], a[i][3]); o.z = pk2(b[i][0], b[i][1]); o.w = pk2(b[i][2], b[i][3]); *(GAS v4u*)(xb + e * 8) = o; } } } }
    { const int gt = F.vcu * (NWAVES * 64) + F.tid; const float* x = IN_F(I_XS); bf16* xb = (bf16*)(ws + SM_XSB);
      if (gt < NS * DM / 8) { const f32x4 a = *(const GAS f32x4*)(x + gt * 8), b = *(const GAS f32x4*)(x + gt * 8 + 4);
          v4u o; o.x = pk2(a[0], a[1]); o.y = pk2(a[2], a[3]); o.z = pk2(b[0], b[1]); o.w = pk2(b[2], b[3]); *(GAS v4u*)(xb + gt * 8) = o; } }
    { const int gt = F.vcu * (NWAVES * 64) + F.tid; if (gt < 4 * 128 * 128) { const int t = (gt >> 7) & 127, s = gt & 127; const float v = IN_F(I_AWS)[gt];
          ((bf16*)(ws + WS_AWSB))[gt] = (bf16)f2bf((s > t) ? 0.f : v); } }
    { const int gt = F.vcu * (NWAVES * 64) + F.tid, NT = F.G * NWAVES * 64; float* rc = (float*)(ws + WS_ROPEC); float* rs = (float*)(ws + WS_ROPES);
      for (int e = gt; e < 2049 * 32; e += NT) { const int t = e >> 5, j = e & 31; const float pos = (t == 2048) ? 8192.f : (float)t; const float ang = pos * ROPE_INV[j];
          double rev = (double)ang * 0.15915494309189535; rev -= __builtin_floor(rev); const float fr = (float)rev;
          rc[e] = __builtin_amdgcn_cosf(fr); rs[e] = __builtin_amdgcn_sinf(fr); } }
}

__device__ __forceinline__ void p0_wout(Frame& F, const Args& A, int rank, int nrank) {
    launder(F); unsigned char* ws = F.ws; LAS float* scr = (LAS float*)(F.lds + RING_OFF + F.wave * 16384);
    constexpr int I_OUT = (DM / 64) * (DM / 32);
    for (int it = rank * NWAVES + F.wave; it < I_OUT; it += nrank * NWAVES) p0_item<0, false>(IN_L(I_WOUT), DM, DM, DM, (bf16*)(ws + WS_WOUT), scr, it, F.lane, nullptr, nullptr, nullptr, nullptr);
}
constexpr int LATE_ITEMS = (DM / 64) * (2 * FF / 32) + (FF / 64) * (DM / 32), LATE_UNITS = LATE_ITEMS / NWAVES;
static_assert(LATE_ITEMS % NWAVES == 0, "late weight units");
__device__ __forceinline__ void late_weight_unit(Frame& F, const Args& A, int unit) {
    launder(F); unsigned char* ws = F.ws; LAS float* scr = (LAS float*)(F.lds + RING_OFF + F.wave * 16384);
    constexpr int I_UP = (DM / 64) * (2 * FF / 32);
    const int r = unit * NWAVES + F.wave;
    if (r < I_UP) p0_item<1, true>(IN_L(I_W2UP), DM, 2 * FF, 2 * FF, (bf16*)(ws + WS_W2UP), scr, r, F.lane, IN_L(I_LN2G), IN_L(I_LN2B), (float*)(ws + PS_UP), (float*)(ws + PS_UP) + 16 * 2 * FF);
    else p0_item<0, false>(IN_L(I_W2DN), FF, DM, DM, (bf16*)(ws + WS_W2DN), scr, r - I_UP, F.lane, nullptr, nullptr, nullptr, nullptr);
    __syncthreads();
}
__device__ __forceinline__ void finalize_cvec(Frame& F, int sel) {
    unsigned char* ws = F.ws; const int gt = F.vcu * (NWAVES * 64) + F.tid + (sel ? 2 * INWP : 0);
    if (sel == 0 && gt >= 2 * INWP) return;
    if (gt < 2 * INWP) { const int which = gt / INWP, n = gt % INWP; const float* p = (const float*)(ws + PS_IN) + (size_t)which * 16 * INWP + n; float s = 0.f;
#pragma unroll
        for (int kb = 0; kb < 16; ++kb) s += p[(size_t)kb * INWP];
        ((float*)(ws + (which ? CV_C2IN : CV_C1IN)))[n] = s; }
    else if (gt < 2 * INWP + 4 * FF) { const int g2 = gt - 2 * INWP, which = g2 / (2 * FF), n = g2 % (2 * FF); const float* p = (const float*)(ws + PS_UP) + (size_t)which * 16 * 2 * FF + n; float s = 0.f;
#pragma unroll
        for (int kb = 0; kb < 16; ++kb) s += p[(size_t)kb * 2 * FF];
        ((float*)(ws + (which ? CV_C2UP : CV_C1UP)))[n] = s; }
}

constexpr int TH_RED = 0, TH_STAT = 131072;
__device__ __forceinline__ void thin_rowstats(const float* stat, int row, int fq, float& mean, float& rstd) {
    float s = 0.f, q = 0.f; const f32x4* p = (const f32x4*)((const f32x2*)stat + row * 64 + fq * 16);
    f32x4 v8[8];
#pragma unroll
    for (int i = 0; i < 8; ++i) v8[i] = p[i];
    __builtin_amdgcn_sched_barrier(0);
#pragma unroll
    for (int i = 0; i < 8; ++i) { s += v8[i][0] + v8[i][2]; q += v8[i][1] + v8[i][3]; }
    s += __shfl_xor(s, 16); s += __shfl_xor(s, 32); q += __shfl_xor(q, 16); q += __shfl_xor(q, 32);
    mean = s * (1.f / 1024.f); const float var = fmaxf(q * (1.f / 1024.f) - mean * mean, 0.f); rstd = 1.0f / sqrtf(var + LN_EPS);
}
__device__ __forceinline__ void thin_putstat(float* stat, int row, int unit, int fq, const f32x4 z) {
    float s = (z[0] + z[1]) + (z[2] + z[3]), q = (z[0] * z[0] + z[1] * z[1]) + (z[2] * z[2] + z[3] * z[3]);
    s += __shfl_xor(s, 16); s += __shfl_xor(s, 32); q += __shfl_xor(q, 16); q += __shfl_xor(q, 32);
    if (fq == 0) ((f32x2*)stat)[row * 64 + unit] = (f32x2){s, q};
}
template <int K, int NBR> __device__ __forceinline__ void thin_gemm(Frame& F, f32x4 (&out)[NBR], const bf16* Asrc, const bf16* const (&brow)[NBR]) {
    const int lane = F.lane, fr = lane & 15, fq = lane >> 4, w = F.wave;
    constexpr int KS = K / 8; static_assert(KS % 32 == 0, "K slice");
    f32x4 acc[8][NBR];
#pragma unroll
    for (int rt = 0; rt < 8; ++rt)
#pragma unroll
        for (int nb = 0; nb < NBR; ++nb) acc[rt][nb] = (f32x4){0.f, 0.f, 0.f, 0.f};
    constexpr int NSTEP = KS / 32, BATCH = (K == DM) ? 2 : 4;
#pragma unroll 1
    for (int s0 = 0; s0 < NSTEP; s0 += BATCH) {
        bf16x8 bf[BATCH][NBR], af[BATCH][8];
#pragma unroll
        for (int bi = 0; bi < BATCH; ++bi) if (s0 + bi < NSTEP) { const int k0 = w * KS + 32 * (s0 + bi) + 8 * fq;
#pragma unroll
            for (int nb = 0; nb < NBR; ++nb) bf[bi][nb] = *(const bf16x8*)(brow[nb] + k0);
#pragma unroll
            for (int rt = 0; rt < 8; ++rt) af[bi][rt] = *(const bf16x8*)(Asrc + (size_t)(16 * rt + fr) * K + k0); }
        __builtin_amdgcn_sched_barrier(0);
#pragma unroll
        for (int bi = 0; bi < BATCH; ++bi) if (s0 + bi < NSTEP) {
#pragma unroll
            for (int rt = 0; rt < 8; ++rt)
#pragma unroll
                for (int nb = 0; nb < NBR; ++nb) acc[rt][nb] = mfma16(bf[bi][nb], af[bi][rt], acc[rt][nb]); }
        __builtin_amdgcn_sched_barrier(0);
    }
    LAS f32x4* red = (LAS f32x4*)(F.lds + RING_OFF + TH_RED);
#pragma unroll
    for (int rt = 0; rt < 8; ++rt)
#pragma unroll
        for (int nb = 0; nb < NBR; ++nb) red[((nb * 8 + w) * 128 + 16 * rt + fr) * 4 + fq] = acc[rt][nb];
    __syncthreads();
#pragma unroll
    for (int nb = 0; nb < NBR; ++nb) { f32x4 s = red[((nb * 8 + 0) * 128 + 16 * w + fr) * 4 + fq];
#pragma unroll
        for (int ws = 1; ws < 8; ++ws) s = s + red[((nb * 8 + ws) * 128 + 16 * w + fr) * 4 + fq];
        out[nb] = s; }
    __syncthreads();
}
template <int STAGE> __device__ __forceinline__ void thin_stage(Frame& F, const Args& A, int unit0, int ustride) {
    launder(F); unsigned char* ws = F.ws; const int lane = F.lane, fr = lane & 15, fq = lane >> 4, w = F.wave; const int row = 16 * w + fr;
    constexpr int NU = (STAGE == 1 || STAGE == 7) ? FF / 16 : (STAGE == 3) ? (INW + 15) / 16 : DM / 16;
    bf16* HSB = (bf16*)(ws + SM_HS); float* Z1 = (float*)(ws + SM_Z1); float* ST1 = (float*)(ws + SM_ST1); float* Z2 = (float*)(ws + SM_Z2); float* ST2 = (float*)(ws + SM_ST2); float* Z3 = (float*)(ws + SM_Z3);
    if (unit0 < 0 || unit0 >= NU) return;
    float mean = 0.f, rstd = 1.f, mean1 = 0.f, rstd1 = 1.f;
    if (STAGE == 3 || STAGE == 6) thin_rowstats(ST1, row, fq, mean1, rstd1);
    if (STAGE == 7 || STAGE == 8) thin_rowstats(ST2, row, fq, mean, rstd);
    for (int unit = unit0; unit < NU; unit += ustride) {
        const int c0 = 16 * unit + 4 * fq;
        if (STAGE == 1 || STAGE == 7) {
            const bf16* Bt = (const bf16*)(ws + (STAGE == 1 ? WS_W1UP : WS_W2UP));
            const int rg = 256 * (unit >> 3) + 16 * (unit & 7) + fr;
            const bf16* const brow[2] = {Bt + (size_t)rg * DM, Bt + (size_t)(rg + 128) * DM};
            f32x4 acc[2]; f32x4 c1g = (f32x4){0.f, 0.f, 0.f, 0.f}, c1u = c1g, c2g = c1g, c2u = c1g;
            if (STAGE == 7) { const float* c1 = (const float*)(ws + CV_C1UP) + 256 * (unit >> 3) + 16 * (unit & 7) + 4 * fq; const float* c2 = (const float*)(ws + CV_C2UP) + 256 * (unit >> 3) + 16 * (unit & 7) + 4 * fq;
                c1g = *(const f32x4*)c1; c1u = *(const f32x4*)(c1 + 128); c2g = *(const f32x4*)c2; c2u = *(const f32x4*)(c2 + 128); }
            thin_gemm<DM, 2>(F, acc, (const bf16*)(ws + (STAGE == 1 ? SM_XSB : SM_Z2B)), brow);
            if (STAGE == 7) { const float rm = -rstd * mean;
                acc[0] = acc[0] * rstd + (c1g * rm + c2g); acc[1] = acc[1] * rstd + (c1u * rm + c2u); }
            f32x4 h;
#pragma unroll
            for (int i = 0; i < 4; ++i) h[i] = pg8::silu_f(acc[0][i]) * acc[1][i];
            u32x2 o; o.x = pk2(h[0], h[1]); o.y = pk2(h[2], h[3]); *(u32x2*)(HSB + (size_t)row * FF + c0) = o;
        } else if (STAGE == 2 || STAGE == 8) {
            const bf16* Bt = (const bf16*)(ws + (STAGE == 2 ? WS_W1DN : WS_W2DN));
            const bf16* const brow[1] = {Bt + (size_t)(16 * unit + fr) * FF};
            f32x4 acc[1];
            thin_gemm<FF, 1>(F, acc, HSB, brow);
            f32x4 res = *(const f32x4*)((STAGE == 2 ? IN_L(I_XS) : (const float*)Z2) + (size_t)row * DM + c0);
            if (STAGE == 8) res = (res - mean) * rstd * *(const f32x4*)(IN_L(I_LN2G) + c0) + *(const f32x4*)(IN_L(I_LN2B) + c0);
            const f32x4 z = res * kAlpha + acc[0] * 0.5f;
            *(f32x4*)((STAGE == 2 ? Z1 : Z3) + (size_t)row * DM + c0) = z;
            if (STAGE == 2) { thin_putstat(ST1, row, unit, fq, z); u32x2 o; o.x = pk2(z[0], z[1]); o.y = pk2(z[2], z[3]); *(u32x2*)((bf16*)(ws + SM_Z1B) + (size_t)row * DM + c0) = o; }
        } else if (STAGE == 6) {
            const bf16* Bt = (const bf16*)(ws + WS_WOUT);
            const bf16* const brow[1] = {Bt + (size_t)(16 * unit + fr) * DM};
            f32x4 acc[1];
            const f32x4 z1 = *(const f32x4*)(Z1 + (size_t)row * DM + c0);
            thin_gemm<DM, 1>(F, acc, (const bf16*)(ws + SM_MIXSB), brow);
            const f32x4 x1 = (z1 - mean1) * rstd1 * *(const f32x4*)(IN_L(I_LN1G) + c0) + *(const f32x4*)(IN_L(I_LN1B) + c0);
            const f32x4 z = x1 * kAlpha + acc[0];
            *(f32x4*)(Z2 + (size_t)row * DM + c0) = z;
            thin_putstat(ST2, row, unit, fq, z); { u32x2 o; o.x = pk2(z[0], z[1]); o.y = pk2(z[2], z[3]); *(u32x2*)((bf16*)(ws + SM_Z2B) + (size_t)row * DM + c0) = o; }
        } else {
            const bf16* Bt = (const bf16*)(ws + WS_WIN);
            const bf16* const brow[1] = {Bt + (size_t)(16 * unit + fr) * DM};
            f32x4 acc[1];
            const f32x4 c1v = *(const f32x4*)((const float*)(ws + CV_C1IN) + c0), c2v = *(const f32x4*)((const float*)(ws + CV_C2IN) + c0);
            thin_gemm<DM, 1>(F, acc, (const bf16*)(ws + SM_Z1B), brow);
            const f32x4 v = acc[0] * rstd1 + (c1v * (-rstd1 * mean1) + c2v);
            const bool roped = (c0 >= 1024 && c0 < 1664) || (c0 >= 1792 && c0 < 2112);
            f32x4 pr;
#pragma unroll
            for (int i = 0; i < 4; ++i) pr[i] = __shfl_xor(v[i], 16);
            if (c0 < 512) { f32x4 o;
#pragma unroll
                for (int i = 0; i < 4; ++i) o[i] = pg8::gelu_f(v[i]);
                *(f32x4*)((float*)(ws + SM_US) + (size_t)row * 512 + c0) = o;
            } else if (c0 < 1024) { f32x4 o;
#pragma unroll
                for (int i = 0; i < 4; ++i) o[i] = pg8::gelu_f(v[i]);
                *(f32x4*)((float*)(ws + SM_GVS) + (size_t)row * 512 + (c0 - 512)) = o;
            } else if (roped) {
                const int base = c0 & ~63, p = c0 & 63, g = p >> 3, n = (p >> 2) & 1;
                const f32x4 c = *(const f32x4*)((const float*)(ws + WS_ROPEC) + 2048 * 32 + 4 * g), s = *(const f32x4*)((const float*)(ws + WS_ROPES) + 2048 * 32 + 4 * g);
                const f32x4 o = n ? (v * c + pr * s) : (v * c - pr * s);
                const int oc = base + 32 * n + 4 * g;
                float* dst;
                if (oc < 1536) dst = (float*)(ws + SM_QS) + (size_t)row * 512 + (oc - 1024);
                else if (oc < 1664) dst = F.out + OUT_KS + (size_t)row * 128 + (oc - 1536);
                else if (oc < 2048) dst = (float*)(ws + SM_QIS) + (size_t)row * 256 + (oc - 1792);
                else dst = F.out + OUT_KIS + (size_t)row * 64 + (oc - 2048);
                *(f32x4*)dst = o;
            } else if (c0 < 1792) { *(f32x4*)(F.out + OUT_VS + (size_t)row * 128 + (c0 - 1664)) = v;
            } else if (c0 == 2112) { *(f32x4*)((float*)(ws + SM_WIS) + (size_t)row * 4) = v * 0.0625f; }
        }
    }
}
__device__ __forceinline__ void thin_final_ln(Frame& F, const Args& A) {
    const int gw = (F.G - 1 - F.vcu) * NWAVES + F.wave; if (gw >= NS) return;
    const float* z = (const float*)(F.ws + SM_Z3) + (size_t)gw * DM; const GAS f32x4* zr = (const GAS f32x4*)z + F.lane;
    f32x4 v[4]; float s = 0.f;
#pragma unroll
    for (int j = 0; j < 4; ++j) { v[j] = zr[64 * j]; s += (v[j].x + v[j].y) + (v[j].z + v[j].w); }
    const float mean = wave_sum(s) * (1.f / DM); float s2 = 0.f;
#pragma unroll
    for (int j = 0; j < 4; ++j) { v[j] = v[j] - mean; s2 += (v[j].x * v[j].x + v[j].y * v[j].y) + (v[j].z * v[j].z + v[j].w * v[j].w); }
    const float rstd = 1.f / sqrtf(wave_sum(s2) * (1.f / DM) + LN_EPS);
    const f32x4* g = (const f32x4*)IN_L(I_LN3G) + F.lane; const f32x4* b = (const f32x4*)IN_L(I_LN3B) + F.lane; f32x4* o = (f32x4*)(F.out + OUT_YS + (size_t)gw * DM) + F.lane;
#pragma unroll
    for (int j = 0; j < 4; ++j) o[64 * j] = v[j] * rstd * g[64 * j] + b[64 * j];
}

__device__ __forceinline__ void final_ln_rows(Frame& F, const Args& A) {
    launder(F); unsigned char* ws = F.ws; const int lane = F.lane;
    const int gw = F.vcu * NWAVES + F.wave, NGW = F.G * NWAVES;
    const float* g3 = IN_L(I_LN3G); const float* b3 = IN_L(I_LN3B);
    f32x4 gv[4], bv[4];
#pragma unroll
    for (int j = 0; j < 4; ++j) { gv[j] = *(const f32x4*)(g3 + 256 * j + 4 * lane); bv[j] = *(const f32x4*)(b3 + 256 * j + 4 * lane); }
    const bf16* Z = (const bf16*)(ws + WS_Z3); const float* ST = (const float*)(ws + WS_STZ3);
#define FLN_LOAD(RAW, SA, SB, r0) { _Pragma("unroll") for (int r = 0; r < 4; ++r) { const size_t row = (size_t)(r0) + (size_t)r * NGW; if (row < (size_t)MP) { SA[r] = *(const f32x4*)(ST + row * 8); SB[r] = *(const f32x4*)(ST + row * 8 + 4); \
            _Pragma("unroll") for (int j = 0; j < 4; ++j) RAW[r][j] = __builtin_nontemporal_load((const u32x2*)(Z + row * DM + 256 * j + 4 * lane)); } } }
#define FLN_STORE(RAW, SA, SB, r0) { _Pragma("unroll") for (int r = 0; r < 4; ++r) { const size_t row = (size_t)(r0) + (size_t)r * NGW; if (row < (size_t)MP) { float mu, rs; pg8::stats_from(SA[r], SB[r], mu, rs); \
            float* o = F.out + OUT_Y + row * DM + 4 * lane; \
            _Pragma("unroll") for (int j = 0; j < 4; ++j) __builtin_nontemporal_store((pg8::unpack4(RAW[r][j]) - mu) * rs * gv[j] + bv[j], (f32x4*)(o + 256 * j)); } } }
    u32x2 rawA[4][4], rawB[4][4]; f32x4 saA[4], sbA[4], saB[4], sbB[4];
    FLN_LOAD(rawA, saA, sbA, gw)
#pragma unroll 1
    for (int row0 = gw; row0 < MP; row0 += 8 * NGW) {
        FLN_LOAD(rawB, saB, sbB, row0 + 4 * NGW)
        __builtin_amdgcn_sched_barrier(0);
        FLN_STORE(rawA, saA, sbA, row0)
        FLN_LOAD(rawA, saA, sbA, row0 + 8 * NGW)
        __builtin_amdgcn_sched_barrier(0);
        FLN_STORE(rawB, saB, sbB, row0 + 4 * NGW)
    }
#undef FLN_LOAD
#undef FLN_STORE
}
constexpr int GM_LD = 136;
__device__ __forceinline__ void gmlp_unit(Frame& F, const Args& A, int b, int c, int g) {
    launder(F); unsigned char* ws = F.ws; const int tid = F.tid, lane = F.lane, fr = lane & 15, fq = lane >> 4, w = F.wave;
    LAS bf16* wsA = (LAS bf16*)(F.lds + RING_OFF); LAS bf16* vnT = wsA + 128 * GM_LD;
    const int m0 = b * SEQ + 128 * c;
    const int s_ = tid >> 2, dq_ = tid & 3; const size_t row_ = (size_t)(m0 + s_);
    const f32x4* st = (const f32x4*)((const float*)(ws + WS_GVST) + row_ * 16);
    const bf16* gv = (const bf16*)(ws + WS_GV) + row_ * 512 + 128 * g + 32 * dq_;
    f32x4 stv[4]; v4u raw4[4];
    {
        const int t = tid >> 2, sb = 32 * (tid & 3); const bf16* src = (const bf16*)(ws + WS_AWSB) + ((size_t)(g * 128 + t) * 128 + sb);
        v4u wv4[4];
#pragma unroll
        for (int i = 0; i < 4; ++i) wv4[i] = *(const v4u*)(src + 8 * i);
#pragma unroll
        for (int i = 0; i < 4; ++i) { stv[i] = st[i]; raw4[i] = *(const v4u*)(gv + 8 * i); }
        __builtin_amdgcn_sched_barrier(0);
#pragma unroll
        for (int i = 0; i < 4; ++i) *(LAS v4u*)(wsA + t * GM_LD + sb + 8 * i) = wv4[i];
    }
    {
        const int s = s_, dq = dq_;
        const f32x4 p0 = stv[0], p1 = stv[1], p2 = stv[2], p3 = stv[3];
        const float mean = ((p0[0] + p0[2]) + (p1[0] + p1[2]) + (p2[0] + p2[2]) + (p3[0] + p3[2])) * 0.125f;
        float m2 = (p0[1] + p0[3]) + (p1[1] + p1[3]) + (p2[1] + p2[3]) + (p3[1] + p3[3]);
        { const float d0 = p0[0] - mean, d1 = p0[2] - mean, d2 = p1[0] - mean, d3 = p1[2] - mean, d4 = p2[0] - mean, d5 = p2[2] - mean, d6 = p3[0] - mean, d7 = p3[2] - mean;
          m2 += 64.f * ((d0 * d0 + d1 * d1) + (d2 * d2 + d3 * d3) + (d4 * d4 + d5 * d5) + (d6 * d6 + d7 * d7)); }
        const float rstd = 1.0f / sqrtf(m2 * (1.f / 512.f) + LN_EPS);
        const float* lg = IN_L(I_ALNG) + 128 * g + 32 * dq; const float* lb = IN_L(I_ALNB) + 128 * g + 32 * dq;
#pragma unroll
        for (int i = 0; i < 4; ++i) { const v4u raw = raw4[i];
            const f32x4 x0 = pg8::unpack4((u32x2){raw.x, raw.y}), x1 = pg8::unpack4((u32x2){raw.z, raw.w});
            const f32x4 g0 = *(const f32x4*)(lg + 8 * i), g1 = *(const f32x4*)(lg + 8 * i + 4), b0 = *(const f32x4*)(lb + 8 * i), b1 = *(const f32x4*)(lb + 8 * i + 4);
            const f32x4 y0 = (x0 - mean) * rstd * g0 + b0, y1 = (x1 - mean) * rstd * g1 + b1;
            const int d = 32 * dq + 8 * i;
#pragma unroll
            for (int e = 0; e < 4; ++e) { vnT[(d + e) * GM_LD + s] = (bf16)f2bf(y0[e]); vnT[(d + 4 + e) * GM_LD + s] = (bf16)f2bf(y1[e]); } }
    }
    __syncthreads();
    {
        f32x4 acc[8];
#pragma unroll
        for (int dt = 0; dt < 8; ++dt) acc[dt] = (f32x4){0.f, 0.f, 0.f, 0.f};
        const int t = 16 * w + fr; const size_t row = (size_t)(m0 + t); const float bias = IN_L(I_ABS)[g * 128 + t];
        const bf16* up = (const bf16*)(ws + WS_U) + row * 512 + 128 * g + 4 * fq; bf16* op = (bf16*)(ws + WS_MIX) + row * 1024 + 128 * g + 4 * fq;
        u32x2 u8[8];
#pragma unroll
        for (int dt = 0; dt < 8; ++dt) u8[dt] = *(const u32x2*)(up + 16 * dt);
        __builtin_amdgcn_sched_barrier(0);
        const int nsteps = (w + 2) >> 1;
        for (int st = 0; st < nsteps; ++st) { const int s0 = 32 * st + 8 * fq;
            const bf16x8 bfr = *(const LAS bf16x8*)(wsA + (16 * w + fr) * GM_LD + s0);
#pragma unroll
            for (int dt = 0; dt < 8; ++dt) { const bf16x8 afr = *(const LAS bf16x8*)(vnT + (16 * dt + fr) * GM_LD + s0); acc[dt] = mfma16(afr, bfr, acc[dt]); } }
        __builtin_amdgcn_sched_barrier(0);
#pragma unroll
        for (int dt = 0; dt < 8; ++dt) { const f32x4 uu = pg8::unpack4(u8[dt]); const f32x4 o = uu * (acc[dt] + bias);
            u32x2 wv; wv.x = pk2(o[0], o[1]); wv.y = pk2(o[2], o[3]); *(u32x2*)(op + 16 * dt) = wv; }
    }
    __syncthreads();
}

__device__ __forceinline__ unsigned ord_f32(float x) { unsigned u = __float_as_uint(x); if (u == 0x80000000u) u = 0u; return (u & 0x80000000u) ? ~u : (u | 0x80000000u); }
__device__ __forceinline__ unsigned ord_f32_nz(float x) { const unsigned u = __float_as_uint(x); return u ^ ((unsigned)((int)u >> 31) | 0x80000000u); }
constexpr int SC_LD = 2052;
constexpr int TA_SC = 0, TA_MASK = 16 * SC_LD * 4, TA_END = TA_MASK + 64 * 64 * 4;
static_assert(TA_END <= RING_BYTES, "topk/attention LDS");
__device__ __forceinline__ void cnt_ge(unsigned& c, unsigned x, unsigned T) {
    asm volatile("v_cmp_le_u32_e32 vcc, %2, %1\n\ts_nop 1\n\tv_addc_co_u32_e32 %0, vcc, 0, %0, vcc" : "+v"(c) : "v"(x), "s"(T) : "vcc");
}
__device__ __forceinline__ unsigned wave_sum_u32(unsigned v) {
    v += (unsigned)__builtin_amdgcn_update_dpp(0, (int)v, 0xB1, 0xF, 0xF, true);
    v += (unsigned)__builtin_amdgcn_update_dpp(0, (int)v, 0x4E, 0xF, 0xF, true);
    v += (unsigned)__builtin_amdgcn_update_dpp(0, (int)v, 0x141, 0xF, 0xF, true);
    v += (unsigned)__builtin_amdgcn_update_dpp(0, (int)v, 0x140, 0xF, 0xF, true);
    return (unsigned)__builtin_amdgcn_readlane((int)v, 0) + (unsigned)__builtin_amdgcn_readlane((int)v, 16) + (unsigned)__builtin_amdgcn_readlane((int)v, 32) + (unsigned)__builtin_amdgcn_readlane((int)v, 48);
}
__device__ __forceinline__ void transpose32(unsigned (&a)[32]) {
#define T32_STAGE(J, M) _Pragma("unroll") for (int k = 0; k < 32; ++k) if (!(k & (J))) { const unsigned lo = a[k], hi = a[k + (J)]; a[k] = (lo & (M)) | ((hi << (J)) & ~(M)); a[k + (J)] = ((lo >> (J)) & (M)) | (hi & ~(M)); }
    T32_STAGE(16, 0x0000FFFFu) T32_STAGE(8, 0x00FF00FFu) T32_STAGE(4, 0x0F0F0F0Fu) T32_STAGE(2, 0x33333333u) T32_STAGE(1, 0x55555555u)
#undef T32_STAGE
}
template <int J> __device__ __forceinline__ void ties_by_index(unsigned cand, int need, int base, unsigned& sel) {
    if constexpr (J < 32) { const bool tb = ((cand >> J) & 1u) != 0u; const unsigned long long tie = __ballot(tb);
        const int rank = base + (int)__builtin_amdgcn_mbcnt_hi((unsigned)(tie >> 32), __builtin_amdgcn_mbcnt_lo((unsigned)tie, 0u));
        sel |= ((unsigned)tb & (unsigned)(rank < need)) << J;
        ties_by_index<J + 1>(cand, need, base + __builtin_popcountll(tie), sel); }
}
__device__ __forceinline__ void select_rows(const LAS float* sc, LAS unsigned* mask16, int qbase, int w, int lane) {
    const int ra = 2 * w, rb = 2 * w + 1, qa = qbase + ra, qb = qbase + rb;
    unsigned PA[32], PB[32];
#pragma unroll
    for (int i = 0; i < 32; ++i) { const int k = 64 * i + lane; PA[i] = __float_as_uint(sc[ra * SC_LD + k]); PB[i] = __float_as_uint(sc[rb * SC_LD + k]); }
    __builtin_amdgcn_sched_barrier(0);
#pragma unroll
    for (int i = 0; i < 32; ++i) { const int k = 64 * i + lane; PA[i] = (k <= qa) ? ord_f32_nz(__uint_as_float(PA[i])) : 0u; PB[i] = (k <= qb) ? ord_f32_nz(__uint_as_float(PB[i])) : 0u; }
    transpose32(PA); transpose32(PB);
    unsigned candA = ~0u, candB = ~0u, selA = 0u, selB = 0u; int abA = 0, abB = 0;
#pragma unroll
    for (int b = 31; b >= 0; --b) {
        const unsigned tA = candA & PA[b], tB = candB & PB[b];
        const unsigned tot = wave_sum_u32((unsigned)__builtin_popcount(tA) | ((unsigned)__builtin_popcount(tB) << 16));
        { const int nA = abA + (int)(tot & 0xffffu); const bool take = nA >= 256, ex = nA == 256;
          selA |= (take && !ex) ? 0u : tA; candA = take ? (ex ? 0u : tA) : (candA & ~PA[b]); abA = take ? (ex ? 256 : abA) : nA; }
        { const int nB = abB + (int)(tot >> 16); const bool take = nB >= 256, ex = nB == 256;
          selB |= (take && !ex) ? 0u : tB; candB = take ? (ex ? 0u : tB) : (candB & ~PB[b]); abB = take ? (ex ? 256 : abB) : nB; }
        if (abA == 256 && abB == 256) break;
    }
    {
        const unsigned tot = wave_sum_u32((unsigned)__builtin_popcount(candA) | ((unsigned)__builtin_popcount(candB) << 16));
        const int needA = 256 - abA, needB = 256 - abB;
        if ((int)(tot & 0xffffu) == needA) selA |= candA; else ties_by_index<0>(candA, needA, 0, selA);
        if ((int)(tot >> 16) == needB) selB |= candB; else ties_by_index<0>(candB, needB, 0, selB);
    }
    mask16[ra * 64 + lane] = selA; mask16[rb * 64 + lane] = selB;
}
__device__ __forceinline__ void topk_load_k(Frame& F, int b, int ntile_max, bf16x8 (&k0)[8], bf16x8 (&k1)[8]) {
    launder(F); const int lane = F.lane, fr = lane & 15, fq = lane >> 4, w = F.wave;
    const bf16* kib = (const bf16*)(F.ws + WS_KI) + ((size_t)b * SEQ + fr) * 64 + 8 * fq;
#pragma unroll
    for (int i = 0; i < 8; ++i) { const int kt = w + NWAVES * i; k0[i] = bf16x8{}; k1[i] = bf16x8{}; if (kt < ntile_max) { const bf16* kp = kib + (size_t)kt * 16 * 64; k0[i] = *(const bf16x8*)kp; k1[i] = *(const bf16x8*)(kp + 32); } }
    __builtin_amdgcn_sched_barrier(0);
}
__device__ __forceinline__ void topk16(Frame& F, int b, int q0, LAS unsigned* mask16, const bf16x8 (&kh0)[8], const bf16x8 (&kh1)[8]) {
    launder(F); unsigned char* ws = F.ws; const int lane = F.lane, fr = lane & 15, fq = lane >> 4, w = F.wave;
    const size_t rowq = (size_t)b * SEQ + q0;
    if (q0 < 256) {
#pragma unroll
        for (int rr = 0; rr < 2; ++rr) { const int r = 2 * w + rr, q = q0 + r; const int d = q - lane;
            mask16[r * 64 + lane] = (d < 0) ? 0u : ((2u << (d >> 6)) - 1u); }
        return;
    }
    LAS float* sc = (LAS float*)(F.lds + RING_OFF + TA_SC);
    {
        const bf16* qip = (const bf16*)(ws + WS_QI) + (rowq + fr) * 256 + 8 * fq;
        bf16x8 qf[4][2];
#pragma unroll
        for (int h = 0; h < 4; ++h) { qf[h][0] = *(const bf16x8*)(qip + 64 * h); qf[h][1] = *(const bf16x8*)(qip + 64 * h + 32); }
        const f32x4 wq = *(const f32x4*)((const float*)(ws + WS_WI) + (rowq + fr) * 4);
        const int ntile = (q0 >> 4) + 1;
        const bf16* kib = (const bf16*)(ws + WS_KI) + ((size_t)b * SEQ + fr) * 64 + 8 * fq;
        bf16x8 k0[8], k1[8];
#pragma unroll
        for (int i = 0; i < 8; ++i) { const int kt = w + 64 + NWAVES * i; if (kt < ntile) { const bf16* kp = kib + (size_t)kt * 16 * 64; k0[i] = *(const bf16x8*)kp; k1[i] = *(const bf16x8*)(kp + 32); } }
        __builtin_amdgcn_sched_barrier(0);
#define TOPK_TILE(KA, KB, kt) { f32x4 s = (f32x4){0.f, 0.f, 0.f, 0.f}; \
            _Pragma("unroll") for (int h = 0; h < 4; ++h) { f32x4 d = mfma16(KA, qf[h][0], (f32x4){0.f, 0.f, 0.f, 0.f}); d = mfma16(KB, qf[h][1], d); \
                _Pragma("unroll") for (int e = 0; e < 4; ++e) s[e] = __builtin_fmaf(wq[h], fmaxf(d[e], 0.f), s[e]); } \
            *(LAS f32x4*)(sc + fr * SC_LD + 16 * (kt) + 4 * fq) = s; }
#pragma unroll
        for (int i = 0; i < 8; ++i) { const int kt = w + NWAVES * i; if (kt < ntile) TOPK_TILE(kh0[i], kh1[i], kt) }
        __builtin_amdgcn_sched_barrier(0);
#pragma unroll
        for (int i = 0; i < 8; ++i) { const int kt = w + 64 + NWAVES * i; if (kt < ntile) TOPK_TILE(k0[i], k1[i], kt) }
#undef TOPK_TILE
    }
    __syncthreads();
    select_rows(sc, mask16, q0, w, lane);
    __syncthreads();
}

typedef float f32x8 __attribute__((ext_vector_type(8)));
constexpr int AT_SLOTB = 8192, AT_LK = 0, AT_LV = 3 * AT_SLOTB, AT_MT = 6 * AT_SLOTB, AT_QS = AT_MT + 32 * 128 * 4, AT_END = AT_QS + 8 * 4096;
static_assert(AT_END <= TA_MASK, "attention rings + tile-major mask overlay the score image");
__device__ __forceinline__ void at_glds16(const void* g, unsigned lds_dst) { unsigned keep;
    asm volatile("s_mov_b32 %0, m0\n\ts_mov_b32 m0, %2\n\ts_nop 0\n\tglobal_load_lds_dwordx4 %1, off\n\ts_mov_b32 m0, %0" : "=&s"(keep) : "v"(g), "s"(lds_dst) : "memory"); }
typedef short at_v4i16 __attribute__((ext_vector_type(4)));
__device__ __forceinline__ u32x2 at_vtr(const LAS char* p) { return __builtin_bit_cast(u32x2, __builtin_amdgcn_ds_read_tr16_b64_v4i16((LAS at_v4i16*)p)); }
__device__ __forceinline__ void at_kload2(bf16x8* kf, const LAS char* kp, int j) { kf[2 * j] = *(const LAS bf16x8*)(kp + j * 2048); kf[2 * j + 1] = *(const LAS bf16x8*)(kp + j * 2048 + 512); }
#define AT_MX3(a, b, c) __builtin_fmaxf(__builtin_fmaxf((a), (b)), (c))
__device__ __forceinline__ float at_rowmax(const f32x16& p0, const f32x16& p1) {
    float a = AT_MX3(p0[0], p0[1], p1[0]), b = AT_MX3(p0[2], p0[3], p1[1]); a = AT_MX3(a, p1[2], p1[3]);
#pragma unroll
    for (int r = 4; r < 16; r += 4) { a = AT_MX3(a, p0[r], p0[r + 1]); b = AT_MX3(b, p0[r + 2], p0[r + 3]); a = AT_MX3(a, p1[r], p1[r + 1]); b = AT_MX3(b, p1[r + 2], p1[r + 3]); }
    const float m = __builtin_fmaxf(a, b); auto rr = __builtin_amdgcn_permlane32_swap(__float_as_uint(m), __float_as_uint(m), false, false);
    return __builtin_fmaxf(__uint_as_float(rr[0]), __uint_as_float(rr[1])); }
__device__ __forceinline__ void mask_to_tiles(Frame& F, const LAS unsigned* mask64) {
    const int tid = F.tid;
    if (tid < 128) { const int row = tid >> 1, hf = tid & 1;
        const LAS v4u* mp = (const LAS v4u*)(mask64 + row * 64 + 4 * hf);
        unsigned a[32];
#pragma unroll
        for (int kh = 0; kh < 2; ++kh)
#pragma unroll
            for (int i4 = 0; i4 < 4; ++i4) { const v4u v = mp[8 * kh + 2 * i4]; a[8 * kh + 2 * i4] = v.x; a[8 * kh + 2 * i4 + 16] = v.y; a[8 * kh + 2 * i4 + 1] = v.z; a[8 * kh + 2 * i4 + 17] = v.w; }
        transpose32(a);
        LAS unsigned* mt = (LAS unsigned*)(F.lds + RING_OFF + AT_MT) + tid;
#pragma unroll
        for (int t = 0; t < 32; ++t) mt[t * 128] = a[t]; }
}
#define AT_SBAR() __builtin_amdgcn_sched_barrier(0)
#define AT_PIN(x) asm volatile("" : "+v"(x))
#define AT_WAIT_BAR(N) asm volatile("s_waitcnt vmcnt(" #N ") lgkmcnt(0)\n\ts_barrier" ::: "memory")
#define AT_MEXP(v, pos, W) __uint_as_float(__float_as_uint(__builtin_amdgcn_exp2f(v)) & (unsigned)__builtin_amdgcn_sbfe((int)(W), (pos), 1))
#define AT_PMASK(j, W) ({ unsigned m_; if ((j) == 15) asm("v_pk_ashrrev_i16 %0, 15, %1 op_sel_hi:[0,1]" : "=v"(m_) : "v"(W)); \
    else asm("v_pk_lshlrev_b16 %0, %2, %1 op_sel_hi:[0,1]\n\tv_pk_ashrrev_i16 %0, 15, %0 op_sel_hi:[0,1]" : "=v"(m_) : "v"(W), "n"(15 - (j))); m_; })
#ifdef PROBE_DUPMASK
#define AT_MEXPC(v, pos, W) ({ unsigned m_, m2_; asm("v_bfe_i32 %0, %1, %2, 1" : "=v"(m_) : "v"(W), "n"(pos)); unsigned r_ = __float_as_uint(__builtin_amdgcn_exp2f(v)) & m_; asm volatile("v_bfe_i32 %0, %2, %3, 1\n\tv_and_b32 %1, %1, %0" : "=&v"(m2_), "+v"(r_) : "v"(W), "n"(pos)); __uint_as_float(r_); })
#else
#define AT_MEXPC(v, pos, W) ({ unsigned m_; asm("v_bfe_i32 %0, %1, %2, 1" : "=v"(m_) : "v"(W), "n"(pos)); __uint_as_float(__float_as_uint(__builtin_amdgcn_exp2f(v)) & m_); })
#endif
__device__ __forceinline__ void attn_unit(Frame& F, int b, int qt, int g) {
    launder(F); unsigned char* ws = F.ws; const int lane = F.lane, r32 = lane & 31, hi = lane >> 5; const int wid = __builtin_amdgcn_readfirstlane(F.wave);
    const int hh = wid & 3, qs = wid >> 2, head = 4 * g + hh, q0 = 64 * qt + 32 * qs; const size_t qrow = (size_t)b * SEQ + q0 + r32;
    const int NT = qt + 1;
    const LAS char* shm = (const LAS char*)(F.lds + RING_OFF); const unsigned lds0 = (unsigned)(size_t)shm;
    const bf16* ksrc = (const bf16*)(ws + WS_K) + ((size_t)b * SEQ + lane) * 128 + 64 * g + 8 * wid;
    const bf16* vsrc = (const bf16*)(ws + WS_VT) + ((size_t)b * SEQ + 16 * (wid & 3) + (lane >> 2)) * 128 + 64 * g + (wid >> 2) * 32 + (lane & 3) * 8;
    const unsigned kdst = lds0 + AT_LK + wid * 1024, vdst = lds0 + AT_LV + wid * 1024;
#define DMA_K(t, slot) at_glds16(ksrc + (size_t)min((int)(t), NT - 1) * (64 * 128), (unsigned)__builtin_amdgcn_readfirstlane((int)(kdst + (slot))))
#define DMA_V(t, slot) at_glds16(vsrc + (size_t)min((int)(t), NT - 1) * (64 * 128), (unsigned)__builtin_amdgcn_readfirstlane((int)(vdst + (slot))))
    const LAS char* kp0 = shm + AT_LK + hi * 1024 + r32 * 16;
    const LAS char* vp0 = shm + AT_LV + ((lane >> 4) & 1) * 32 + (lane & 3) * 8 + (4 * hi + ((lane & 15) >> 2)) * 64;
    const LAS unsigned* mT = (const LAS unsigned*)(shm + AT_MT) + 2 * (32 * qs + r32) + hi;
    DMA_K(0, 0); DMA_V(0, 0); DMA_K(1, AT_SLOTB);
    bf16x8 qr[4];
    const LAS char* qsp = shm + AT_QS + wid * 4096 + lane * 16;
    { const bf16* qp = (const bf16*)(ws + WS_Q) + qrow * 512 + 64 * head + 8 * hi;
#pragma unroll
      for (int ks = 0; ks < 4; ++ks) qr[ks] = *(const bf16x8*)(qp + 16 * ks);
#pragma unroll
      for (int ks = 0; ks < 4; ++ks) *(LAS bf16x8*)(shm + AT_QS + wid * 4096 + lane * 16 + ks * 1024) = qr[ks]; }
#define QRD(i) do { qv[i] = *(const LAS bf16x8*)(qsp + ((i) & 3) * 1024); } while (0)
    float mhat = 0.f, fsc = 1.f; f32x16 o[2]; o[0] = f32x16{}; o[1] = f32x16{}; f32x16 negm = f32x16{}; AT_PIN(negm);
    f32x16 lacc = f32x16{};
    v4u onesw = (v4u){0x3F803F80u, 0x3F803F80u, 0x3F803F80u, 0x3F803F80u}; AT_PIN(onesw);
    bool resc = false;
    f32x16 pA0, pA1, pB0, pB1; bf16x8 kf[8]; u32x2 vlo[8], vhi[8]; v4u pw0, pw1, pw2, pw3;
    int sl_prev = 0, sl_cur = 0, sl_next = AT_SLOTB;
#define ROT() do { sl_prev = sl_cur; sl_cur = sl_next; sl_next = (sl_next == 2 * AT_SLOTB) ? 0 : sl_next + AT_SLOTB; } while (0)
#define RESC() do { if (resc) { o[0] = o[0] * fsc; o[1] = o[1] * fsc; lacc = lacc * fsc; } } while (0)
    DMA_K(2, 2 * AT_SLOTB);
    AT_WAIT_BAR(3);
#pragma unroll
    for (int d0 = 0; d0 < 4; ++d0) at_kload2(kf, kp0, d0);
    pA0 = mfma32(kf[0], qr[0], negm); pA1 = mfma32(kf[1], qr[0], negm); pA0 = mfma32(kf[2], qr[1], pA0); pA1 = mfma32(kf[3], qr[1], pA1);
    pA0 = mfma32(kf[4], qr[2], pA0); pA1 = mfma32(kf[5], qr[2], pA1); pA0 = mfma32(kf[6], qr[3], pA0); pA1 = mfma32(kf[7], qr[3], pA1);
    { const float rm = at_rowmax(pA0, pA1); mhat = rm;
#pragma unroll
      for (int r = 0; r < 16; ++r) negm[r] = -mhat;
      AT_PIN(negm);
#pragma unroll
      for (int r = 0; r < 16; ++r) { pA0[r] = __builtin_amdgcn_exp2f(pA0[r] - rm); pA1[r] = pA1[r] - rm; } }
    AT_WAIT_BAR(0);
    DMA_K(3, 0); DMA_V(1, AT_SLOTB); ROT();
#pragma unroll
    for (int d0 = 0; d0 < 4; ++d0) at_kload2(kf, kp0 + sl_cur, d0);
    AT_WAIT_BAR(2);
#define PKW(P, i) pg8::cvt_pk_bf16(P[i], P[(i) + 1])
#define PKM(P, i, J0) (PKW(P, i) & AT_PMASK((J0) + (i) / 2, mwp))
#define PAF(k) as_bf16x8(pw##k)
#define VFR(i) as_bf16x8((v4u){vlo[i].x, vlo[i].y, vhi[i].x, vhi[i].y})
#define VRD(i) do { vlo[i] = at_vtr(vp_ + (((i) >> 2) * 4096 + ((i) & 3) * 1024)); vhi[i] = at_vtr(vp_ + (((i) >> 2) * 4096 + ((i) & 3) * 1024 + 512)); } while (0)
#define KRD(d0) do { at_kload2(kf, kp0 + sl_next, d0); AT_SBAR(); } while (0)
#define GAPA(MF, W0, W1, PW) do { MF; W0; W1; AT_PIN(PW); AT_SBAR(); } while (0)
#define MX1(X, i) X[i] = __builtin_amdgcn_exp2f(X[i])
#define GAPAX(MF, W0, W1, PW, X, EXPS) do { MF; W0; W1; AT_PIN(PW); EXPS; AT_PIN(X); AT_SBAR(); } while (0)
#define LSUM(k) do { lacc = mfma32(as_bf16x8(onesw), PAF(k), lacc); AT_SBAR(); } while (0)
#define GAPB(MF, X, i) do { MF; X[i] = __builtin_amdgcn_exp2f(X[i]); X[(i) + 1] = __builtin_amdgcn_exp2f(X[(i) + 1]); AT_PIN(X); AT_SBAR(); } while (0)
#define STEP(C0, C1, P0, P1, t) do { AT_SBAR(); \
    const LAS char* vp_ = vp0 + sl_prev; const unsigned mwp = mT[((t) - 1) * 128]; \
    bf16x8 qv[8]; QRD(0); QRD(1); AT_SBAR(); \
    QRD(2); AT_SBAR(); GAPAX(C0 = mfma32(kf[0], qv[0], negm), pw0[0] = PKM(P0, 0, 0),  pw0[1] = PKM(P0, 2, 0),  pw0, P1, MX1(P1, 0); MX1(P1, 1); MX1(P1, 2)); \
    QRD(3); AT_SBAR(); GAPAX(C0 = mfma32(kf[2], qv[1], C0),   pw0[2] = PKM(P0, 4, 0),  pw0[3] = PKM(P0, 6, 0),  pw0, P1, MX1(P1, 3); MX1(P1, 4); MX1(P1, 5)); \
    QRD(4); AT_SBAR(); GAPAX(C0 = mfma32(kf[4], qv[2], C0),   pw1[0] = PKM(P0, 8, 0),  pw1[1] = PKM(P0, 10, 0), pw1, P1, MX1(P1, 6); MX1(P1, 7)); LSUM(0); \
    QRD(5); AT_SBAR(); GAPAX(C0 = mfma32(kf[6], qv[3], C0),   pw1[2] = PKM(P0, 12, 0), pw1[3] = PKM(P0, 14, 0), pw1, P1, MX1(P1, 8); MX1(P1, 9)); \
    QRD(6); AT_SBAR(); GAPAX(C1 = mfma32(kf[1], qv[4], negm), pw2[0] = PKM(P1, 0, 8),  pw2[1] = PKM(P1, 2, 8),  pw2, P1, MX1(P1, 10); MX1(P1, 11)); LSUM(1); \
    QRD(7); AT_SBAR(); GAPAX(C1 = mfma32(kf[3], qv[5], C1),   pw2[2] = PKM(P1, 4, 8),  pw2[3] = PKM(P1, 6, 8),  pw2, P1, MX1(P1, 12); MX1(P1, 13)); \
    GAPAX(C1 = mfma32(kf[5], qv[6], C1),   pw3[0] = PKM(P1, 8, 8),  pw3[1] = PKM(P1, 10, 8), pw3, P1, MX1(P1, 14); MX1(P1, 15)); LSUM(2); \
    GAPA(C1 = mfma32(kf[7], qv[7], C1),    pw3[2] = PKM(P1, 12, 8), pw3[3] = PKM(P1, 14, 8), pw3); LSUM(3); \
    DMA_K((t) + 3, sl_cur); DMA_V((t) + 1, sl_next);                                                       \
    VRD(0); VRD(4); AT_SBAR();                                                                             \
    { const float rm = at_rowmax(C0, C1); resc = false;                                                    \
      if (__builtin_expect(__any(rm > 8.f), 0)) { const float dl = __builtin_fmaxf(rm, 0.f); mhat += dl;    \
          _Pragma("unroll") for (int r = 0; r < 16; ++r) { C0[r] -= dl; C1[r] -= dl; } \
          _Pragma("unroll") for (int r = 0; r < 16; ++r) negm[r] = -mhat; \
          AT_PIN(negm); fsc = __builtin_amdgcn_exp2f(-dl); resc = true; } } \
    AT_SBAR(); \
    VRD(1); AT_SBAR(); GAPB(o[0] = mfma32(VFR(0), PAF(0), o[0]), C0, 0); \
    VRD(5); AT_SBAR(); GAPB(o[1] = mfma32(VFR(4), PAF(0), o[1]), C0, 2); \
    KRD(0); VRD(2); AT_SBAR(); GAPB(o[0] = mfma32(VFR(1), PAF(1), o[0]), C0, 4); \
    KRD(1); VRD(6); AT_SBAR(); GAPB(o[1] = mfma32(VFR(5), PAF(1), o[1]), C0, 6); \
    KRD(2); VRD(3); AT_SBAR(); GAPB(o[0] = mfma32(VFR(2), PAF(2), o[0]), C0, 8); \
    KRD(3); VRD(7); AT_SBAR(); GAPB(o[1] = mfma32(VFR(6), PAF(2), o[1]), C0, 10); \
    GAPB(o[0] = mfma32(VFR(3), PAF(3), o[0]), C0, 12);              GAPB(o[1] = mfma32(VFR(7), PAF(3), o[1]), C0, 14); \
    } while (0)
    int t = 1;
    for (; t + 1 < NT; t += 2) {
        STEP(pB0, pB1, pA0, pA1, t);     AT_WAIT_BAR(2); RESC(); ROT();
        STEP(pA0, pA1, pB0, pB1, t + 1); AT_WAIT_BAR(2); RESC(); ROT();
    }
    if (t < NT) { STEP(pB0, pB1, pA0, pA1, t); AT_WAIT_BAR(2); RESC(); ROT(); pA0 = pB0; pA1 = pB1; }
    {
#pragma unroll
      for (int r = 0; r < 16; ++r) pA1[r] = __builtin_amdgcn_exp2f(pA1[r]);
      const unsigned mwp = mT[(NT - 1) * 128];
      pw0 = (v4u){PKM(pA0, 0, 0), PKM(pA0, 2, 0), PKM(pA0, 4, 0), PKM(pA0, 6, 0)}; pw1 = (v4u){PKM(pA0, 8, 0), PKM(pA0, 10, 0), PKM(pA0, 12, 0), PKM(pA0, 14, 0)};
      pw2 = (v4u){PKM(pA1, 0, 8), PKM(pA1, 2, 8), PKM(pA1, 4, 8), PKM(pA1, 6, 8)}; pw3 = (v4u){PKM(pA1, 8, 8), PKM(pA1, 10, 8), PKM(pA1, 12, 8), PKM(pA1, 14, 8)};
      const LAS char* vp_ = vp0 + sl_prev;
#pragma unroll
      for (int i = 0; i < 8; ++i) VRD(i);
      o[0] = mfma32(VFR(0), PAF(0), o[0]); o[1] = mfma32(VFR(4), PAF(0), o[1]); o[0] = mfma32(VFR(1), PAF(1), o[0]); o[1] = mfma32(VFR(5), PAF(1), o[1]);
      o[0] = mfma32(VFR(2), PAF(2), o[0]); o[1] = mfma32(VFR(6), PAF(2), o[1]); o[0] = mfma32(VFR(3), PAF(3), o[0]); o[1] = mfma32(VFR(7), PAF(3), o[1]);
      lacc = mfma32(as_bf16x8(onesw), PAF(0), lacc); lacc = mfma32(as_bf16x8(onesw), PAF(1), lacc); lacc = mfma32(as_bf16x8(onesw), PAF(2), lacc); lacc = mfma32(as_bf16x8(onesw), PAF(3), lacc); }
    const float l_reg = lacc[0];
    asm volatile("s_waitcnt vmcnt(0)" ::: "memory");
    {
        const float linv = 1.0f / l_reg; bf16* op = (bf16*)(ws + WS_MIX) + qrow * 1024 + 512 + 64 * head + 8 * hi;
#pragma unroll
        for (int k = 0; k < 8; k += 2) {
            const int dba = k >> 2, ia = k & 3, ib = ia + 1;
            unsigned ax = pg8::cvt_pk_bf16(o[dba][4 * ia] * linv, o[dba][4 * ia + 1] * linv), ay = pg8::cvt_pk_bf16(o[dba][4 * ia + 2] * linv, o[dba][4 * ia + 3] * linv);
            unsigned bx = pg8::cvt_pk_bf16(o[dba][4 * ib] * linv, o[dba][4 * ib + 1] * linv), by = pg8::cvt_pk_bf16(o[dba][4 * ib + 2] * linv, o[dba][4 * ib + 3] * linv);
            { auto r = __builtin_amdgcn_permlane32_swap(ax, bx, false, false); ax = r[0]; bx = r[1]; }
            { auto r = __builtin_amdgcn_permlane32_swap(ay, by, false, false); ay = r[0]; by = r[1]; }
            *(v4u*)(op + 8 * k) = (v4u){ax, ay, bx, by}; }
    }
    asm volatile("s_waitcnt lgkmcnt(0)\n\ts_barrier" ::: "memory");
#undef DMA_K
#undef DMA_V
#undef ROT
#undef RESC
#undef PKW
#undef PKM
#undef PAF
#undef VFR
#undef VRD
#undef KRD
#undef GAPA
#undef GAPAX
#undef MX1
#undef QRD
#undef LSUM
#undef GAPB
#undef STEP
}
__device__ __forceinline__ void topk_attn_unit(Frame& F, int b, int qt) {
    LAS unsigned* mask64 = (LAS unsigned*)(F.lds + RING_OFF + TA_MASK);
    bf16x8 kh0[8], kh1[8];
    topk_load_k(F, b, (qt < 4) ? 0 : 4 * qt + 4, kh0, kh1);
#pragma unroll 1
    for (int sub = 0; sub < 4; ++sub) topk16(F, b, 64 * qt + 16 * sub, mask64 + sub * 16 * 64, kh0, kh1);
    __syncthreads();
    mask_to_tiles(F, mask64);
    __syncthreads();
#pragma unroll 1
#ifdef PROBE_ATT2
    for (int g = 0; g < 4; ++g) attn_unit(F, b, qt, g & 1);
#else
    for (int g = 0; g < 2; ++g) attn_unit(F, b, qt, g);
#endif
}

__device__ __forceinline__ float dpp_sum16(float v) {
    v += __builtin_bit_cast(float, __builtin_amdgcn_update_dpp(0, __builtin_bit_cast(int, v), 0xB1, 0xF, 0xF, true));
    v += __builtin_bit_cast(float, __builtin_amdgcn_update_dpp(0, __builtin_bit_cast(int, v), 0x4E, 0xF, 0xF, true));
    v += __builtin_bit_cast(float, __builtin_amdgcn_update_dpp(0, __builtin_bit_cast(int, v), 0x141, 0xF, 0xF, true));
    v += __builtin_bit_cast(float, __builtin_amdgcn_update_dpp(0, __builtin_bit_cast(int, v), 0x140, 0xF, 0xF, true));
    return v;
}
__device__ __forceinline__ float dot4(const f32x4 a, const f32x4 b) { return __builtin_fmaf(a[3], b[3], __builtin_fmaf(a[2], b[2], __builtin_fmaf(a[1], b[1], a[0] * b[0]))); }
constexpr int SU_SC = 0, SU_QI = 8208 * 4, SU_WI = SU_QI + 256 * 4, SU_Q = SU_WI + 16, SU_SEL = SU_Q + 512 * 4, SU_P = SU_SEL + 256 * 4, SU_CNT = SU_P + 8 * 256 * 4, SU_CW = SU_CNT + 64 * 4, SU_RED = SU_CW + 2 * 17 * 8 * 4, SU_END = SU_RED + 64 * 4;
static_assert(SU_END <= RING_BYTES, "sample-unit LDS");
__device__ __forceinline__ void sample_unit(Frame& F, const Args& A, int b) {
    launder(F); unsigned char* ws = F.ws; const int tid = F.tid, lane = F.lane, w = F.wave;
    LAS float* sc = (LAS float*)(F.lds + RING_OFF + SU_SC); LAS float* qi_s = (LAS float*)(F.lds + RING_OFF + SU_QI); LAS float* wi_s = (LAS float*)(F.lds + RING_OFF + SU_WI);
    LAS float* q_s = (LAS float*)(F.lds + RING_OFF + SU_Q); LAS int* sel = (LAS int*)(F.lds + RING_OFF + SU_SEL); LAS float* p_s = (LAS float*)(F.lds + RING_OFF + SU_P);
    LAS unsigned* cnts = (LAS unsigned*)(F.lds + RING_OFF + SU_CNT); LAS unsigned* cw = (LAS unsigned*)(F.lds + RING_OFF + SU_CW); LAS float* red = (LAS float*)(F.lds + RING_OFF + SU_RED);
    const int* pt = (const int*)IN_L(I_PT) + b * NPAGE;
    if (tid < 256) qi_s[tid] = ((const float*)(ws + SM_QIS))[b * 256 + tid];
    if (tid < 4) wi_s[tid] = ((const float*)(ws + SM_WIS))[b * 4 + tid];
    q_s[tid] = ((const float*)(ws + SM_QS))[b * 512 + tid];
    {
        const float gv = ((const float*)(ws + SM_GVS))[b * 512 + tid];
        const float s1 = wave_sum(gv); if (lane == 0) red[w] = s1;
        __syncthreads();
        float mean = 0.f;
#pragma unroll
        for (int i = 0; i < 8; ++i) mean += red[i];
        mean *= (1.f / 512.f);
        const float d = gv - mean; const float s2 = wave_sum(d * d); if (lane == 0) red[8 + w] = s2;
        __syncthreads();
        float var = 0.f;
#pragma unroll
        for (int i = 0; i < 8; ++i) var += red[8 + i];
        const float rstd = 1.0f / sqrtf(var * (1.f / 512.f) + LN_EPS);
        const float av = d * rstd * IN_L(I_ALNG)[tid] + IN_L(I_ALNB)[tid];
        F.out[OUT_AV + (size_t)b * 512 + tid] = av;
        const int g = tid >> 7; const float mixed = IN_L(I_AWS)[(size_t)g * 128 * 128] * av + IN_L(I_ABS)[g * 128];
        ((bf16*)(ws + SM_MIXSB))[(size_t)b * 1024 + tid] = (bf16)f2bf(((const float*)(ws + SM_US))[b * 512 + tid] * mixed);
    }
    {
        const int sub = lane & 15, kq = lane >> 4;
        f32x4 qh[4];
#pragma unroll
        for (int h = 0; h < 4; ++h) qh[h] = *(const LAS f32x4*)(qi_s + 64 * h + 4 * sub);
        const float w0 = wi_s[0], w1 = wi_s[1], w2 = wi_s[2], w3 = wi_s[3];
        const float* cki = IN_L(I_CKI) + 4 * sub;
#define SU_LOAD(buf, phys, half) { const float* base_ = cki + (size_t)(phys) * (128 * 64) + (half) * (64 * 64); \
            _Pragma("unroll") for (int it = 0; it < 16; ++it) buf[it] = __builtin_nontemporal_load((const f32x4*)(base_ + (4 * it + kq) * 64)); }
#define SU_SCORE(buf, pg_, half) { \
            _Pragma("unroll") for (int it = 0; it < 16; ++it) { const int key = (half) * 64 + 4 * it + kq; const f32x4 kv = buf[it]; \
                const float d0 = dpp_sum16(dot4(kv, qh[0])), d1 = dpp_sum16(dot4(kv, qh[1])), d2 = dpp_sum16(dot4(kv, qh[2])), d3 = dpp_sum16(dot4(kv, qh[3])); \
                float s = w0 * fmaxf(d0, 0.f); s = __builtin_fmaf(w1, fmaxf(d1, 0.f), s); s = __builtin_fmaf(w2, fmaxf(d2, 0.f), s); s = __builtin_fmaf(w3, fmaxf(d3, 0.f), s); \
                if (sub == 0) sc[(pg_) * 128 + key] = s; } }
        {
            f32x4 kvA[16], kvB[16];
            int phys_cur = __builtin_amdgcn_readfirstlane(pt[w]);
            SU_LOAD(kvA, phys_cur, 0)
#pragma unroll 1
            for (int pg = w; pg < NPAGE; pg += NWAVES) {
                const int pgn = (pg + NWAVES < NPAGE) ? pg + NWAVES : pg;
                const int phys_nv = pt[pgn];
                SU_LOAD(kvB, phys_cur, 1)
                __builtin_amdgcn_sched_barrier(0);
                SU_SCORE(kvA, pg, 0)
                const int phys_next = __builtin_amdgcn_readfirstlane(phys_nv);
                if (pg + NWAVES < NPAGE) SU_LOAD(kvA, phys_next, 0)
                __builtin_amdgcn_sched_barrier(0);
                SU_SCORE(kvB, pg, 1)
                phys_cur = phys_next;
            }
        }
#undef SU_LOAD
#undef SU_SCORE
        if (w == 0) { const f32x4 kv = *(const f32x4*)(F.out + OUT_KIS + (size_t)b * 64 + 4 * sub);
            const float d0 = dpp_sum16(dot4(kv, qh[0])), d1 = dpp_sum16(dot4(kv, qh[1])), d2 = dpp_sum16(dot4(kv, qh[2])), d3 = dpp_sum16(dot4(kv, qh[3]));
            float s = w0 * fmaxf(d0, 0.f); s = __builtin_fmaf(w1, fmaxf(d1, 0.f), s); s = __builtin_fmaf(w2, fmaxf(d2, 0.f), s); s = __builtin_fmaf(w3, fmaxf(d3, 0.f), s);
            if (lane == 0) sc[PAST] = s; }
    }
    __syncthreads();
    unsigned x[17];
#pragma unroll
    for (int i = 0; i < 17; ++i) { const int p = tid + 512 * i; x[i] = __float_as_uint(sc[p < PAST + 1 ? p : PAST]); }
    __builtin_amdgcn_sched_barrier(0);
#pragma unroll
    for (int i = 0; i < 17; ++i) { const int p = tid + 512 * i; x[i] = (p <= PAST) ? ord_f32(__uint_as_float(x[i])) : 0u; }
    unsigned prefix = 0u;
#pragma unroll 1
    for (int bit = 31; bit >= 0; --bit) { const unsigned T = prefix | (1u << bit); unsigned c = 0u;
#pragma unroll
        for (int i = 0; i < 17; ++i) cnt_ge(c, x[i], T);
        const unsigned cnt = wave_sum_u32(c);
        LAS unsigned* slot = cnts + 8 * (bit & 1);
        if (lane == 0) slot[w] = cnt;
        __syncthreads();
        unsigned tot = 0;
#pragma unroll
        for (int i = 0; i < 8; ++i) tot += slot[i];
        if (tot >= 256u) prefix = T;
        if (tot == 256u) break; }
    const unsigned thr = prefix;
    {
        const unsigned long long lt = (1ull << lane) - 1ull;
        int cg = 0;
#pragma unroll
        for (int i = 0; i < 17; ++i) cg += __builtin_popcountll(__ballot(x[i] > thr));
        if (lane == 0) cnts[16 + w] = (unsigned)cg;
#pragma unroll
        for (int i = 0; i < 17; ++i) { const unsigned long long gb = __ballot(x[i] > thr), tb = __ballot(x[i] == thr);
            if (lane == 0) { cw[(i * 8 + w) * 2] = (unsigned)__builtin_popcountll(gb); cw[(i * 8 + w) * 2 + 1] = (unsigned)__builtin_popcountll(tb); } }
        __syncthreads();
        unsigned ngt = 0;
#pragma unroll
        for (int i = 0; i < 8; ++i) ngt += cnts[16 + i];
        const unsigned need = 256u - ngt;
        unsigned run_gt = 0, run_ti = 0;
#pragma unroll
        for (int i = 0; i < 17; ++i) {
            unsigned my_g = run_gt, my_t = run_ti;
#pragma unroll
            for (int ww = 0; ww < 8; ++ww) { const unsigned a = cw[(i * 8 + ww) * 2], c = cw[(i * 8 + ww) * 2 + 1]; if (ww < w) { my_g += a; my_t += c; } run_gt += a; run_ti += c; }
            const unsigned long long gb = __ballot(x[i] > thr), tb = __ballot(x[i] == thr); const int p = tid + 512 * i;
            if ((gb >> lane) & 1ull) sel[my_g + (unsigned)__builtin_popcountll(gb & lt)] = p;
            else if ((tb >> lane) & 1ull) { const unsigned rk = my_t + (unsigned)__builtin_popcountll(tb & lt); if (rk < need) sel[ngt + rk] = p; }
            __builtin_amdgcn_sched_barrier(0);
        }
    }
    __syncthreads();
    {
        LAS int* ro_s = (LAS int*)cw;
        if (tid < 256) { const int p = sel[tid]; ro_s[tid] = (p < PAST) ? pt[p >> 7] * 128 + (p & 127) : -1; }
        __syncthreads();
        const int h = w, g = h >> 2; const float* ck = IN_L(I_CK); const float* cv = IN_L(I_CV);
        const int sub = lane & 15, kq = lane >> 4;
        const f32x4 qv = *(const LAS f32x4*)(q_s + 64 * h + 4 * sub);
        const float* knew = F.out + OUT_KS + ((size_t)b * 2 + g) * 64 + 4 * sub; const float* vnew = F.out + OUT_VS + ((size_t)b * 2 + g) * 64 + 4 * sub;
#pragma unroll 1
        for (int it0 = 0; it0 < 64; it0 += 32) { f32x4 kr16[32];
#pragma unroll
            for (int i = 0; i < 32; ++i) { const int ro = ro_s[4 * (it0 + i) + kq]; kr16[i] = *(const f32x4*)((ro >= 0) ? ck + ((size_t)ro * 2 + g) * 64 + 4 * sub : knew); }
            __builtin_amdgcn_sched_barrier(0);
#pragma unroll
            for (int i = 0; i < 32; ++i) { const float d = dpp_sum16(dot4(kr16[i], qv)); if (sub == 0) p_s[h * 256 + 4 * (it0 + i) + kq] = d * 0.125f; } }
        LDS_WAIT(); asm volatile("" ::: "memory");
        const float l0 = p_s[h * 256 + lane], l1 = p_s[h * 256 + lane + 64], l2 = p_s[h * 256 + lane + 128], l3 = p_s[h * 256 + lane + 192];
        const float mx = wave_max(fmaxf(fmaxf(l0, l1), fmaxf(l2, l3)));
        const float e0 = __expf(l0 - mx), e1 = __expf(l1 - mx), e2 = __expf(l2 - mx), e3 = __expf(l3 - mx);
        p_s[h * 256 + lane] = e0; p_s[h * 256 + lane + 64] = e1; p_s[h * 256 + lane + 128] = e2; p_s[h * 256 + lane + 192] = e3;
        const float ls = (e0 + e1) + (e2 + e3);
        const float linv = 1.0f / wave_sum(ls);
        LDS_WAIT(); asm volatile("" ::: "memory");
        f32x4 acc = (f32x4){0.f, 0.f, 0.f, 0.f};
#pragma unroll 1
        for (int it0 = 0; it0 < 64; it0 += 32) { f32x4 vr16[32];
#pragma unroll
            for (int i = 0; i < 32; ++i) { const int ro = ro_s[4 * (it0 + i) + kq]; vr16[i] = *(const f32x4*)((ro >= 0) ? cv + ((size_t)ro * 2 + g) * 64 + 4 * sub : vnew); }
            __builtin_amdgcn_sched_barrier(0);
#pragma unroll
            for (int i = 0; i < 32; ++i) acc = acc + vr16[i] * p_s[h * 256 + 4 * (it0 + i) + kq]; }
#pragma unroll
        for (int i = 0; i < 4; ++i) { acc[i] += __shfl_xor(acc[i], 16); acc[i] += __shfl_xor(acc[i], 32); }
        if (kq == 0) { const f32x4 o = acc * linv; u32x2 wv; wv.x = pk2(o[0], o[1]); wv.y = pk2(o[2], o[3]); *(u32x2*)((bf16*)(ws + SM_MIXSB) + (size_t)b * 1024 + 512 + 64 * h + 4 * sub) = wv; }
    }
    __syncthreads();
}

__global__ void __launch_bounds__(NWAVES * 64, 2) hymba_fwd(Args args) {
    extern __shared__ __attribute__((aligned(16))) unsigned char lds[];
    Frame F;
    F.lds = (LAS unsigned char*)lds;
    F.MISC = (volatile LAS unsigned*)(F.lds + MISC_OFF);
    F.tid = threadIdx.x; F.lane = F.tid & 63; F.wave = __builtin_amdgcn_readfirstlane(F.tid >> 6);
    F.G = gridDim.x; { const int bx = blockIdx.x; F.vcu = (F.G % 8 == 0) ? (bx % 8) * (F.G / 8) + bx / 8 : bx; }
    F.out = args.out; F.ws = args.ws; const Args& A = args;
    unsigned char* ws = args.ws;
    F.ctl = (gu32*)(ws + WS_CTL);
    for (int u = F.tid; u < (LDS_BYTES - LDSCTL_OFF) / 4; u += NWAVES * 64) ((LAS unsigned*)(F.lds + LDSCTL_OFF))[u] = 0u;
    __syncthreads();
    if (F.tid < 22) { const unsigned long long* ka = (const unsigned long long*)__builtin_amdgcn_kernarg_segment_ptr();
        ((volatile LAS unsigned long long*)(F.lds + LDSCTL_OFF))[F.tid] = ka[F.tid]; }
    __syncthreads();
    XcdBarrier bar; bar.bar = (unsigned*)(F.ctl + CW_BAR); bar.x = 0; bar.st = nullptr;
    if (N_LAUNCHES == 1) bar = xcd_barrier_post((unsigned*)(F.ctl + CW_BAR), F.MISC + 8);
#define GRID_BAR() do { if (N_LAUNCHES == 1) xcd_barrier(bar); } while (0)
    const int lo = args.ph_lo, hi = args.ph_hi;
#define IN(k) (lo <= (k) && (k) < hi)
#define BOTH(k) (IN(k) && IN((k) + 1))
    const int c = (int)blockIdx.x;

    if (IN(0)) { p0_prologue(F, A); if (BOTH(0)) GRID_BAR(); }

    if (IN(1)) {
        pg8::Gemm g{(const bf16*)(ws + WS_XB), (const bf16*)(ws + WS_W1UP), MP, 2 * FF, DM}; pg8::StaticOrder S; S.init(MP, 2 * FF, F.G, c);
        pg8::EpiSwiGLU<false> E{(bf16*)(ws + WS_H), FF, nullptr, nullptr, nullptr, 0u};
        pg8::gemm_phase<pg8::EpiSwiGLU<false>, pg8::StaticOrder, true, true>(F.lds + RING_OFF, g, S, E);
        finalize_cvec(F, 0);
        thin_stage<1>(F, A, F.G - 1 - F.vcu, F.G);
        if (BOTH(1)) GRID_BAR();
    }
    if (IN(2)) {
        pg8::Gemm g{(const bf16*)(ws + WS_H), (const bf16*)(ws + WS_W1DN), MP, DM, FF}; pg8::StaticOrder S; S.init(MP, DM, F.G, c);
        pg8::EpiZ<0, true> E{(const bf16*)(ws + WS_XB), nullptr, nullptr, nullptr, (bf16*)(ws + WS_Z1), (float*)(ws + WS_STZ1), (unsigned)(size_t)(F.lds + XLDS_OFF)};
        pg8::gemm_phase<pg8::EpiZ<0, true>, pg8::StaticOrder, true, true>(F.lds + RING_OFF, g, S, E);
        thin_stage<2>(F, A, F.G - 1 - F.vcu, F.G);
        if (BOTH(2)) GRID_BAR();
    }
    if (IN(3)) {
        pg8::EpiWin E{(bf16*)(ws + WS_U), (bf16*)(ws + WS_GV), (bf16*)(ws + WS_Q), (bf16*)(ws + WS_K), (bf16*)(ws + WS_VT), (bf16*)(ws + WS_QI), (bf16*)(ws + WS_KI),
                      (float*)(ws + WS_GVST), (float*)(ws + WS_WI), F.out + OUT_KP, F.out + OUT_VP, F.out + OUT_KIP, (const float*)(ws + WS_ROPEC), (const float*)(ws + WS_ROPES),
                      (const float*)(ws + WS_STZ1), (const float*)(ws + CV_C1IN), (const float*)(ws + CV_C2IN), (unsigned)(size_t)(F.lds + XLDS_OFF + 8192), 0};
        { pg8::Gemm g{(const bf16*)(ws + WS_Z1), (const bf16*)(ws + WS_WIN), MP, 2048, DM}; pg8::StaticOrder S; S.init(MP, 2048, F.G, c);
          pg8::gemm_phase<pg8::EpiWin, pg8::StaticOrder, true, true>(F.lds + RING_OFF, g, S, E); }
        __syncthreads();
        { pg8::Gemm g{(const bf16*)(ws + WS_Z1), (const bf16*)(ws + WS_WIN) + (size_t)2048 * DM, MP, 256, DM}; pg8::StaticOrder S; S.init(MP, 256, F.G, c);
          E.pn_off = 8;
          pg8::gemm_phase<pg8::EpiWin, pg8::StaticOrder, true, true, true>(F.lds + RING_OFF, g, S, E); }
        if (c >= 128) { thin_stage<3>(F, A, c - 128, 128); p0_wout(F, A, c - 128, 128); }
        if (BOTH(3)) GRID_BAR();
    }
    if (IN(4)) {
#ifndef PROBE_Q_DUP
#define PROBE_Q_DUP 0
#endif
        constexpr int N_SMP = NS * (PROBE_Q_DUP == 1 ? 2 : 1), N_ATT = NB * 32 * (PROBE_Q_DUP == 2 ? 2 : 1), N_GM = NB * 16 * 4 * (PROBE_Q_DUP == 3 ? 2 : 1);
        constexpr int Q_SAMPLE = N_SMP, Q_ATTN = Q_SAMPLE + N_ATT, Q_GM = Q_ATTN + N_GM, Q_TOTAL = Q_GM + LATE_UNITS;
        gu32* qhead = F.ctl + CW_QUEUE; volatile LAS unsigned* qslot = F.MISC + 16;
        if (F.tid == 0) qslot[0] = __hip_atomic_fetch_add(qhead, 1u, RLX_AGENT);
        __syncthreads();
        int item = __builtin_amdgcn_readfirstlane((int)qslot[0]); int par = 0;
        while (item < Q_TOTAL) {
            unsigned nxt = 0u; if (F.tid == 0) nxt = __hip_atomic_fetch_add(qhead, 1u, RLX_AGENT);
            if (item < Q_SAMPLE) sample_unit(F, A, item % NS);
            else if (item < Q_ATTN) { const int i = (item - Q_SAMPLE) % (NB * 32); topk_attn_unit(F, i & 15, 31 - (i >> 4)); }
            else if (item < Q_GM) { const int L = (item - Q_ATTN) % (NB * 16 * 4); gmlp_unit(F, A, L >> 6, (L >> 2) & 15, L & 3); }
            else late_weight_unit(F, A, item - Q_GM);
            par ^= 1; if (F.tid == 0) qslot[par] = nxt;
            __syncthreads();
            item = __builtin_amdgcn_readfirstlane((int)qslot[par]);
        }
        if (BOTH(4)) GRID_BAR();
    }
    if (IN(5)) {
        pg8::Gemm g{(const bf16*)(ws + WS_MIX), (const bf16*)(ws + WS_WOUT), MP, DM, DM}; pg8::StaticOrder S; S.init(MP, DM, F.G, c);
        pg8::EpiZ<1, false> E{(const bf16*)(ws + WS_Z1), (const float*)(ws + WS_STZ1), IN_F(I_LN1G), IN_F(I_LN1B), (bf16*)(ws + WS_Z2), (float*)(ws + WS_STZ2), (unsigned)(size_t)(F.lds + XLDS_OFF)};
        pg8::gemm_phase<pg8::EpiZ<1, false>, pg8::StaticOrder, true, true>(F.lds + RING_OFF, g, S, E);
        finalize_cvec(F, 1);
        thin_stage<6>(F, A, F.G - 1 - F.vcu, F.G);
        if (BOTH(5)) GRID_BAR();
    }
    if (IN(6)) {
        pg8::Gemm g{(const bf16*)(ws + WS_Z2), (const bf16*)(ws + WS_W2UP), MP, 2 * FF, DM}; pg8::StaticOrder S; S.init(MP, 2 * FF, F.G, c);
        pg8::EpiSwiGLU<true> E{(bf16*)(ws + WS_H), FF, (const float*)(ws + WS_STZ2), (const float*)(ws + CV_C1UP), (const float*)(ws + CV_C2UP), (unsigned)(size_t)(F.lds + XLDS_OFF + 8192)};
        pg8::gemm_phase<pg8::EpiSwiGLU<true>, pg8::StaticOrder, true, true>(F.lds + RING_OFF, g, S, E);
        thin_stage<7>(F, A, F.G - 1 - F.vcu, F.G);
        if (BOTH(6)) GRID_BAR();
    }
    if (IN(7)) {
        pg8::Gemm g{(const bf16*)(ws + WS_H), (const bf16*)(ws + WS_W2DN), MP, DM, FF}; pg8::StaticOrder S; S.init(MP, DM, F.G, c);
        pg8::EpiZ<1, true> E{(const bf16*)(ws + WS_Z2), (const float*)(ws + WS_STZ2), IN_F(I_LN2G), IN_F(I_LN2B), (bf16*)(ws + WS_Z3), (float*)(ws + WS_STZ3), (unsigned)(size_t)(F.lds + XLDS_OFF)};
        pg8::gemm_phase<pg8::EpiZ<1, true>, pg8::StaticOrder, true, true>(F.lds + RING_OFF, g, S, E);
        thin_stage<8>(F, A, F.G - 1 - F.vcu, F.G);
        if (BOTH(7)) GRID_BAR();
    }
    if (IN(8)) { thin_final_ln(F, A); final_ln_rows(F, A); }
#undef IN
#undef BOTH
#undef GRID_BAR
}

extern "C" void kernel_launch(void* const* d_in, const int* in_sizes, int n_in, void* d_out, int out_size, void* d_ws, size_t ws_size, hipStream_t stream) {
    static int grid = 0;
    if (grid == 0) {
        if (n_in != 22 || in_sizes[0] != MP * DM || (size_t)out_size != OUT_TOTAL || ws_size < WS_END) {
            fprintf(stderr, "kernel_launch: unexpected shapes (n_in %d, in0 %d, out %d, ws %zu); nothing launched\n", n_in, n_in > 0 ? in_sizes[0] : -1, out_size, ws_size); grid = -1; return; }
        int dev = 0, cus = 0, per_cu = 0;
        if (hipGetDevice(&dev) != hipSuccess || hipDeviceGetAttribute(&cus, hipDeviceAttributeMultiprocessorCount, dev) != hipSuccess) { fprintf(stderr, "kernel_launch: device query failed\n"); grid = -1; return; }
        if (hipFuncSetAttribute((const void*)hymba_fwd, hipFuncAttributeMaxDynamicSharedMemorySize, LDS_BYTES) != hipSuccess) { fprintf(stderr, "kernel_launch: hipFuncSetAttribute failed\n"); grid = -1; return; }
        if (hipOccupancyMaxActiveBlocksPerMultiprocessor(&per_cu, (const void*)hymba_fwd, NWAVES * 64, LDS_BYTES) != hipSuccess || per_cu < 1)
            fprintf(stderr, "kernel_launch: note: occupancy query reports %d workgroups per CU\n", per_cu);
        (void)hipGetLastError();
        grid = cus;
        if (grid != 256) fprintf(stderr, "kernel_launch: %d CUs; the fused LayerNorm phases need 256 workgroups: output will be NaN\n", grid);
    }
    if (grid < 0) return;
    if (hipMemsetAsync((char*)d_ws + WS_CTL, 0, CTL_ZERO_BYTES, stream) != hipSuccess) { fprintf(stderr, "kernel_launch: memset failed\n"); return; }
    Args a{};
    for (int i = 0; i < 22; ++i) a.in[i] = d_in[i];
    a.out = (float*)d_out; a.ws = (unsigned char*)d_ws;
    for (int li = 0; li < N_LAUNCHES; ++li) {
        a.ph_lo = (N_LAUNCHES == 1) ? 0 : li; a.ph_hi = (N_LAUNCHES == 1) ? N_PHASES : li + 1;
        hipLaunchKernelGGL(hymba_fwd, dim3(grid), dim3(NWAVES * 64), LDS_BYTES, stream, a);
        const hipError_t le = hipPeekAtLastError();
        if (le != hipSuccess) { fprintf(stderr, "kernel_launch: launch %d failed: %s\n", li, hipGetErrorName(le)); break; }
    }
}
```
